# Optimizing an MI355X kernel written in HIP

```python
import jax, jax.numpy as jnp
from jax import lax
import numpy as np

D_MODEL = 1024
BATCH = 32
SEQ = 2048
DEPTH = 2

CTX_LEN = 256
GRID_W = 64

D_LRU = 512
LRU_BLOCKS = 8
LRU_BLOCK = D_LRU // LRU_BLOCKS
LRU_CONV = 4
LRU_CONV_LEFT = 2
LRU_C = 8.0
D_FOURIER = 256
D_POOL = 256
POOL_WINDOWS = (2, 4, 8, 16)
POOL_GROUP = D_POOL // len(POOL_WINDOWS)
D_SCONV = 256
SCONV_WIDTH = 3
SCONV_LEFT = 1
N_BRANCH = 4
D_FF = 4 * D_MODEL
N_MOD = 6
EPS = 1e-6

OFF_LRU_X = 0
OFF_LRU_G = OFF_LRU_X + D_LRU
OFF_FOURIER = OFF_LRU_G + D_LRU
OFF_POOL = OFF_FOURIER + D_FOURIER
OFF_SCONV = OFF_POOL + D_POOL
OFF_GATE = OFF_SCONV + 3 * D_SCONV
N_IN = OFF_GATE + N_BRANCH * D_MODEL

kernel_name = "hybrid_lru_fourier_pool_conv_dit"


def rmsnorm(x, g):
    xf = x.astype(jnp.float32)
    y = xf * lax.rsqrt(jnp.mean(xf * xf, axis=-1, keepdims=True) + EPS)
    return (y * g.astype(jnp.float32)).astype(x.dtype)


def modulate(u, shift, scale):
    return u * (1.0 + scale) + shift


def depthwise_conv(x, w, left):
    k, ch = w.shape
    return lax.conv_general_dilated(
        x, w[:, None, :].astype(x.dtype), window_strides=(1,),
        padding=[(left, k - 1 - left)],
        dimension_numbers=("NWC", "WIO", "NWC"), feature_group_count=ch)


def rglru_bidir(xa, w_a, b_a, w_x, b_x, lam, h0):
    bn, length, _ = xa.shape
    xf = xa.astype(jnp.float32)
    xs = jnp.stack([xf, xf[:, ::-1]], axis=0)
    xh = xs.reshape(2, bn, length, LRU_BLOCKS, LRU_BLOCK)
    r = jax.nn.sigmoid(jnp.einsum('dblhi,dhij->dblhj', xh, w_a.astype(jnp.float32))
                       .reshape(2, bn, length, D_LRU) + b_a.astype(jnp.float32)[:, None, None])
    gi = jax.nn.sigmoid(jnp.einsum('dblhi,dhij->dblhj', xh, w_x.astype(jnp.float32))
                        .reshape(2, bn, length, D_LRU) + b_x.astype(jnp.float32)[:, None, None])
    log_a = -LRU_C * r * jax.nn.softplus(-lam.astype(jnp.float32))[:, None, None]
    a = jnp.exp(log_a)
    b = jnp.sqrt(-jnp.expm1(2.0 * log_a)) * (gi * xs)
    b = b.at[:, :, 0].add(a[:, :, 0] * h0)

    def combine(e1, e2):
        a1, b1 = e1
        a2, b2 = e2
        return a1 * a2, a2 * b1 + b2

    _, h = lax.associative_scan(combine, (a, b), axis=2)
    return h


def fourier_mix(u):
    return jnp.fft.fft2(u.astype(jnp.float32), axes=(1, 2), norm="ortho").real.astype(u.dtype)


def multiscale_pool(u, pool_w, pool_scale):
    length = u.shape[2]
    uf = u.astype(jnp.float32)
    cs = jnp.pad(jnp.cumsum(uf, axis=2), ((0, 0), (0, 0), (1, 0), (0, 0)))
    t = jnp.arange(length)
    outs = []
    for gidx, w in enumerate(POOL_WINDOWS):
        lo = jnp.maximum(t - w // 2, 0)
        hi = jnp.minimum(t + w // 2, length)
        sl = slice(gidx * POOL_GROUP, (gidx + 1) * POOL_GROUP)
        csg = cs[..., sl]
        mean = (jnp.take(csg, hi, axis=2) - jnp.take(csg, lo, axis=2)) / (hi - lo).astype(jnp.float32)[:, None]
        outs.append(mean - uf[..., sl])
    p = jnp.concatenate(outs, axis=-1)
    shp = p.shape
    p = jnp.einsum('bnlgi,gij->bnlgj', p.reshape(shp[:-1] + (len(POOL_WINDOWS), POOL_GROUP)),
                   pool_w.astype(jnp.float32)).reshape(shp)
    return (p * pool_scale.astype(jnp.float32)).astype(u.dtype)


def token_mixer(u, pool_rows, h0, w_in, conv_w, conv_b, w_a, b_a, w_x, b_x, lam,
                pool_w, pool_scale, sconv_w, w_br_lru, w_br_fourier, w_br_pool,
                w_br_sconv, w_out):
    bn, length, _ = u.shape
    z = u @ w_in
    xa = depthwise_conv(z[..., OFF_LRU_X:OFF_LRU_G], conv_w, LRU_CONV_LEFT) + conv_b
    h = rglru_bidir(xa, w_a, b_a, w_x, b_x, lam, h0)
    h_last = h[:, :, -1]
    y_lru = ((h[0] + h[1][:, ::-1]) * jax.nn.gelu(z[..., OFF_LRU_G:OFF_FOURIER].astype(jnp.float32))).astype(u.dtype)
    y_fourier = fourier_mix(z[..., OFF_FOURIER:OFF_POOL])
    zp = z[..., OFF_POOL:OFF_SCONV].reshape(bn, pool_rows, length // pool_rows, D_POOL)
    y_pool = multiscale_pool(zp, pool_w, pool_scale).reshape(bn, length, D_POOL)
    zs = z[..., OFF_SCONV:OFF_GATE]
    gb, gc, hs = zs[..., :D_SCONV], zs[..., D_SCONV:2 * D_SCONV], zs[..., 2 * D_SCONV:]
    y_sconv = gb * depthwise_conv(gc * hs, sconv_w, SCONV_LEFT)
    gates = jax.nn.sigmoid(z[..., OFF_GATE:].reshape(bn, length, N_BRANCH, D_MODEL))
    merged = (gates[:, :, 0] * (y_lru @ w_br_lru)
              + gates[:, :, 1] * (y_fourier @ w_br_fourier)
              + gates[:, :, 2] * (y_pool @ w_br_pool)
              + gates[:, :, 3] * (y_sconv @ w_br_sconv))
    return merged @ w_out, h_last


def sqrelu_mlp(u, w1, w2):
    return jnp.square(jax.nn.relu(u @ w1)) @ w2


def setup_inputs(seed: int = 0) -> dict:
    key = jax.random.key(seed)
    ks = jax.random.split(key, 32)

    def nrm(k, shape, scale):
        return jax.random.normal(k, shape, jnp.float32) * scale

    u_lam = jax.random.uniform(ks[14], (DEPTH, 2, D_LRU), jnp.float32, 0.9, 0.999)
    a_lam = u_lam ** (1.0 / LRU_C)
    return {
        "x": nrm(ks[0], (BATCH, SEQ, D_MODEL), 1.0),
        "c": nrm(ks[1], (BATCH, D_MODEL), 1.0),
        "ctx": nrm(ks[2], (BATCH, CTX_LEN, D_MODEL), 1.0),
        "c_ctx": nrm(ks[3], (D_MODEL,), 1.0),
        "w_mod": nrm(ks[4], (DEPTH, D_MODEL, N_MOD * D_MODEL), 0.5 * D_MODEL ** -0.5),
        "b_mod": nrm(ks[5], (DEPTH, N_MOD * D_MODEL), 0.02),
        "g_norm1": 1.0 + nrm(ks[6], (DEPTH, D_MODEL), 0.02),
        "g_norm2": 1.0 + nrm(ks[7], (DEPTH, D_MODEL), 0.02),
        "w_in": nrm(ks[8], (DEPTH, D_MODEL, N_IN), D_MODEL ** -0.5),
        "lru_conv_w": nrm(ks[9], (DEPTH, LRU_CONV, D_LRU), LRU_CONV ** -0.5),
        "lru_conv_b": nrm(ks[10], (DEPTH, D_LRU), 0.02),
        "lru_w_a": nrm(ks[11], (DEPTH, 2, LRU_BLOCKS, LRU_BLOCK, LRU_BLOCK), LRU_BLOCK ** -0.5),
        "lru_b_a": nrm(ks[12], (DEPTH, 2, D_LRU), 0.1),
        "lru_w_x": nrm(ks[13], (DEPTH, 2, LRU_BLOCKS, LRU_BLOCK, LRU_BLOCK), LRU_BLOCK ** -0.5),
        "lru_b_x": nrm(ks[15], (DEPTH, 2, D_LRU), 0.1),
        "lru_lam": jnp.log(a_lam) - jnp.log1p(-a_lam),
        "pool_w": nrm(ks[16], (DEPTH, len(POOL_WINDOWS), POOL_GROUP, POOL_GROUP), POOL_GROUP ** -0.5),
        "pool_scale": 1.0 + nrm(ks[17], (DEPTH, D_POOL), 0.1),
        "sconv_w": nrm(ks[18], (DEPTH, SCONV_WIDTH, D_SCONV), SCONV_WIDTH ** -0.5),
        "w_br_lru": nrm(ks[19], (DEPTH, D_LRU, D_MODEL), D_LRU ** -0.5),
        "w_br_fourier": nrm(ks[20], (DEPTH, D_FOURIER, D_MODEL), D_FOURIER ** -0.5),
        "w_br_pool": nrm(ks[21], (DEPTH, D_POOL, D_MODEL), D_POOL ** -0.5),
        "w_br_sconv": nrm(ks[22], (DEPTH, D_SCONV, D_MODEL), D_SCONV ** -0.5),
        "w_out": nrm(ks[23], (DEPTH, D_MODEL, D_MODEL), D_MODEL ** -0.5),
        "w_ff1": nrm(ks[24], (DEPTH, D_MODEL, D_FF), D_MODEL ** -0.5),
        "w_ff2": nrm(ks[25], (DEPTH, D_FF, D_MODEL), D_FF ** -0.5),
        "g_final": 1.0 + nrm(ks[26], (D_MODEL,), 0.02),
    }


def reference(x, c, ctx, c_ctx, w_mod, b_mod, g_norm1, g_norm2, w_in, lru_conv_w, lru_conv_b,
              lru_w_a, lru_b_a, lru_w_x, lru_b_x, lru_lam, pool_w, pool_scale, sconv_w,
              w_br_lru, w_br_fourier, w_br_pool, w_br_sconv, w_out, w_ff1, w_ff2, g_final):
    bn = x.shape[0]
    rows = x.shape[1] // GRID_W
    for l in range(DEPTH):
        mixer_params = (w_in[l], lru_conv_w[l], lru_conv_b[l], lru_w_a[l], lru_b_a[l],
                        lru_w_x[l], lru_b_x[l], lru_lam[l], pool_w[l], pool_scale[l], sconv_w[l],
                        w_br_lru[l], w_br_fourier[l], w_br_pool[l], w_br_sconv[l], w_out[l])
        mod = (jax.nn.silu(c) @ w_mod[l] + b_mod[l]).reshape(bn, N_MOD, 1, D_MODEL)
        mod_c = (jax.nn.silu(c_ctx) @ w_mod[l] + b_mod[l]).reshape(N_MOD, D_MODEL)
        uc = modulate(rmsnorm(ctx, g_norm1[l]), mod_c[0], mod_c[1])
        h_zero = jnp.zeros((2, bn, D_LRU), jnp.float32)
        if l < DEPTH - 1:
            yc, h_ctx = token_mixer(uc, 1, h_zero, *mixer_params)
            ctx = ctx + mod_c[2] * yc
            ctx = ctx + mod_c[5] * sqrelu_mlp(
                modulate(rmsnorm(ctx, g_norm2[l]), mod_c[3], mod_c[4]), w_ff1[l], w_ff2[l])
        else:
            xa_c = depthwise_conv(uc @ w_in[l][:, OFF_LRU_X:OFF_LRU_G], lru_conv_w[l], LRU_CONV_LEFT) + lru_conv_b[l]
            h_ctx = rglru_bidir(xa_c, lru_w_a[l], lru_b_a[l], lru_w_x[l], lru_b_x[l], lru_lam[l], h_zero)[:, :, -1]
        ux = modulate(rmsnorm(x, g_norm1[l]), mod[:, 0], mod[:, 1])
        yx, _ = token_mixer(ux, rows, h_ctx, *mixer_params)
        x = x + mod[:, 2] * yx
        x = x + mod[:, 5] * sqrelu_mlp(
            modulate(rmsnorm(x, g_norm2[l]), mod[:, 3], mod[:, 4]), w_ff1[l], w_ff2[l])
    return rmsnorm(x, g_final)
```

```cpp
#include <hip/hip_runtime.h>
#include <hip/hip_cooperative_groups.h>
#include <cstdio>
#include <cstdint>
namespace cg = cooperative_groups;

#ifndef MK_COOP
#define MK_COOP 1
#endif

#define LAS __attribute__((address_space(3)))
typedef unsigned short bf16_t;
typedef short bf16x8 __attribute__((ext_vector_type(8)));
typedef float f32x4 __attribute__((ext_vector_type(4)));
typedef float f32x2 __attribute__((ext_vector_type(2)));
typedef unsigned u32x4 __attribute__((ext_vector_type(4)));
typedef unsigned u32x2 __attribute__((ext_vector_type(2)));

constexpr int NBATCH = 32, SEQ = 2048, CTXL = 256, DM = 1024, DEPTH = 2, DLRU = 512, NIN = 6400, DFF = 4096;
constexpr int NB = 16, NCH = 2;
constexpr int RL = NB * SEQ, RC = NB * CTXL, RT = RL + RC;
constexpr int ZN = 6144, YN = 1280;
constexpr int Z_LG = 512, Z_POOL = 1024, Z_SC = 1280, Z_GATE = 2048;
constexpr int Y_F = 512, Y_POOL = 768, Y_SC = 1024;
constexpr int NSC = 36;
constexpr size_t MiB = 1u << 20;
constexpr size_t WS_CTL = 0, CTL_ZERO_BYTES = 65536;
constexpr size_t WS_MOD = 1 * MiB, WS_WG = 3 * MiB, WS_SUMA = 4 * MiB, WS_SUMH = 7 * MiB, WS_DFTC = 10 * MiB, WS_DFT = 12 * MiB;
constexpr size_t WS_WIN = 28 * MiB, WS_WF = 52 * MiB, WS_WBR = 54 * MiB, WS_WOUT = 60 * MiB, WS_W1 = 64 * MiB, WS_W2 = 80 * MiB;
constexpr size_t WS_CTXW = 96 * MiB, WS_U = 128 * MiB, WS_MRG = 200 * MiB, WS_PT = 272 * MiB, WS_PTC = 304 * MiB, WS_Y = 336 * MiB, WS_Z = 432 * MiB;
constexpr size_t WS_END = WS_Z + (size_t)RT * ZN * 2;
static_assert(WS_END <= 1024 * MiB, "workspace map");
static_assert(WS_Y + (size_t)RT * YN * 2 <= WS_Z && WS_PTC + (size_t)NB * 256 * 4096 * 2 <= WS_Y && WS_MRG + (size_t)RT * DM * 2 <= WS_PT, "workspace map 2");
constexpr int LDS_BYTES = 147456, RING_BYTES = 131072, QSLOT_OFF = LDS_BYTES - 64;
constexpr int NPHASE = 2 + DEPTH * NCH * 9;

__device__ __forceinline__ float bf_lo(unsigned w) { return __uint_as_float(w << 16); }
__device__ __forceinline__ float bf_hi(unsigned w) { return __uint_as_float(w & 0xffff0000u); }
__device__ __forceinline__ unsigned cvt_pk_bf16(float lo, float hi) { unsigned r; asm volatile("v_cvt_pk_bf16_f32 %0, %1, %2" : "=v"(r) : "v"(lo), "v"(hi)); return r; }
__device__ __forceinline__ float sigm(float x) { return __builtin_amdgcn_rcpf(1.0f + __expf(-x)); }
__device__ __forceinline__ float wave_sum(float v) {
#pragma unroll
    for (int o = 1; o < 64; o <<= 1) v += __shfl_xor(v, o);
    return v;
}
#define LDS_WAIT() asm volatile("s_waitcnt lgkmcnt(0)" ::: "memory")

namespace pg8 {
constexpr int BM = 256, BK = 64, HALF = 128, HTB = HALF * BK * 2, STAGE_BYTES = 8 * HTB, NXCD = 8, WGM = 8;
__host__ __device__ __forceinline__ int lds_byte(int r, int c) { const int st = (r >> 4) * 2 + (c >> 5), rr = r & 15, cc = c & 31, ob = rr * 64 + cc * 2; return st * 1024 + (ob ^ (((ob >> 9) & 1) << 5)); }
__host__ __device__ __forceinline__ void stage_rc(int b, int& R, int& C) { const int st = b / 1024, sb = b % 1024, swz = sb ^ (((sb >> 9) & 1) << 5); R = (st >> 1) * 16 + swz / 64; C = (st & 1) * 32 + (swz % 64) / 2; }
__host__ __device__ __forceinline__ int perm32(int rho) { const int n = rho >> 4, i = rho & 15; return 8 * (i >> 2) + 4 * n + (i & 3); }

struct Unit { const char* a; const char* b; char* dst; const char* x0; const char* x1; int nt, seg, ldc; float scale; };
struct Gemm { int lda, ldb; };

__device__ __forceinline__ bool tile_of(long L, int nM, int nN, int& pm, int& pn) {
    const int nwg = nM * nN; if (L >= nwg) return false;
    int wgid = (int)L; { const int q = nwg / NXCD, r = nwg % NXCD, xcd = wgid % NXCD, off = wgid / NXCD; wgid = (xcd < r ? xcd * (q + 1) : r * (q + 1) + (xcd - r) * q) + off; }
    const int nig = WGM * nN, gid = wgid / nig, fm = gid * WGM, gsz = (nM - fm) < WGM ? (nM - fm) : WGM;
    pm = fm + ((wgid % nig) % gsz); pn = (wgid % nig) / gsz; return true;
}

struct EpiBf {
    static constexpr bool PERM = true;
    int act;
    __device__ __forceinline__ bool operator()(f32x4 (&acc)[2][2][4][2], const Unit& u, int wr, int wc, int fr, int fq) const {
        bf16_t* base = (bf16_t*)u.dst + (size_t)(wr * 64 + fr) * u.ldc + wc * 32 + 8 * fq;
        const float sc = u.scale;
#pragma unroll
        for (int ai = 0; ai < 2; ++ai)
#pragma unroll
            for (int m = 0; m < 4; ++m) { bf16_t* rowp = base + (size_t)(ai * HALF + m * 16) * u.ldc;
#pragma unroll
                for (int bj = 0; bj < 2; ++bj) { f32x4 v0 = acc[ai][bj][m][0], v1 = acc[ai][bj][m][1];
                    if (act == 1) {
#pragma unroll
                        for (int e = 0; e < 4; ++e) { const float a = fmaxf(v0[e], 0.f), b = fmaxf(v1[e], 0.f); v0[e] = a * a; v1[e] = b * b; } }
                    v0 = v0 * sc; v1 = v1 * sc;
                    u32x4 w; w.x = cvt_pk_bf16(v0[0], v0[1]); w.y = cvt_pk_bf16(v0[2], v0[3]); w.z = cvt_pk_bf16(v1[0], v1[1]); w.w = cvt_pk_bf16(v1[2], v1[3]);
                    *(u32x4*)(rowp + bj * HALF) = w; } }
        return true;
    }
};
struct EpiRes {
    static constexpr bool PERM = false;
    __device__ __forceinline__ bool operator()(f32x4 (&acc)[2][2][4][2], const Unit& u, int wr, int wc, int fr, int fq) const {
        const float* gv = (const float*)u.x1 + wc * 32 + 4 * fq;
        f32x4 g[2][2];
#pragma unroll
        for (int bj = 0; bj < 2; ++bj)
#pragma unroll
            for (int n = 0; n < 2; ++n) g[bj][n] = *(const f32x4*)(gv + bj * HALF + n * 16);
        const size_t o0 = (size_t)(wr * 64 + fr) * DM + wc * 32 + 4 * fq;
        const float* bs = (const float*)u.x0 + o0; float* od = (float*)u.dst + o0;
#pragma unroll
        for (int ai = 0; ai < 2; ++ai)
#pragma unroll
            for (int m = 0; m < 4; ++m) { const size_t off = (size_t)(ai * HALF + m * 16) * DM;
#pragma unroll
                for (int bj = 0; bj < 2; ++bj)
#pragma unroll
                    for (int n = 0; n < 2; ++n) { const f32x4 b = *(const f32x4*)(bs + off + bj * HALF + n * 16); *(f32x4*)(od + off + bj * HALF + n * 16) = b + g[bj][n] * acc[ai][bj][m][n]; }
                if (m & 1) asm volatile("" ::: "memory"); }
        return true;
    }
};
struct EpiMerge {
    static constexpr bool PERM = true;
    __device__ __forceinline__ bool operator()(f32x4 (&acc)[2][2][4][2], const Unit& u, int wr, int wc, int fr, int fq) const {
        const bf16_t* g0 = (const bf16_t*)u.x0 + (size_t)(wr * 64 + fr) * ZN + wc * 32 + 8 * fq;
        const bool lastseg = (u.seg == 3);
        bf16_t* base = (bf16_t*)u.dst + (size_t)(wr * 64 + fr) * DM + wc * 32 + 8 * fq;
#pragma unroll
        for (int ai = 0; ai < 2; ++ai)
#pragma unroll
            for (int m = 0; m < 4; ++m) { const bf16_t* rp = g0 + (size_t)(ai * HALF + m * 16) * ZN;
#pragma unroll
                for (int bj = 0; bj < 2; ++bj) {
                    const u32x4 ga = *(const u32x4*)(rp + bj * HALF);
                    u32x4 gb = ga; if (!lastseg) gb = *(const u32x4*)(rp + bj * HALF + DM);
                    f32x4 v0 = acc[ai][bj][m][0], v1 = acc[ai][bj][m][1];
#pragma unroll
                    for (int e = 0; e < 4; ++e) {
                        const unsigned wa = ga[e], wb = gb[e];
                        const float a0 = fminf(fmaxf(bf_lo(wa), -30.f), 30.f), a1 = fminf(fmaxf(bf_hi(wa), -30.f), 30.f);
                        const float b0 = fminf(fmaxf(bf_lo(wb), -30.f), 30.f), b1 = fminf(fmaxf(bf_hi(wb), -30.f), 30.f);
                        const float num0 = lastseg ? 1.f : 1.f + __expf(-b0), num1 = lastseg ? 1.f : 1.f + __expf(-b1);
                        const float f0 = num0 * __builtin_amdgcn_rcpf(1.f + __expf(-a0)), f1 = num1 * __builtin_amdgcn_rcpf(1.f + __expf(-a1));
                        if (e < 2) { v0[2 * e] *= f0; v0[2 * e + 1] *= f1; } else { v1[2 * (e - 2)] *= f0; v1[2 * (e - 2) + 1] *= f1; }
                    }
                    acc[ai][bj][m][0] = v0; acc[ai][bj][m][1] = v1;
                    if (lastseg) { u32x4 w; w.x = cvt_pk_bf16(v0[0], v0[1]); w.y = cvt_pk_bf16(v0[2], v0[3]); w.z = cvt_pk_bf16(v1[0], v1[1]); w.w = cvt_pk_bf16(v1[2], v1[3]);
                        *(u32x4*)(base + (size_t)(ai * HALF + m * 16) * DM + bj * HALF) = w; }
                }
                asm volatile("" ::: "memory"); }
        return lastseg;
    }
};

template <class Epi, class Sched>
__device__ __forceinline__ void gemm_phase(LAS unsigned char* lds, const Gemm g, const Sched& S, const Epi& E, const int tid) {
    const int wid = __builtin_amdgcn_readfirstlane(tid >> 6), lane = tid & 63, wr = wid >> 2, wc = wid & 3, fr = lane & 15, fq = lane >> 4;
    unsigned voffA[2], voffB[2];
#pragma unroll
    for (int i = 0; i < 2; ++i) { int R, C; stage_rc(tid * 16 + i * 8192, R, C); const int Rb = Epi::PERM ? ((R & ~31) + perm32(R & 31)) : R;
        voffA[i] = (unsigned)(R * g.lda + C) * 2u; voffB[i] = (unsigned)(Rb * g.ldb + C) * 2u; }
    const size_t kstep = (size_t)(BK * 2);
    const size_t hstepA = (size_t)HALF * g.lda * 2, hstepB = (size_t)HALF * g.ldb * 2;
    const unsigned ldsw = (unsigned)wid * 1024u;
    const int aoff = lds_byte(wr * 64 + fr, fq * 8), boff = lds_byte(wc * 32 + fr, fq * 8);
#define PG8_SA(b, h) (((b) * 2 + (h)) * HTB)
#define PG8_SB(b, h) ((4 + (b) * 2 + (h)) * HTB)
#define PG8_STAGE(bufoff, gbase, voff) do { _Pragma("unroll") for (int _i = 0; _i < 2; ++_i) \
        __builtin_amdgcn_global_load_lds((const unsigned*)((const char*)(gbase) + (voff)[_i]), (LAS unsigned*)(lds + (bufoff) + ldsw + _i * 8192), 16, 0, 0); } while (0)
#define PG8_LDA(dst, b, h) do { _Pragma("unroll") for (int m = 0; m < 4; ++m) _Pragma("unroll") for (int k = 0; k < 2; ++k) dst[m][k] = *(const LAS bf16x8*)(lds + PG8_SA(b, h) + aoff + m * 2048 + k * 1024); } while (0)
#define PG8_LDB(dst, b, h) do { _Pragma("unroll") for (int n = 0; n < 2; ++n) _Pragma("unroll") for (int k = 0; k < 2; ++k) dst[n][k] = *(const LAS bf16x8*)(lds + PG8_SB(b, h) + boff + n * 2048 + k * 1024); } while (0)
#define PG8_MMA(ai, bj, At, Bt) do { __builtin_amdgcn_s_setprio(1); _Pragma("unroll") for (int m = 0; m < 4; ++m) _Pragma("unroll") for (int n = 0; n < 2; ++n) _Pragma("unroll") for (int k = 0; k < 2; ++k) \
        acc[ai][bj][m][n] = __builtin_amdgcn_mfma_f32_16x16x32_bf16(Bt[n][k], At[m][k], acc[ai][bj][m][n], 0, 0, 0); __builtin_amdgcn_s_setprio(0); } while (0)
#define PG8_WAIT_V(n) asm volatile("s_waitcnt vmcnt(" #n ")" ::: "memory")
#define PG8_WAIT_L(n) asm volatile("s_waitcnt lgkmcnt(" #n ")" ::: "memory")
#define PG8_BAR __builtin_amdgcn_s_barrier()
#define PG8_SCHED __builtin_amdgcn_sched_barrier(0)
    Unit cur, nxt; int ui = 0;
    if (!S.next(0, cur)) return;
    f32x4 acc[2][2][4][2];
#pragma unroll
    for (int a = 0; a < 2; ++a)
#pragma unroll
        for (int b = 0; b < 2; ++b)
#pragma unroll
            for (int m = 0; m < 4; ++m)
#pragma unroll
                for (int n = 0; n < 2; ++n) acc[a][b][m][n] = (f32x4){0.f, 0.f, 0.f, 0.f};
    bf16x8 At[4][2], B0[2][2], B1[2][2];
    const char* cA = cur.a; const char* cB = cur.b;
    PG8_STAGE(PG8_SB(0, 0), cB, voffB); PG8_STAGE(PG8_SB(0, 1), cB + hstepB, voffB); PG8_STAGE(PG8_SA(0, 0), cA, voffA); PG8_STAGE(PG8_SA(0, 1), cA + hstepA, voffA);
    if (wr == 1) PG8_BAR;
    PG8_WAIT_V(2); PG8_BAR;
    PG8_STAGE(PG8_SB(1, 0), cB + kstep, voffB); PG8_STAGE(PG8_SA(1, 0), cA + kstep, voffA); PG8_STAGE(PG8_SB(1, 1), cB + hstepB + kstep, voffB);
    PG8_WAIT_V(6); PG8_BAR;
    for (;;) {
        const bool has_next = S.next(ui + 1, nxt);
        const char* nA = has_next ? nxt.a : cA; const char* nB = has_next ? nxt.b : cB;
        const int nt = cur.nt;
        for (int t = 0; t < nt; t += 2) {
            const bool last = (t == nt - 2);
            const char* a1 = cA + (size_t)(t + 1) * kstep;
            const char* a2 = last ? nA : cA + (size_t)(t + 2) * kstep; const char* b2 = last ? nB : cB + (size_t)(t + 2) * kstep;
            const char* a3 = a2 + kstep; const char* b3 = b2 + kstep;
            PG8_LDB(B0, 0, 0); PG8_LDB(B1, 0, 1); PG8_SCHED; PG8_LDA(At, 0, 0); PG8_STAGE(PG8_SA(1, 1), a1 + hstepA, voffA);
            PG8_WAIT_V(8); PG8_WAIT_L(0); PG8_BAR; PG8_MMA(0, 0, At, B0); PG8_MMA(0, 1, At, B1); PG8_BAR; PG8_SCHED;
            PG8_LDA(At, 0, 1); PG8_STAGE(PG8_SB(0, 0), b2, voffB); PG8_STAGE(PG8_SB(0, 1), b2 + hstepB, voffB); PG8_STAGE(PG8_SA(0, 0), a2, voffA);
            PG8_WAIT_V(8); PG8_WAIT_L(0); PG8_BAR; PG8_MMA(1, 0, At, B0); PG8_MMA(1, 1, At, B1); PG8_BAR; PG8_SCHED;
            PG8_LDB(B0, 1, 0); PG8_LDB(B1, 1, 1); PG8_SCHED; PG8_LDA(At, 1, 0); PG8_STAGE(PG8_SA(0, 1), a2 + hstepA, voffA);
            PG8_WAIT_V(8); PG8_WAIT_L(0); PG8_BAR; PG8_MMA(0, 0, At, B0); PG8_MMA(0, 1, At, B1); PG8_BAR; PG8_SCHED;
            PG8_LDA(At, 1, 1); PG8_STAGE(PG8_SB(1, 0), b3, voffB); PG8_STAGE(PG8_SB(1, 1), b3 + hstepB, voffB); PG8_STAGE(PG8_SA(1, 0), a3, voffA);
            PG8_WAIT_V(8); PG8_WAIT_L(0); PG8_BAR; PG8_MMA(1, 0, At, B0); PG8_MMA(1, 1, At, B1); PG8_BAR; PG8_SCHED;
        }
        if (wr == 0) PG8_BAR;
        const bool zero = E(acc, cur, wr, wc, fr, fq);
        if (!has_next) break;
        if (zero) {
#pragma unroll
            for (int a = 0; a < 2; ++a)
#pragma unroll
                for (int b = 0; b < 2; ++b)
#pragma unroll
                    for (int m = 0; m < 4; ++m)
#pragma unroll
                        for (int n = 0; n < 2; ++n) acc[a][b][m][n] = (f32x4){0.f, 0.f, 0.f, 0.f};
        }
        cur = nxt; cA = nA; cB = nB; ++ui;
        if (wr == 1) PG8_BAR;
    }
    PG8_WAIT_V(0);
    PG8_BAR;
#undef PG8_SA
#undef PG8_SB
#undef PG8_STAGE
#undef PG8_LDA
#undef PG8_LDB
#undef PG8_MMA
#undef PG8_WAIT_V
#undef PG8_WAIT_L
#undef PG8_BAR
#undef PG8_SCHED
}
}

struct Args { const float* in[27]; float* out; unsigned char* ws; int ph_lo, ph_hi; };
typedef const __attribute__((address_space(4))) Args* ArgP;
enum { I_X = 0, I_C, I_CTX, I_CCTX, I_WMOD, I_BMOD, I_G1, I_G2, I_WIN, I_CONVW, I_CONVB, I_WA, I_BA, I_WX, I_BX, I_LAM, I_POOLW, I_POOLS, I_SCW,
       I_BRL, I_BRF, I_BRP, I_BRS, I_WOUT, I_FF1, I_FF2, I_GF };

struct Sched {
    int kind, l, ch, G, c;
    ArgP ap;
    __device__ __forceinline__ bool next(int i, pg8::Unit& u) const {
        unsigned char* ws = ap->ws;
        const long L = (long)i * G + c;
        const int nM = (l == 0) ? RT / 256 : RL / 256;
        u.x0 = nullptr; u.x1 = nullptr; u.seg = 0; u.scale = 1.f;
        int pm, pn;
        if (kind == 1) {
            const char* U = (const char*)(ws + WS_U);
            const int nZ = nM * 24;
            long L2 = L - nZ; bool isz = false;
            if (L < nZ) { pg8::tile_of(L, nM, 24, pm, pn); isz = true; }
            else if (l == 1) { if (L2 < 32) { pm = 128 + (int)(L2 >> 1); pn = (int)(L2 & 1); isz = true; } else L2 -= 32; }
            if (isz) {
                u.a = U + (size_t)pm * 256 * DM * 2; u.b = (const char*)(ws + WS_WIN) + ((size_t)l * ZN + (size_t)pn * 256) * DM * 2; u.nt = 16;
                u.dst = (char*)(ws + WS_Z) + ((size_t)pm * 256 * ZN + (size_t)pn * 256) * 2; u.ldc = ZN; return true;
            }
            if (L2 >= 2 * nM) return false;
            const int seg = (int)(L2 & 1), tt = (int)(L2 >> 1);
            u.a = (const char*)(ws + WS_WF) + ((size_t)l * 512 + (size_t)seg * 256) * DM * 2; u.b = U + (size_t)tt * 256 * DM * 2; u.nt = 16; u.ldc = 4096;
            if (tt < 128) u.dst = (char*)(ws + WS_PT) + ((size_t)(tt >> 3) * 256 * 4096 + (size_t)seg * 2048 + (size_t)(tt & 7) * 256) * 2;
            else u.dst = (char*)(ws + WS_PTC) + ((size_t)(tt - 128) * 256 * 4096 + (size_t)seg * 256) * 2;
            return true;
        }
        if (kind == 7) {
            if (!pg8::tile_of(L, nM, 16, pm, pn)) return false;
            u.a = (const char*)(ws + WS_U) + (size_t)pm * 256 * DM * 2; u.b = (const char*)(ws + WS_W1) + ((size_t)l * DFF + (size_t)pn * 256) * DM * 2; u.nt = 16;
            u.dst = (char*)(ws + WS_Z) + ((size_t)pm * 256 * DFF + (size_t)pn * 256) * 2; u.ldc = DFF; return true;
        }
        if (kind == 2) {
            if (L < 128) { const int b_ = (int)(L >> 3), kt = (int)(L & 7);
                u.a = (const char*)(ws + WS_DFT) + (size_t)kt * 256 * 4096 * 2; u.b = (const char*)(ws + WS_PT) + (size_t)b_ * 256 * 4096 * 2; u.nt = 64;
                u.dst = (char*)(ws + WS_Y) + ((size_t)(b_ * SEQ + kt * 256) * YN + Y_F) * 2; u.ldc = YN; u.scale = 0.001381067932004975f  ; return true; }
            if (l == 0 && L < 144) { const int j = (int)L - 128;
                u.a = (const char*)(ws + WS_DFTC); u.b = (const char*)(ws + WS_PTC) + (size_t)j * 256 * 4096 * 2; u.nt = 8;
                u.dst = (char*)(ws + WS_Y) + ((size_t)(RL + j * 256) * YN + Y_F) * 2; u.ldc = YN; u.scale = 1.f / 256.f; return true; }
            return false;
        }
        if (kind == 4) {
            const int seg = i & 3; const long T = (long)(i >> 2) * G + c;
            if (!pg8::tile_of(T, nM, 4, pm, pn)) return false;
            const int coff = seg == 0 ? 0 : (256 + 256 * seg);
            u.a = (const char*)(ws + WS_Y) + ((size_t)pm * 256 * YN + coff) * 2; u.b = (const char*)(ws + WS_WBR) + (((size_t)l * DM + (size_t)pn * 256) * YN + coff) * 2;
            u.nt = seg == 0 ? 8 : 4; u.seg = seg; u.ldc = DM;
            u.dst = (char*)(ws + WS_MRG) + ((size_t)pm * 256 * DM + (size_t)pn * 256) * 2;
            u.x0 = (const char*)(ws + WS_Z) + ((size_t)pm * 256 * ZN + Z_GATE + seg * DM + pn * 256) * 2;
            return true;
        }
        if (!pg8::tile_of(L, nM, 4, pm, pn)) return false;
        if (kind == 5) { u.a = (const char*)(ws + WS_MRG) + (size_t)pm * 256 * DM * 2; u.b = (const char*)(ws + WS_WOUT) + ((size_t)l * DM + (size_t)pn * 256) * DM * 2; u.nt = 16; }
        else { u.a = (const char*)(ws + WS_Z) + (size_t)pm * 256 * DFF * 2; u.b = (const char*)(ws + WS_W2) + ((size_t)l * DM + (size_t)pn * 256) * DFF * 2; u.nt = 64; }
        int bidx; size_t eoff;
        if (pm < 128) { eoff = ((size_t)(ch * RL + pm * 256) * DM + pn * 256) * 4; bidx = ch * NB + (pm >> 3);
            char* out = (char*)ap->out; u.dst = out + eoff; u.x0 = (kind == 5 && l == 0) ? (const char*)ap->in[I_X] + eoff : (const char*)out + eoff; }
        else { eoff = ((size_t)(ch * RC + (pm - 128) * 256) * DM + pn * 256) * 4; bidx = 32;
            u.dst = (char*)(ws + WS_CTXW) + eoff; u.x0 = (kind == 5) ? (const char*)ap->in[I_CTX] + eoff : (const char*)(ws + WS_CTXW) + eoff; }
        u.x1 = (const char*)(ws + WS_MOD) + ((size_t)((l * 33 + bidx) * 6 + (kind == 5 ? 2 : 5)) * DM + pn * 256) * 4;
        u.ldc = DM;
        return true;
    }
};

__device__ __forceinline__ void tr_item(const float* W, int ldw, int col0, int ncols, bf16_t* WT, int ldt, int koff, LAS float* scr, int item, int lane) {
    const int nblk = ncols / 32, kb = item / nblk, nb = item % nblk, k0 = 64 * kb, n0 = 32 * nb;
#pragma unroll 8
    for (int i = 0; i < 32; ++i) { const int kk = 2 * i + (lane >> 5); scr[kk * 33 + (lane & 31)] = W[(size_t)(k0 + kk) * ldw + col0 + n0 + (lane & 31)]; }
    LDS_WAIT(); asm volatile("" ::: "memory");
    const int c = lane & 7;
#pragma unroll
    for (int j = 0; j < 4; ++j) { const int n = (lane >> 3) + 8 * j; const LAS float* s = scr + (8 * c) * 33 + n;
        u32x4 o; o.x = cvt_pk_bf16(s[0 * 33], s[1 * 33]); o.y = cvt_pk_bf16(s[2 * 33], s[3 * 33]); o.z = cvt_pk_bf16(s[4 * 33], s[5 * 33]); o.w = cvt_pk_bf16(s[6 * 33], s[7 * 33]);
        *(u32x4*)(WT + (size_t)(n0 + n) * ldt + koff + k0 + 8 * c) = o; }
    LDS_WAIT(); asm volatile("" ::: "memory");
}

__device__ __forceinline__ void p0_prologue(ArgP A, LAS unsigned char* lds, int G, const int tid) {
    const int lane = tid & 63, wave = tid >> 6, bx = blockIdx.x;
    unsigned char* ws = A->ws;
    if (bx < 192) {
        const int l = bx / 96, cb = bx % 96, n = cb * 64 + lane;
        LAS float* sl = (LAS float*)lds;
        for (int idx = tid; idx < 33 * 1024; idx += 512) { const int bb = idx >> 10, k = idx & 1023; const float v = bb < 32 ? A->in[I_C][bb * 1024 + k] : A->in[I_CCTX][k]; sl[idx] = v * sigm(v); }
        __syncthreads();
        float acc[33];
#pragma unroll
        for (int bb = 0; bb < 33; ++bb) acc[bb] = 0.f;
        const float* wp = A->in[I_WMOD] + ((size_t)l * 1024 + wave * 128) * 6144 + n;
        for (int k4 = 0; k4 < 32; ++k4) {
            const float w0 = wp[(size_t)(4 * k4 + 0) * 6144], w1 = wp[(size_t)(4 * k4 + 1) * 6144], w2 = wp[(size_t)(4 * k4 + 2) * 6144], w3 = wp[(size_t)(4 * k4 + 3) * 6144];
#pragma unroll
            for (int bb = 0; bb < 33; ++bb) { const f32x4 s = *(const LAS f32x4*)(sl + bb * 1024 + wave * 128 + 4 * k4); acc[bb] += s[0] * w0 + s[1] * w1 + s[2] * w2 + s[3] * w3; }
        }
        __syncthreads();
        LAS float* red = (LAS float*)lds;
#pragma unroll
        for (int bb = 0; bb < 33; ++bb) red[(wave * 33 + bb) * 64 + lane] = acc[bb];
        __syncthreads();
        float* MOD = (float*)(ws + WS_MOD);
        for (int idx = tid; idx < 33 * 64; idx += 512) { const int bb = idx >> 6, ln = idx & 63; float s = A->in[I_BMOD][l * 6144 + cb * 64 + ln];
#pragma unroll
            for (int w = 0; w < 8; ++w) s += red[(w * 33 + bb) * 64 + ln];
            MOD[(size_t)(l * 33 + bb) * 6144 + cb * 64 + ln] = s; }
        __syncthreads();
    } else if (bx < 224) {
        const int it = bx - 192, l = it >> 4, k0 = (it & 15) * 64;
        LAS float* wt = (LAS float*)lds;
        LAS float* tab = (LAS float*)(lds + 65536);
        for (int idx = tid; idx < 64 * 256; idx += 512) { const int kk = idx >> 8, c = idx & 255; wt[idx] = A->in[I_WIN][((size_t)l * 1024 + k0 + kk) * NIN + 1024 + c]; }
        { const int i = tid & 255; tab[tid] = (tid < 256) ? cospif((float)i / 128.f) : sinpif((float)i / 128.f); }
        __syncthreads();
        const int m = tid & 255; const LAS float* tb = tab + (tid >> 8) * 256;
        bf16_t* WF = (bf16_t*)(ws + WS_WF) + ((size_t)l * 512 + tid) * DM + k0;
        for (int kg = 0; kg < 8; ++kg) {
            float a[8];
#pragma unroll
            for (int q = 0; q < 8; ++q) a[q] = 0.f;
            for (int c = 0; c < 256; ++c) { const float tv = tb[(m * c) & 255];
#pragma unroll
                for (int q = 0; q < 8; ++q) a[q] += wt[(kg * 8 + q) * 256 + c] * tv; }
            u32x4 o; o.x = cvt_pk_bf16(a[0], a[1]); o.y = cvt_pk_bf16(a[2], a[3]); o.z = cvt_pk_bf16(a[4], a[5]); o.w = cvt_pk_bf16(a[6], a[7]);
            *(u32x4*)(WF + kg * 8) = o;
        }
        __syncthreads();
    }
    {
        LAS float* scr = (LAS float*)(lds + wave * 16384);
        const int gw = wave * G + bx, NGW = G * 8;
        for (int it = gw; it < 16384; it += NGW) {
            const int l = it >> 13; int r = it & 8191;
            const float* win = A->in[I_WIN] + (size_t)l * 1024 * NIN;
            bf16_t* WIN = (bf16_t*)(ws + WS_WIN) + (size_t)l * ZN * DM;
            bf16_t* WBR = (bf16_t*)(ws + WS_WBR) + (size_t)l * DM * YN;
            if (r < 512) { tr_item(win, NIN, 0, 1024, WIN, DM, 0, scr, r, lane); continue; } r -= 512;
            if (r < 2560) { tr_item(win, NIN, 1280, 5120, WIN + (size_t)1024 * DM, DM, 0, scr, r, lane); continue; } r -= 2560;
            if (r < 256) { tr_item(A->in[I_BRL] + (size_t)l * 512 * DM, DM, 0, DM, WBR, YN, 0, scr, r, lane); continue; } r -= 256;
            if (r < 128) { tr_item(A->in[I_BRF] + (size_t)l * 256 * DM, DM, 0, DM, WBR, YN, Y_F, scr, r, lane); continue; } r -= 128;
            if (r < 128) { tr_item(A->in[I_BRS] + (size_t)l * 256 * DM, DM, 0, DM, WBR, YN, Y_SC, scr, r, lane); continue; } r -= 128;
            if (r < 512) { tr_item(A->in[I_WOUT] + (size_t)l * DM * DM, DM, 0, DM, (bf16_t*)(ws + WS_WOUT) + (size_t)l * DM * DM, DM, 0, scr, r, lane); continue; } r -= 512;
            if (r < 2048) { tr_item(A->in[I_FF1] + (size_t)l * DM * DFF, DFF, 0, DFF, (bf16_t*)(ws + WS_W1) + (size_t)l * DFF * DM, DM, 0, scr, r, lane); continue; } r -= 2048;
            tr_item(A->in[I_FF2] + (size_t)l * DFF * DM, DM, 0, DM, (bf16_t*)(ws + WS_W2) + (size_t)l * DM * DFF, DFF, 0, scr, r, lane);
        }
    }
    const int gt = bx * 512 + tid, NGT = G * 512;
    {
        bf16_t* WG = (bf16_t*)(ws + WS_WG);
        for (int idx = gt; idx < 2 * 8 * 256 * 64; idx += NGT) { const int i = idx & 63, n = (idx >> 6) & 255, h = (idx >> 14) & 7, l = idx >> 17, d = n >> 7, gate = (n >> 6) & 1, j = n & 63;
            const float v = (gate ? A->in[I_WX] : A->in[I_WA])[((size_t)((l * 2 + d) * 8 + h) * 64 + i) * 64 + j];
            WG[idx] = (bf16_t)(cvt_pk_bf16(v, 0.f) & 0xffffu); }
    }
    {
        for (int idx = gt; idx < 2 * 256 * 1024; idx += NGT) { const int n = idx & 1023, i = (idx >> 10) & 255, l = idx >> 18, g = i >> 6, il = i & 63;
            const float* pw = A->in[I_POOLW] + ((size_t)(l * 4 + g) * 64 + il) * 64; const float* ps = A->in[I_POOLS] + l * 256 + g * 64; const float* wb = A->in[I_BRP] + ((size_t)l * 256 + g * 64) * DM + n;
            float s = 0.f;
            for (int j = 0; j < 64; ++j) s += pw[j] * ps[j] * wb[(size_t)j * DM];
            ((bf16_t*)(ws + WS_WBR))[((size_t)l * DM + n) * YN + Y_POOL + i] = (bf16_t)(cvt_pk_bf16(s, 0.f) & 0xffffu); }
    }
    {
        bf16_t* DF = (bf16_t*)(ws + WS_DFT);
        for (int idx = gt; idx < 2048 * 512; idx += NGT) { const int k = idx >> 9, n8 = (idx & 511) * 8; float v[8];
#pragma unroll
            for (int e = 0; e < 8; ++e) { const int np = n8 + e; if (np < 2048) v[e] = cospif((float)((k * np) & 2047) * (1.f / 1024.f)); else v[e] = -sinpif((float)((k * (np - 2048)) & 2047) * (1.f / 1024.f)); }
            u32x4 o; o.x = cvt_pk_bf16(v[0], v[1]); o.y = cvt_pk_bf16(v[2], v[3]); o.z = cvt_pk_bf16(v[4], v[5]); o.w = cvt_pk_bf16(v[6], v[7]);
            *(u32x4*)(DF + (size_t)k * 4096 + n8) = o; }
        bf16_t* DC = (bf16_t*)(ws + WS_DFTC);
        for (int idx = gt; idx < 256 * 64; idx += NGT) { const int k = idx >> 6, n8 = (idx & 63) * 8; float v[8];
#pragma unroll
            for (int e = 0; e < 8; ++e) { const int np = n8 + e; if (np < 256) v[e] = cospif((float)((k * np) & 255) * (1.f / 128.f)); else v[e] = -sinpif((float)((k * (np - 256)) & 255) * (1.f / 128.f)); }
            u32x4 o; o.x = cvt_pk_bf16(v[0], v[1]); o.y = cvt_pk_bf16(v[2], v[3]); o.z = cvt_pk_bf16(v[4], v[5]); o.w = cvt_pk_bf16(v[6], v[7]);
            *(u32x4*)(DC + (size_t)k * 4096 + n8) = o; }
    }
}

__device__ __forceinline__ void norm_phase(ArgP A, int l, int ch, bool second, int G, const int tid) {
    const int lane = tid & 63, wave = tid >> 6;
    unsigned char* ws = A->ws;
    const int nrows = (second && l == 1) ? RL : RT;
    const float* gn = (second ? A->in[I_G2] : A->in[I_G1]) + l * DM;
    const float* MOD = (const float*)(ws + WS_MOD);
    bf16_t* U = (bf16_t*)(ws + WS_U);
    for (int r = blockIdx.x * 8 + wave; r < nrows; r += G * 8) {
        const float* src; int bidx;
        if (r < RL) { const size_t grow = (size_t)ch * RL + r; src = ((!second && l == 0) ? A->in[I_X] : (const float*)A->out) + grow * DM; bidx = ch * NB + (r >> 11); }
        else { const size_t grow = (size_t)ch * RC + (r - RL); src = ((!second && l == 0) ? A->in[I_CTX] : (const float*)(ws + WS_CTXW)) + grow * DM; bidx = 32; }
        const float* sh = MOD + (size_t)((l * 33 + bidx) * 6 + (second ? 3 : 0)) * DM; const float* sc = sh + DM;
        f32x4 v[4]; float s = 0.f;
#pragma unroll
        for (int j = 0; j < 4; ++j) { v[j] = *(const f32x4*)(src + 4 * (lane + 64 * j)); s += (v[j][0] * v[j][0] + v[j][1] * v[j][1]) + (v[j][2] * v[j][2] + v[j][3] * v[j][3]); }
        const float rstd = 1.0f / sqrtf(wave_sum(s) * (1.f / DM) + 1e-6f);
#pragma unroll
        for (int j = 0; j < 4; ++j) { const int col = 4 * (lane + 64 * j);
            const f32x4 gg = *(const f32x4*)(gn + col), s1 = *(const f32x4*)(sc + col), s0 = *(const f32x4*)(sh + col);
            const f32x4 o = (v[j] * rstd) * gg * (s1 + 1.0f) + s0;
            u32x2 w; w.x = cvt_pk_bf16(o[0], o[1]); w.y = cvt_pk_bf16(o[2], o[3]);
            *(u32x2*)(U + (size_t)r * DM + col) = w; }
    }
}
__device__ __forceinline__ void final_norm(ArgP A, int G, const int tid) {
    const int lane = tid & 63, wave = tid >> 6;
    const float* gn = A->in[I_GF];
    for (int r = blockIdx.x * 8 + wave; r < NBATCH * SEQ; r += G * 8) {
        float* p = A->out + (size_t)r * DM;
        f32x4 v[4]; float s = 0.f;
#pragma unroll
        for (int j = 0; j < 4; ++j) { v[j] = *(const f32x4*)(p + 4 * (lane + 64 * j)); s += (v[j][0] * v[j][0] + v[j][1] * v[j][1]) + (v[j][2] * v[j][2] + v[j][3] * v[j][3]); }
        const float rstd = 1.0f / sqrtf(wave_sum(s) * (1.f / DM) + 1e-6f);
#pragma unroll
        for (int j = 0; j < 4; ++j) { const int col = 4 * (lane + 64 * j); const f32x4 gg = *(const f32x4*)(gn + col); *(f32x4*)(p + col) = (v[j] * rstd) * gg; }
    }
}

__device__ __forceinline__ void unpack8(const u32x4 w, float (&f)[8]) {
#pragma unroll
    for (int e = 0; e < 4; ++e) { f[2 * e] = bf_lo(w[e]); f[2 * e + 1] = bf_hi(w[e]); }
}
__device__ __forceinline__ u32x4 pack8(const float (&f)[8]) { u32x4 o; o.x = cvt_pk_bf16(f[0], f[1]); o.y = cvt_pk_bf16(f[2], f[3]); o.z = cvt_pk_bf16(f[4], f[5]); o.w = cvt_pk_bf16(f[6], f[7]); return o; }

__device__ __forceinline__ void lru_item(ArgP A, int l, int it, bool pass2, LAS unsigned char* lds, const int tid) {
    const int lane = tid & 63, wid = tid >> 6;
    unsigned char* ws = A->ws;
    const int head = it & 7, rest = it >> 3;
    int sc, bl;
    if (!pass2 || l == 0) { sc = rest % NSC; bl = rest / NSC; } else { sc = 4 + (rest & 31); bl = rest >> 5; }
    const bool isctx = sc < 4; const int c = isctx ? sc : sc - 4, Lseq = isctx ? CTXL : SEQ, rowbase = isctx ? RL + bl * CTXL : bl * SEQ, t0 = c * 64;
    const bf16_t* Z = (const bf16_t*)(ws + WS_Z);
    LAS float* xaf = (LAS float*)lds;
    LAS bf16_t* xab = (LAS bf16_t*)(lds + 17408);
    LAS float* hbuf = (LAS float*)(lds + 32768);
    {
        const int t = tid >> 3, i8 = (tid & 7) * 8, tok = t0 + t, Cc = head * 64 + i8;
        float acc[8];
        { const f32x4 b0 = *(const f32x4*)(A->in[I_CONVB] + l * DLRU + Cc), b1 = *(const f32x4*)(A->in[I_CONVB] + l * DLRU + Cc + 4);
#pragma unroll
          for (int e = 0; e < 4; ++e) { acc[e] = b0[e]; acc[4 + e] = b1[e]; } }
#pragma unroll
        for (int k = 0; k < 4; ++k) { const int tt = tok + k - 2;
            if (tt >= 0 && tt < Lseq) { float z[8]; unpack8(*(const u32x4*)(Z + (size_t)(rowbase + tt) * ZN + Cc), z);
                const float* cw = A->in[I_CONVW] + (size_t)(l * 4 + k) * DLRU + Cc; const f32x4 c0 = *(const f32x4*)cw, c1 = *(const f32x4*)(cw + 4);
#pragma unroll
                for (int e = 0; e < 4; ++e) { acc[e] += z[e] * c0[e]; acc[4 + e] += z[4 + e] * c1[e]; } } }
        *(LAS f32x4*)(xaf + t * 68 + i8) = (f32x4){acc[0], acc[1], acc[2], acc[3]}; *(LAS f32x4*)(xaf + t * 68 + i8 + 4) = (f32x4){acc[4], acc[5], acc[6], acc[7]};
        *(LAS u32x4*)(xab + t * 72 + i8) = pack8(acc);
    }
    __syncthreads();
    {
        const int d = wid >> 2, g = wid & 3, fr = lane & 15, fq = lane >> 4;
        const bf16_t* wb = (const bf16_t*)(ws + WS_WG) + ((size_t)((l * 8 + head) * 256 + d * 128 + 16 * g + fr)) * 64 + 8 * fq;
        bf16x8 wR[2], wG[2];
#pragma unroll
        for (int ks = 0; ks < 2; ++ks) { wR[ks] = *(const bf16x8*)(wb + 32 * ks); wG[ks] = *(const bf16x8*)(wb + 64 * 64 + 32 * ks); }
        const int cb = head * 64 + 16 * g + 4 * fq;
        const f32x4 ba = *(const f32x4*)(A->in[I_BA] + (l * 2 + d) * DLRU + cb), bxv = *(const f32x4*)(A->in[I_BX] + (l * 2 + d) * DLRU + cb), lam = *(const f32x4*)(A->in[I_LAM] + (l * 2 + d) * DLRU + cb);
        f32x4 sp8;
#pragma unroll
        for (int e = 0; e < 4; ++e) sp8[e] = 8.0f * log1pf(__expf(-lam[e]));
        const int p = (d == 0) ? sc : (isctx ? 3 - c : 4 + 31 - c);
        float* SA = (float*)(ws + WS_SUMA) + ((size_t)(bl * 2 + d) * NSC) * DLRU + cb; float* SH = (float*)(ws + WS_SUMH) + ((size_t)(bl * 2 + d) * NSC) * DLRU + cb;
        f32x4 hin = (f32x4){0.f, 0.f, 0.f, 0.f}, Atot = (f32x4){1.f, 1.f, 1.f, 1.f}, Htot = (f32x4){0.f, 0.f, 0.f, 0.f};
        if (pass2) for (int pp = 0; pp < p; ++pp) { const f32x4 a4 = *(const f32x4*)(SA + (size_t)pp * DLRU), h4 = *(const f32x4*)(SH + (size_t)pp * DLRU); hin = a4 * hin + h4; }
        const int lastl = (lane & 48) | (d ? 0 : 15);
#pragma unroll
        for (int q = 0; q < 4; ++q) { const int tt = d ? 3 - q : q;
            f32x4 aR = (f32x4){0.f, 0.f, 0.f, 0.f}, aG = (f32x4){0.f, 0.f, 0.f, 0.f};
#pragma unroll
            for (int ks = 0; ks < 2; ++ks) { const bf16x8 bfrag = *(const LAS bf16x8*)(xab + (16 * tt + fr) * 72 + 8 * fq + 32 * ks);
                aR = __builtin_amdgcn_mfma_f32_16x16x32_bf16(wR[ks], bfrag, aR, 0, 0, 0); aG = __builtin_amdgcn_mfma_f32_16x16x32_bf16(wG[ks], bfrag, aG, 0, 0, 0); }
            const f32x4 xv = *(const LAS f32x4*)(xaf + (16 * tt + fr) * 68 + 16 * g + 4 * fq);
            f32x4 hv;
#pragma unroll
            for (int e = 0; e < 4; ++e) {
                const float r = sigm(aR[e] + ba[e]), gi = sigm(aG[e] + bxv[e]);
                const float la = -r * sp8[e], a = __expf(la), x2 = -2.0f * la;
                const float om = x2 < 0.1f ? x2 * (1.0f - x2 * (0.5f - x2 * (0.16666667f - x2 * 0.041666668f))) : 1.0f - a * a;
                float Av = a, Bv = sqrtf(om) * gi * xv[e];
#pragma unroll
                for (int off = 1; off < 16; off <<= 1) { const int src = d ? lane + off : lane - off; const float Ap = __shfl(Av, src), Bp = __shfl(Bv, src);
                    const bool valid = d ? (fr + off < 16) : (fr >= off); if (valid) { Bv = Av * Bp + Bv; Av = Av * Ap; } }
                if (pass2) { const float h = Av * hin[e] + Bv; hv[e] = h; hin[e] = __shfl(h, lastl); }
                else { const float AT = __shfl(Av, lastl), BT = __shfl(Bv, lastl); Htot[e] = AT * Htot[e] + BT; Atot[e] = Atot[e] * AT; }
            }
            if (pass2) *(LAS f32x4*)(hbuf + ((d * 64 + 16 * tt + fr) * 68 + 16 * g + 4 * fq)) = hv;
        }
        if (!pass2 && fr == 0) { *(f32x4*)(SA + (size_t)p * DLRU) = Atot; *(f32x4*)(SH + (size_t)p * DLRU) = Htot; }
    }
    if (pass2) {
        __syncthreads();
        const int t = tid >> 3, i8 = (tid & 7) * 8, tok = t0 + t, Cc = head * 64 + i8;
        float zg[8]; unpack8(*(const u32x4*)(Z + (size_t)(rowbase + tok) * ZN + Z_LG + Cc), zg);
        const f32x4 h00 = *(const LAS f32x4*)(hbuf + t * 68 + i8), h01 = *(const LAS f32x4*)(hbuf + t * 68 + i8 + 4), h10 = *(const LAS f32x4*)(hbuf + (64 + t) * 68 + i8), h11 = *(const LAS f32x4*)(hbuf + (64 + t) * 68 + i8 + 4);
        float y[8];
#pragma unroll
        for (int e = 0; e < 8; ++e) { const float hs = e < 4 ? h00[e & 3] + h10[e & 3] : h01[e & 3] + h11[e & 3]; const float x = zg[e];
            const float u2 = 1.5957691216057308f * (x + 0.044715f * x * x * x);
            y[e] = hs * x * sigm(u2); }
        *(u32x4*)((bf16_t*)(ws + WS_Y) + (size_t)(rowbase + tok) * YN + Cc) = pack8(y);
    }
}

__device__ __forceinline__ void seg_decode(int it, int& rowbase, int& s0, int& lob, int& hib, int& Lseq) {
    if (it < 512) { const int bl = it >> 5, sg = it & 31; rowbase = bl * SEQ; s0 = sg * 64; lob = s0; hib = s0 + 64; Lseq = SEQ; }
    else { const int j = it - 512, bl = j >> 2, q = j & 3; rowbase = RL + bl * CTXL; s0 = q * 64; lob = 0; hib = CTXL; Lseq = CTXL; }
}
__device__ __forceinline__ void pool_item(ArgP A, int it, LAS unsigned char* lds, const int tid) {
    unsigned char* ws = A->ws;
    int rowbase, s0, lob, hib, Lseq; seg_decode(it, rowbase, s0, lob, hib, Lseq);
    const bf16_t* Z = (const bf16_t*)(ws + WS_Z);
    LAS float* tile = (LAS float*)lds;
    { const int rr = tid >> 5, c8 = (tid & 31) * 8;
#pragma unroll
      for (int ps = 0; ps < 5; ++ps) { const int jr = ps * 16 + rr, tok = s0 - 8 + jr;
          if (tok >= lob && tok < hib) { float z[8]; unpack8(*(const u32x4*)(Z + (size_t)(rowbase + tok) * ZN + Z_POOL + c8), z);
              *(LAS f32x4*)(tile + jr * 256 + c8) = (f32x4){z[0], z[1], z[2], z[3]}; *(LAS f32x4*)(tile + jr * 256 + c8 + 4) = (f32x4){z[4], z[5], z[6], z[7]}; } } }
    __syncthreads();
    const int chn = tid & 255, half = tid >> 8, w2 = 1 << (chn >> 6);
    bf16_t* Y = (bf16_t*)(ws + WS_Y);
    for (int t = half * 32; t < half * 32 + 32; ++t) { const int tok = s0 + t; const int lo = max(tok - w2, lob), hi = min(tok + w2, hib);
        float s = 0.f; for (int j = lo; j < hi; ++j) s += tile[(j - s0 + 8) * 256 + chn];
        const float pv = s / (float)(hi - lo) - tile[(t + 8) * 256 + chn];
        Y[(size_t)(rowbase + tok) * YN + Y_POOL + chn] = (bf16_t)(cvt_pk_bf16(pv, 0.f) & 0xffffu); }
}
__device__ __forceinline__ void sconv_item(ArgP A, int l, int it, const int tid) {
    unsigned char* ws = A->ws;
    int rowbase, s0, lob, hib, Lseq; seg_decode(it, rowbase, s0, lob, hib, Lseq);
    const bf16_t* Z = (const bf16_t*)(ws + WS_Z);
    const int c8 = (tid & 31) * 8, tr = tid >> 5;
    const float* sw = A->in[I_SCW] + (size_t)l * 3 * 256 + c8;
#pragma unroll
    for (int ps = 0; ps < 4; ++ps) { const int tok = s0 + ps * 16 + tr; float acc[8];
#pragma unroll
        for (int e = 0; e < 8; ++e) acc[e] = 0.f;
#pragma unroll
        for (int dt = -1; dt <= 1; ++dt) { const int tt = tok + dt;
            if (tt >= 0 && tt < Lseq) { float gc[8], hs[8]; const bf16_t* zr = Z + (size_t)(rowbase + tt) * ZN + Z_SC + c8; unpack8(*(const u32x4*)(zr + 256), gc); unpack8(*(const u32x4*)(zr + 512), hs);
                const f32x4 w0 = *(const f32x4*)(sw + (dt + 1) * 256), w1 = *(const f32x4*)(sw + (dt + 1) * 256 + 4);
#pragma unroll
                for (int e = 0; e < 4; ++e) { acc[e] += gc[e] * hs[e] * w0[e]; acc[4 + e] += gc[4 + e] * hs[4 + e] * w1[e]; } } }
        float gb[8]; unpack8(*(const u32x4*)(Z + (size_t)(rowbase + tok) * ZN + Z_SC + c8), gb);
#pragma unroll
        for (int e = 0; e < 8; ++e) acc[e] *= gb[e];
        *(u32x4*)((bf16_t*)(ws + WS_Y) + (size_t)(rowbase + tok) * YN + Y_SC + c8) = pack8(acc); }
}

__device__ __forceinline__ int fetch_item(unsigned* ctr, LAS unsigned char* lds, const int tid) {
    LAS unsigned* slot = (LAS unsigned*)(lds + QSLOT_OFF);
    __syncthreads();
    if (tid == 0) *slot = atomicAdd(ctr, 1u);
    __syncthreads();
    return (int)*slot;
}

template <bool COOP>
__global__ void __launch_bounds__(512, 2) fwd_kernel(Args Aparam) {
    extern __shared__ __attribute__((aligned(16))) unsigned char lds_raw[];
    LAS unsigned char* lds = (LAS unsigned char*)lds_raw;
    const int G = gridDim.x;
    ArgP A = (ArgP)__builtin_amdgcn_kernarg_segment_ptr();
    const int ph_lo = A->ph_lo, ph_hi = A->ph_hi;
    for (int ph = ph_lo; ph < ph_hi; ++ph) {
        asm volatile("" : "+s"(A));
        int tid = threadIdx.x; asm volatile("" : "+v"(tid));
        unsigned* ctl = (unsigned*)(A->ws + WS_CTL);
        if (ph == 0) p0_prologue(A, lds, G, tid);
        else if (ph == NPHASE - 1) final_norm(A, G, tid);
        else {
            const int q = ph - 1, k = q % 9, lc = q / 9, l = lc >> 1, ch = lc & 1;
            if (k == 0 || k == 6) norm_phase(A, l, ch, k == 6, G, tid);
            else if (k == 3) {
                const int total = (l == 0) ? NB * NSC * 8 : NB * 32 * 8;
                for (;;) { const int it = fetch_item(ctl + 64 * ph, lds, tid); if (it >= total) break; lru_item(A, l, it, true, lds, tid); }
            } else {
                Sched S; S.kind = k; S.l = l; S.ch = ch; S.G = G; S.c = (int)blockIdx.x; S.ap = A;
                pg8::Gemm g; g.lda = (k == 2 || k == 8) ? 4096 : (k == 4 ? YN : DM); g.ldb = g.lda;
                if (k == 1 || k == 2 || k == 7) { pg8::EpiBf E; E.act = (k == 7) ? 1 : 0; pg8::gemm_phase<pg8::EpiBf, Sched>(lds, g, S, E, tid); }
                else if (k == 4) { pg8::EpiMerge E; pg8::gemm_phase<pg8::EpiMerge, Sched>(lds, g, S, E, tid); }
                else { pg8::EpiRes E; pg8::gemm_phase<pg8::EpiRes, Sched>(lds, g, S, E, tid); }
                if (k == 2) {
                    const int nseg = (l == 0) ? 576 : 512, n1 = NB * NSC * 8, total = n1 + 2 * nseg;
                    for (;;) { const int it = fetch_item(ctl + 64 * ph, lds, tid); if (it >= total) break;
                        if (it < n1) lru_item(A, l, it, false, lds, tid);
                        else if (it < n1 + nseg) pool_item(A, it - n1, lds, tid);
                        else sconv_item(A, l, it - n1 - nseg, tid); }
                }
            }
        }
        if (ph + 1 < ph_hi) { if constexpr (COOP) { cg::this_grid().sync(); } }
    }
}

extern "C" void kernel_launch(void* const* d_in, const int* in_sizes, int n_in, void* d_out, int out_size, void* d_ws, size_t ws_size, hipStream_t stream) {
    static int grid = 0;
    if (grid == 0) {
        if (n_in != 27 || out_size != NBATCH * SEQ * DM || ws_size < WS_END) { fprintf(stderr, "kernel_launch: unexpected shapes (n_in %d out %d ws %zu)\n", n_in, out_size, ws_size); grid = -1; return; }
        int dev = 0, cus = 0, per_cu = 0;
        hipGetDevice(&dev); hipDeviceGetAttribute(&cus, hipDeviceAttributeMultiprocessorCount, dev);
        hipFuncSetAttribute((const void*)fwd_kernel<true>, hipFuncAttributeMaxDynamicSharedMemorySize, LDS_BYTES);
        hipFuncSetAttribute((const void*)fwd_kernel<false>, hipFuncAttributeMaxDynamicSharedMemorySize, LDS_BYTES);
        hipOccupancyMaxActiveBlocksPerMultiprocessor(&per_cu, (const void*)fwd_kernel<true>, 512, LDS_BYTES);
        (void)hipGetLastError();
        if (per_cu < 1) per_cu = 1;
        grid = cus * 1;
        if (grid <= 0) grid = 256;
    }
    if (grid < 0) return;
    hipMemsetAsync((char*)d_ws + WS_CTL, 0, CTL_ZERO_BYTES, stream);
    Args a{};
    for (int i = 0; i < 27; ++i) a.in[i] = (const float*)d_in[i];
    a.out = (float*)d_out; a.ws = (unsigned char*)d_ws;
#if MK_COOP
    a.ph_lo = 0; a.ph_hi = NPHASE;
    void* args[] = {&a};
    hipError_t e = hipLaunchCooperativeKernel((const void*)fwd_kernel<true>, dim3(grid), dim3(512), args, LDS_BYTES, stream);
    if (e != hipSuccess) fprintf(stderr, "cooperative launch failed: %s (grid %d)\n", hipGetErrorString(e), grid);
#else
    for (int ph = 0; ph < NPHASE; ++ph) { a.ph_lo = ph; a.ph_hi = ph + 1; hipLaunchKernelGGL(fwd_kernel<false>, dim3(grid), dim3(512), LDS_BYTES, stream, a); }
#endif
}
```

```cpp
#include <hip/hip_runtime.h>
#include <hip/hip_cooperative_groups.h>
#include <cstdio>
#include <cstdint>
namespace cg = cooperative_groups;

#ifndef MK_COOP
#define MK_COOP 1
#endif

#define LAS __attribute__((address_space(3)))
typedef unsigned short bf16_t;
typedef short bf16x8 __attribute__((ext_vector_type(8)));
typedef float f32x4 __attribute__((ext_vector_type(4)));
typedef float f32x2 __attribute__((ext_vector_type(2)));
typedef unsigned u32x4 __attribute__((ext_vector_type(4)));
typedef unsigned u32x2 __attribute__((ext_vector_type(2)));

constexpr int NBATCH = 32, SEQ = 2048, CTXL = 256, DM = 1024, DEPTH = 2, DLRU = 512, NIN = 6400, DFF = 4096;
constexpr int NB = 16, NCH = 2;
constexpr int RL = NB * SEQ, RC = NB * CTXL, RT = RL + RC;
constexpr int ZN = 6144, YN = 1280;
constexpr int Z_LG = 512, Z_POOL = 1024, Z_SC = 1280, Z_GATE = 2048;
constexpr int Y_F = 512, Y_POOL = 768, Y_SC = 1024;
constexpr int NSC = 36;
constexpr size_t MiB = 1u << 20;
constexpr size_t WS_CTL = 0, CTL_ZERO_BYTES = 65536;
constexpr size_t WS_MOD = 1 * MiB, WS_WG = 3 * MiB, WS_SUMA = 4 * MiB, WS_SUMH = 7 * MiB, WS_DFTC = 10 * MiB, WS_DFT = 12 * MiB;
constexpr size_t WS_WIN = 28 * MiB, WS_WF = 52 * MiB, WS_WBR = 54 * MiB, WS_WOUT = 60 * MiB, WS_W1 = 64 * MiB, WS_W2 = 80 * MiB;
constexpr size_t WS_CTXW = 96 * MiB, WS_U = 128 * MiB, WS_MRG = 200 * MiB, WS_PT = 272 * MiB, WS_PTC = 304 * MiB, WS_Y = 336 * MiB, WS_Z = 432 * MiB;
constexpr size_t WS_END = WS_Z + (size_t)RT * ZN * 2;
static_assert(WS_END <= 1024 * MiB, "workspace map");
static_assert(WS_Y + (size_t)RT * YN * 2 <= WS_Z && WS_PTC + (size_t)NB * 256 * 4096 * 2 <= WS_Y && WS_MRG + (size_t)RT * DM * 2 <= WS_PT, "workspace map 2");
constexpr int LDS_BYTES = 147456, RING_BYTES = 131072, QSLOT_OFF = LDS_BYTES - 64;
constexpr int NPHASE = 2 + DEPTH * NCH * 9;

__device__ __forceinline__ float bf_lo(unsigned w) { return __uint_as_float(w << 16); }
__device__ __forceinline__ float bf_hi(unsigned w) { return __uint_as_float(w & 0xffff0000u); }
__device__ __forceinline__ unsigned cvt_pk_bf16(float lo, float hi) { unsigned r; asm volatile("v_cvt_pk_bf16_f32 %0, %1, %2" : "=v"(r) : "v"(lo), "v"(hi)); return r; }
__device__ __forceinline__ float sigm(float x) { return __builtin_amdgcn_rcpf(1.0f + __expf(-x)); }
__device__ __forceinline__ float wave_sum(float v) {
#pragma unroll
    for (int o = 1; o < 64; o <<= 1) v += __shfl_xor(v, o);
    return v;
}
#define LDS_WAIT() asm volatile("s_waitcnt lgkmcnt(0)" ::: "memory")

namespace pg8 {
constexpr int BM = 256, BK = 64, HALF = 128, HTB = HALF * BK * 2, STAGE_BYTES = 8 * HTB, NXCD = 8, WGM = 8;
__host__ __device__ __forceinline__ int lds_byte(int r, int c) { const int st = (r >> 4) * 2 + (c >> 5), rr = r & 15, cc = c & 31, ob = rr * 64 + cc * 2; return st * 1024 + (ob ^ (((ob >> 9) & 1) << 5)); }
__host__ __device__ __forceinline__ void stage_rc(int b, int& R, int& C) { const int st = b / 1024, sb = b % 1024, swz = sb ^ (((sb >> 9) & 1) << 5); R = (st >> 1) * 16 + swz / 64; C = (st & 1) * 32 + (swz % 64) / 2; }
__host__ __device__ __forceinline__ int perm32(int rho) { const int n = rho >> 4, i = rho & 15; return 8 * (i >> 2) + 4 * n + (i & 3); }

struct Unit { const char* a; const char* b; char* dst; const char* x0; const char* x1; int nt, seg, ldc; float scale; };
struct Gemm { int lda, ldb; };

__device__ __forceinline__ bool tile_of(long L, int nM, int nN, int& pm, int& pn) {
    const int nwg = nM * nN; if (L >= nwg) return false;
    int wgid = (int)L; { const int q = nwg / NXCD, r = nwg % NXCD, xcd = wgid % NXCD, off = wgid / NXCD; wgid = (xcd < r ? xcd * (q + 1) : r * (q + 1) + (xcd - r) * q) + off; }
    const int nig = WGM * nN, gid = wgid / nig, fm = gid * WGM, gsz = (nM - fm) < WGM ? (nM - fm) : WGM;
    pm = fm + ((wgid % nig) % gsz); pn = (wgid % nig) / gsz; return true;
}

struct EpiBf {
    static constexpr bool PERM = true;
    int act;
    __device__ __forceinline__ bool operator()(f32x4 (&acc)[2][2][4][2], const Unit& u, int wr, int wc, int fr, int fq) const {
        bf16_t* base = (bf16_t*)u.dst + (size_t)(wr * 64 + fr) * u.ldc + wc * 32 + 8 * fq;
        const float sc = u.scale;
#pragma unroll
        for (int ai = 0; ai < 2; ++ai)
#pragma unroll
            for (int m = 0; m < 4; ++m) { bf16_t* rowp = base + (size_t)(ai * HALF + m * 16) * u.ldc;
#pragma unroll
                for (int bj = 0; bj < 2; ++bj) { f32x4 v0 = acc[ai][bj][m][0], v1 = acc[ai][bj][m][1];
                    if (act == 1) {
#pragma unroll
                        for (int e = 0; e < 4; ++e) { const float a = fmaxf(v0[e], 0.f), b = fmaxf(v1[e], 0.f); v0[e] = a * a; v1[e] = b * b; } }
                    v0 = v0 * sc; v1 = v1 * sc;
                    u32x4 w; w.x = cvt_pk_bf16(v0[0], v0[1]); w.y = cvt_pk_bf16(v0[2], v0[3]); w.z = cvt_pk_bf16(v1[0], v1[1]); w.w = cvt_pk_bf16(v1[2], v1[3]);
                    *(u32x4*)(rowp + bj * HALF) = w; } }
        return true;
    }
};
struct EpiRes {
    static constexpr bool PERM = false;
    __device__ __forceinline__ bool operator()(f32x4 (&acc)[2][2][4][2], const Unit& u, int wr, int wc, int fr, int fq) const {
        const float* gv = (const float*)u.x1 + wc * 32 + 4 * fq;
        f32x4 g[2][2];
#pragma unroll
        for (int bj = 0; bj < 2; ++bj)
#pragma unroll
            for (int n = 0; n < 2; ++n) g[bj][n] = *(const f32x4*)(gv + bj * HALF + n * 16);
        const size_t o0 = (size_t)(wr * 64 + fr) * DM + wc * 32 + 4 * fq;
        const float* bs = (const float*)u.x0 + o0; float* od = (float*)u.dst + o0;
#pragma unroll
        for (int ai = 0; ai < 2; ++ai)
#pragma unroll
            for (int m = 0; m < 4; ++m) { const size_t off = (size_t)(ai * HALF + m * 16) * DM;
#pragma unroll
                for (int bj = 0; bj < 2; ++bj)
#pragma unroll
                    for (int n = 0; n < 2; ++n) { const f32x4 b = *(const f32x4*)(bs + off + bj * HALF + n * 16); *(f32x4*)(od + off + bj * HALF + n * 16) = b + g[bj][n] * acc[ai][bj][m][n]; }
                if (m & 1) asm volatile("" ::: "memory"); }
        return true;
    }
};
struct EpiMerge {
    static constexpr bool PERM = true;
    __device__ __forceinline__ void apply(const bool LAST, f32x4 (&acc)[2][2][4][2], const Unit& u, int wr, int wc, int fr, int fq) const {
        const bf16_t* g0 = (const bf16_t*)u.x0 + (size_t)(wr * 64 + fr) * ZN + wc * 32 + 8 * fq;
        bf16_t* base = (bf16_t*)u.dst + (size_t)(wr * 64 + fr) * DM + wc * 32 + 8 * fq;
        const int gboff = LAST ? 0 : DM;
#pragma unroll
        for (int am = 0; am < 4; ++am) { const int ai = am >> 1, m0 = (am & 1) * 2;
            u32x4 ga[2][2], gb[2][2];
#pragma unroll
            for (int mm = 0; mm < 2; ++mm)
#pragma unroll
                for (int bj = 0; bj < 2; ++bj) { const bf16_t* rp = g0 + (size_t)(ai * HALF + (m0 + mm) * 16) * ZN + bj * HALF; ga[mm][bj] = *(const u32x4*)rp; gb[mm][bj] = *(const u32x4*)(rp + gboff); }
#pragma unroll
            for (int mm = 0; mm < 2; ++mm)
#pragma unroll
                for (int bj = 0; bj < 2; ++bj) { const int m = m0 + mm;
                    f32x4 v0 = acc[ai][bj][m][0], v1 = acc[ai][bj][m][1];
#pragma unroll
                    for (int e = 0; e < 4; ++e) {
                        const unsigned wa = ga[mm][bj][e];
                        const float a0 = fminf(fmaxf(bf_lo(wa), -30.f), 30.f), a1 = fminf(fmaxf(bf_hi(wa), -30.f), 30.f);
                        const unsigned wb = gb[mm][bj][e]; const float b0 = fminf(fmaxf(bf_lo(wb), -30.f), 30.f), b1 = fminf(fmaxf(bf_hi(wb), -30.f), 30.f);
                        const float num0 = LAST ? 1.f : 1.f + __expf(-b0), num1 = LAST ? 1.f : 1.f + __expf(-b1);
                        const float f0 = num0 * __builtin_amdgcn_rcpf(1.f + __expf(-a0)), f1 = num1 * __builtin_amdgcn_rcpf(1.f + __expf(-a1));
                        if (e < 2) { v0[2 * e] *= f0; v0[2 * e + 1] *= f1; } else { v1[2 * (e - 2)] *= f0; v1[2 * (e - 2) + 1] *= f1; }
                    }
                    acc[ai][bj][m][0] = v0; acc[ai][bj][m][1] = v1;
                    if (LAST) { u32x4 w; w.x = cvt_pk_bf16(v0[0], v0[1]); w.y = cvt_pk_bf16(v0[2], v0[3]); w.z = cvt_pk_bf16(v1[0], v1[1]); w.w = cvt_pk_bf16(v1[2], v1[3]);
                        *(u32x4*)(base + (size_t)(ai * HALF + m * 16) * DM + bj * HALF) = w; }
                }
            asm volatile("" ::: "memory");
        }
    }
    __device__ __forceinline__ bool operator()(f32x4 (&acc)[2][2][4][2], const Unit& u, int wr, int wc, int fr, int fq) const {
        const bool last = (u.seg == 3); apply(last, acc, u, wr, wc, fr, fq); return last;
    }
};

template <class Epi, class Sched>
__device__ __forceinline__ void gemm_phase(LAS unsigned char* lds, const Gemm g, const Sched& S, const Epi& E, const int tid) {
    const int wid = __builtin_amdgcn_readfirstlane(tid >> 6), lane = tid & 63, wr = wid >> 2, wc = wid & 3, fr = lane & 15, fq = lane >> 4;
    unsigned voffA[2], voffB[2];
#pragma unroll
    for (int i = 0; i < 2; ++i) { int R, C; stage_rc(tid * 16 + i * 8192, R, C); const int Rb = Epi::PERM ? ((R & ~31) + perm32(R & 31)) : R;
        voffA[i] = (unsigned)(R * g.lda + C) * 2u; voffB[i] = (unsigned)(Rb * g.ldb + C) * 2u; }
    const size_t kstep = (size_t)(BK * 2);
    const size_t hstepA = (size_t)HALF * g.lda * 2, hstepB = (size_t)HALF * g.ldb * 2;
    const unsigned ldsw = (unsigned)wid * 1024u;
    const int aoff = lds_byte(wr * 64 + fr, fq * 8), boff = lds_byte(wc * 32 + fr, fq * 8);
#define PG8_SA(b, h) (((b) * 2 + (h)) * HTB)
#define PG8_SB(b, h) ((4 + (b) * 2 + (h)) * HTB)
#define PG8_STAGE(bufoff, gbase, voff) do { _Pragma("unroll") for (int _i = 0; _i < 2; ++_i) \
        __builtin_amdgcn_global_load_lds((const unsigned*)((const char*)(gbase) + (voff)[_i]), (LAS unsigned*)(lds + (bufoff) + ldsw + _i * 8192), 16, 0, 0); } while (0)
#define PG8_LDA(dst, b, h) do { _Pragma("unroll") for (int m = 0; m < 4; ++m) _Pragma("unroll") for (int k = 0; k < 2; ++k) dst[m][k] = *(const LAS bf16x8*)(lds + PG8_SA(b, h) + aoff + m * 2048 + k * 1024); } while (0)
#define PG8_LDB(dst, b, h) do { _Pragma("unroll") for (int n = 0; n < 2; ++n) _Pragma("unroll") for (int k = 0; k < 2; ++k) dst[n][k] = *(const LAS bf16x8*)(lds + PG8_SB(b, h) + boff + n * 2048 + k * 1024); } while (0)
#define PG8_MMA(ai, bj, At, Bt) do { __builtin_amdgcn_s_setprio(1); _Pragma("unroll") for (int m = 0; m < 4; ++m) _Pragma("unroll") for (int n = 0; n < 2; ++n) _Pragma("unroll") for (int k = 0; k < 2; ++k) \
        acc[ai][bj][m][n] = __builtin_amdgcn_mfma_f32_16x16x32_bf16(Bt[n][k], At[m][k], acc[ai][bj][m][n], 0, 0, 0); __builtin_amdgcn_s_setprio(0); } while (0)
#define PG8_WAIT_V(n) asm volatile("s_waitcnt vmcnt(" #n ")" ::: "memory")
#define PG8_WAIT_L(n) asm volatile("s_waitcnt lgkmcnt(" #n ")" ::: "memory")
#define PG8_BAR __builtin_amdgcn_s_barrier()
#define PG8_SCHED __builtin_amdgcn_sched_barrier(0)
    Unit cur, nxt; int ui = 0;
    if (!S.next(0, cur)) return;
    f32x4 acc[2][2][4][2];
#pragma unroll
    for (int a = 0; a < 2; ++a)
#pragma unroll
        for (int b = 0; b < 2; ++b)
#pragma unroll
            for (int m = 0; m < 4; ++m)
#pragma unroll
                for (int n = 0; n < 2; ++n) acc[a][b][m][n] = (f32x4){0.f, 0.f, 0.f, 0.f};
    bf16x8 At[4][2], B0[2][2], B1[2][2];
    const char* cA = cur.a; const char* cB = cur.b;
    PG8_STAGE(PG8_SB(0, 0), cB, voffB); PG8_STAGE(PG8_SB(0, 1), cB + hstepB, voffB); PG8_STAGE(PG8_SA(0, 0), cA, voffA); PG8_STAGE(PG8_SA(0, 1), cA + hstepA, voffA);
    if (wr == 1) PG8_BAR;
    PG8_WAIT_V(2); PG8_BAR;
    PG8_STAGE(PG8_SB(1, 0), cB + kstep, voffB); PG8_STAGE(PG8_SA(1, 0), cA + kstep, voffA); PG8_STAGE(PG8_SB(1, 1), cB + hstepB + kstep, voffB);
    PG8_WAIT_V(6); PG8_BAR;
    for (;;) {
        const bool has_next = S.next(ui + 1, nxt);
        const char* nA = has_next ? nxt.a : cA; const char* nB = has_next ? nxt.b : cB;
        const int nt = cur.nt;
        for (int t = 0; t < nt; t += 2) {
            const bool last = (t == nt - 2);
            const char* a1 = cA + (size_t)(t + 1) * kstep;
            const char* a2 = last ? nA : cA + (size_t)(t + 2) * kstep; const char* b2 = last ? nB : cB + (size_t)(t + 2) * kstep;
            const char* a3 = a2 + kstep; const char* b3 = b2 + kstep;
            PG8_LDB(B0, 0, 0); PG8_LDB(B1, 0, 1); PG8_SCHED; PG8_LDA(At, 0, 0); PG8_STAGE(PG8_SA(1, 1), a1 + hstepA, voffA);
            PG8_WAIT_V(8); PG8_WAIT_L(0); PG8_BAR; PG8_MMA(0, 0, At, B0); PG8_MMA(0, 1, At, B1); PG8_BAR; PG8_SCHED;
            PG8_LDA(At, 0, 1); PG8_STAGE(PG8_SB(0, 0), b2, voffB); PG8_STAGE(PG8_SB(0, 1), b2 + hstepB, voffB); PG8_STAGE(PG8_SA(0, 0), a2, voffA);
            PG8_WAIT_V(8); PG8_WAIT_L(0); PG8_BAR; PG8_MMA(1, 0, At, B0); PG8_MMA(1, 1, At, B1); PG8_BAR; PG8_SCHED;
            PG8_LDB(B0, 1, 0); PG8_LDB(B1, 1, 1); PG8_SCHED; PG8_LDA(At, 1, 0); PG8_STAGE(PG8_SA(0, 1), a2 + hstepA, voffA);
            PG8_WAIT_V(8); PG8_WAIT_L(0); PG8_BAR; PG8_MMA(0, 0, At, B0); PG8_MMA(0, 1, At, B1); PG8_BAR; PG8_SCHED;
            PG8_LDA(At, 1, 1); PG8_STAGE(PG8_SB(1, 0), b3, voffB); PG8_STAGE(PG8_SB(1, 1), b3 + hstepB, voffB); PG8_STAGE(PG8_SA(1, 0), a3, voffA);
            PG8_WAIT_V(8); PG8_WAIT_L(0); PG8_BAR; PG8_MMA(1, 0, At, B0); PG8_MMA(1, 1, At, B1); PG8_BAR; PG8_SCHED;
        }
        if (wr == 0) PG8_BAR;
        const bool zero = E(acc, cur, wr, wc, fr, fq);
        if (!has_next) break;
        if (zero) {
#pragma unroll
            for (int a = 0; a < 2; ++a)
#pragma unroll
                for (int b = 0; b < 2; ++b)
#pragma unroll
                    for (int m = 0; m < 4; ++m)
#pragma unroll
                        for (int n = 0; n < 2; ++n) acc[a][b][m][n] = (f32x4){0.f, 0.f, 0.f, 0.f};
        }
        cur = nxt; cA = nA; cB = nB; ++ui;
        if (wr == 1) PG8_BAR;
    }
    PG8_WAIT_V(0);
    PG8_BAR;
#undef PG8_SA
#undef PG8_SB
#undef PG8_STAGE
#undef PG8_LDA
#undef PG8_LDB
#undef PG8_MMA
#undef PG8_WAIT_V
#undef PG8_WAIT_L
#undef PG8_BAR
#undef PG8_SCHED
}
}

struct Args { const float* in[27]; float* out; unsigned char* ws; int ph_lo, ph_hi; };
typedef const __attribute__((address_space(4))) Args* ArgP;
enum { I_X = 0, I_C, I_CTX, I_CCTX, I_WMOD, I_BMOD, I_G1, I_G2, I_WIN, I_CONVW, I_CONVB, I_WA, I_BA, I_WX, I_BX, I_LAM, I_POOLW, I_POOLS, I_SCW,
       I_BRL, I_BRF, I_BRP, I_BRS, I_WOUT, I_FF1, I_FF2, I_GF };

struct Sched {
    int kind, l, ch, G, c;
    ArgP ap;
    __device__ __forceinline__ bool next(int i, pg8::Unit& u) const {
        unsigned char* ws = ap->ws;
        const long L = (long)i * G + c;
        const int nM = (l == 0) ? RT / 256 : RL / 256;
        u.x0 = nullptr; u.x1 = nullptr; u.seg = 0; u.scale = 1.f;
        int pm, pn;
        if (kind == 1) {
            const char* U = (const char*)(ws + WS_U);
            const int nZ = nM * 24;
            long L2 = L - nZ; bool isz = false;
            if (L < nZ) { pg8::tile_of(L, nM, 24, pm, pn); isz = true; }
            else if (l == 1) { if (L2 < 32) { pm = 128 + (int)(L2 >> 1); pn = (int)(L2 & 1); isz = true; } else L2 -= 32; }
            if (isz) {
                u.a = U + (size_t)pm * 256 * DM * 2; u.b = (const char*)(ws + WS_WIN) + ((size_t)l * ZN + (size_t)pn * 256) * DM * 2; u.nt = 16;
                u.dst = (char*)(ws + WS_Z) + ((size_t)pm * 256 * ZN + (size_t)pn * 256) * 2; u.ldc = ZN; return true;
            }
            if (L2 >= 2 * nM) return false;
            const int seg = (int)(L2 & 1), tt = (int)(L2 >> 1);
            u.a = (const char*)(ws + WS_WF) + ((size_t)l * 512 + (size_t)seg * 256) * DM * 2; u.b = U + (size_t)tt * 256 * DM * 2; u.nt = 16; u.ldc = 4096;
            if (tt < 128) u.dst = (char*)(ws + WS_PT) + ((size_t)(tt >> 3) * 256 * 4096 + (size_t)seg * 2048 + (size_t)(tt & 7) * 256) * 2;
            else u.dst = (char*)(ws + WS_PTC) + ((size_t)(tt - 128) * 256 * 4096 + (size_t)seg * 256) * 2;
            return true;
        }
        if (kind == 7) {
            if (!pg8::tile_of(L, nM, 16, pm, pn)) return false;
            u.a = (const char*)(ws + WS_U) + (size_t)pm * 256 * DM * 2; u.b = (const char*)(ws + WS_W1) + ((size_t)l * DFF + (size_t)pn * 256) * DM * 2; u.nt = 16;
            u.dst = (char*)(ws + WS_Z) + ((size_t)pm * 256 * DFF + (size_t)pn * 256) * 2; u.ldc = DFF; return true;
        }
        if (kind == 2) {
            if (L < 128) { const int b_ = (int)(L >> 3), kt = (int)(L & 7);
                u.a = (const char*)(ws + WS_DFT) + (size_t)kt * 256 * 4096 * 2; u.b = (const char*)(ws + WS_PT) + (size_t)b_ * 256 * 4096 * 2; u.nt = 64;
                u.dst = (char*)(ws + WS_Y) + ((size_t)(b_ * SEQ + kt * 256) * YN + Y_F) * 2; u.ldc = YN; u.scale = 0.001381067932004975f  ; return true; }
            if (l == 0 && L < 144) { const int j = (int)L - 128;
                u.a = (const char*)(ws + WS_DFTC); u.b = (const char*)(ws + WS_PTC) + (size_t)j * 256 * 4096 * 2; u.nt = 8;
                u.dst = (char*)(ws + WS_Y) + ((size_t)(RL + j * 256) * YN + Y_F) * 2; u.ldc = YN; u.scale = 1.f / 256.f; return true; }
            return false;
        }
        if (kind == 4) {
            const int seg = i & 3; const long T = (long)(i >> 2) * G + c;
            if (!pg8::tile_of(T, nM, 4, pm, pn)) return false;
            const int coff = seg == 0 ? 0 : (256 + 256 * seg);
            u.a = (const char*)(ws + WS_Y) + ((size_t)pm * 256 * YN + coff) * 2; u.b = (const char*)(ws + WS_WBR) + (((size_t)l * DM + (size_t)pn * 256) * YN + coff) * 2;
            u.nt = seg == 0 ? 8 : 4; u.seg = seg; u.ldc = DM;
            u.dst = (char*)(ws + WS_MRG) + ((size_t)pm * 256 * DM + (size_t)pn * 256) * 2;
            u.x0 = (const char*)(ws + WS_Z) + ((size_t)pm * 256 * ZN + Z_GATE + seg * DM + pn * 256) * 2;
            return true;
        }
        if (!pg8::tile_of(L, nM, 4, pm, pn)) return false;
        if (kind == 5) { u.a = (const char*)(ws + WS_MRG) + (size_t)pm * 256 * DM * 2; u.b = (const char*)(ws + WS_WOUT) + ((size_t)l * DM + (size_t)pn * 256) * DM * 2; u.nt = 16; }
        else { u.a = (const char*)(ws + WS_Z) + (size_t)pm * 256 * DFF * 2; u.b = (const char*)(ws + WS_W2) + ((size_t)l * DM + (size_t)pn * 256) * DFF * 2; u.nt = 64; }
        int bidx; size_t eoff;
        if (pm < 128) { eoff = ((size_t)(ch * RL + pm * 256) * DM + pn * 256) * 4; bidx = ch * NB + (pm >> 3);
            char* out = (char*)ap->out; u.dst = out + eoff; u.x0 = (kind == 5 && l == 0) ? (const char*)ap->in[I_X] + eoff : (const char*)out + eoff; }
        else { eoff = ((size_t)(ch * RC + (pm - 128) * 256) * DM + pn * 256) * 4; bidx = 32;
            u.dst = (char*)(ws + WS_CTXW) + eoff; u.x0 = (kind == 5) ? (const char*)ap->in[I_CTX] + eoff : (const char*)(ws + WS_CTXW) + eoff; }
        u.x1 = (const char*)(ws + WS_MOD) + ((size_t)((l * 33 + bidx) * 6 + (kind == 5 ? 2 : 5)) * DM + pn * 256) * 4;
        u.ldc = DM;
        return true;
    }
};

__device__ __forceinline__ void tr_item(const float* W, int ldw, int col0, int ncols, bf16_t* WT, int ldt, int koff, LAS float* scr, int item, int lane) {
    const int nblk = ncols / 32, kb = item / nblk, nb = item % nblk, k0 = 64 * kb, n0 = 32 * nb;
#pragma unroll 8
    for (int i = 0; i < 32; ++i) { const int kk = 2 * i + (lane >> 5); scr[kk * 33 + (lane & 31)] = W[(size_t)(k0 + kk) * ldw + col0 + n0 + (lane & 31)]; }
    LDS_WAIT(); asm volatile("" ::: "memory");
    const int c = lane & 7;
#pragma unroll
    for (int j = 0; j < 4; ++j) { const int n = (lane >> 3) + 8 * j; const LAS float* s = scr + (8 * c) * 33 + n;
        u32x4 o; o.x = cvt_pk_bf16(s[0 * 33], s[1 * 33]); o.y = cvt_pk_bf16(s[2 * 33], s[3 * 33]); o.z = cvt_pk_bf16(s[4 * 33], s[5 * 33]); o.w = cvt_pk_bf16(s[6 * 33], s[7 * 33]);
        *(u32x4*)(WT + (size_t)(n0 + n) * ldt + koff + k0 + 8 * c) = o; }
    LDS_WAIT(); asm volatile("" ::: "memory");
}

__device__ __forceinline__ void p0_prologue(ArgP A, LAS unsigned char* lds, int G, const int tid) {
    const int lane = tid & 63, wave = tid >> 6, bx = blockIdx.x;
    unsigned char* ws = A->ws;
    if (bx < 192) {
        const int l = bx / 96, cb = bx % 96, n = cb * 64 + lane;
        LAS float* sl = (LAS float*)lds;
        for (int idx = tid; idx < 33 * 1024; idx += 512) { const int bb = idx >> 10, k = idx & 1023; const float v = bb < 32 ? A->in[I_C][bb * 1024 + k] : A->in[I_CCTX][k]; sl[idx] = v * sigm(v); }
        __syncthreads();
        float acc[33];
#pragma unroll
        for (int bb = 0; bb < 33; ++bb) acc[bb] = 0.f;
        const float* wp = A->in[I_WMOD] + ((size_t)l * 1024 + wave * 128) * 6144 + n;
        for (int k4 = 0; k4 < 32; ++k4) {
            const float w0 = wp[(size_t)(4 * k4 + 0) * 6144], w1 = wp[(size_t)(4 * k4 + 1) * 6144], w2 = wp[(size_t)(4 * k4 + 2) * 6144], w3 = wp[(size_t)(4 * k4 + 3) * 6144];
#pragma unroll
            for (int bb = 0; bb < 33; ++bb) { const f32x4 s = *(const LAS f32x4*)(sl + bb * 1024 + wave * 128 + 4 * k4); acc[bb] += s[0] * w0 + s[1] * w1 + s[2] * w2 + s[3] * w3; }
        }
        __syncthreads();
        LAS float* red = (LAS float*)lds;
#pragma unroll
        for (int bb = 0; bb < 33; ++bb) red[(wave * 33 + bb) * 64 + lane] = acc[bb];
        __syncthreads();
        float* MOD = (float*)(ws + WS_MOD);
        for (int idx = tid; idx < 33 * 64; idx += 512) { const int bb = idx >> 6, ln = idx & 63; float s = A->in[I_BMOD][l * 6144 + cb * 64 + ln];
#pragma unroll
            for (int w = 0; w < 8; ++w) s += red[(w * 33 + bb) * 64 + ln];
            MOD[(size_t)(l * 33 + bb) * 6144 + cb * 64 + ln] = s; }
        __syncthreads();
    } else if (bx < 224) {
        const int it = bx - 192, l = it >> 4, k0 = (it & 15) * 64;
        LAS float* wt = (LAS float*)lds;
        LAS float* tab = (LAS float*)(lds + 65536);
        for (int idx = tid; idx < 64 * 256; idx += 512) { const int kk = idx >> 8, c = idx & 255; wt[idx] = A->in[I_WIN][((size_t)l * 1024 + k0 + kk) * NIN + 1024 + c]; }
        { const int i = tid & 255; tab[tid] = (tid < 256) ? cospif((float)i / 128.f) : sinpif((float)i / 128.f); }
        __syncthreads();
        const int m = tid & 255; const LAS float* tb = tab + (tid >> 8) * 256;
        bf16_t* WF = (bf16_t*)(ws + WS_WF) + ((size_t)l * 512 + tid) * DM + k0;
        for (int kg = 0; kg < 8; ++kg) {
            float a[8];
#pragma unroll
            for (int q = 0; q < 8; ++q) a[q] = 0.f;
            for (int c = 0; c < 256; ++c) { const float tv = tb[(m * c) & 255];
#pragma unroll
                for (int q = 0; q < 8; ++q) a[q] += wt[(kg * 8 + q) * 256 + c] * tv; }
            u32x4 o; o.x = cvt_pk_bf16(a[0], a[1]); o.y = cvt_pk_bf16(a[2], a[3]); o.z = cvt_pk_bf16(a[4], a[5]); o.w = cvt_pk_bf16(a[6], a[7]);
            *(u32x4*)(WF + kg * 8) = o;
        }
        __syncthreads();
    }
    {
        LAS float* scr = (LAS float*)(lds + wave * 16384);
        const int gw = wave * G + bx, NGW = G * 8;
        for (int it = gw; it < 16384; it += NGW) {
            const int l = it >> 13; int r = it & 8191;
            const float* win = A->in[I_WIN] + (size_t)l * 1024 * NIN;
            bf16_t* WIN = (bf16_t*)(ws + WS_WIN) + (size_t)l * ZN * DM;
            bf16_t* WBR = (bf16_t*)(ws + WS_WBR) + (size_t)l * DM * YN;
            if (r < 512) { tr_item(win, NIN, 0, 1024, WIN, DM, 0, scr, r, lane); continue; } r -= 512;
            if (r < 2560) { tr_item(win, NIN, 1280, 5120, WIN + (size_t)1024 * DM, DM, 0, scr, r, lane); continue; } r -= 2560;
            if (r < 256) { tr_item(A->in[I_BRL] + (size_t)l * 512 * DM, DM, 0, DM, WBR, YN, 0, scr, r, lane); continue; } r -= 256;
            if (r < 128) { tr_item(A->in[I_BRF] + (size_t)l * 256 * DM, DM, 0, DM, WBR, YN, Y_F, scr, r, lane); continue; } r -= 128;
            if (r < 128) { tr_item(A->in[I_BRS] + (size_t)l * 256 * DM, DM, 0, DM, WBR, YN, Y_SC, scr, r, lane); continue; } r -= 128;
            if (r < 512) { tr_item(A->in[I_WOUT] + (size_t)l * DM * DM, DM, 0, DM, (bf16_t*)(ws + WS_WOUT) + (size_t)l * DM * DM, DM, 0, scr, r, lane); continue; } r -= 512;
            if (r < 2048) { tr_item(A->in[I_FF1] + (size_t)l * DM * DFF, DFF, 0, DFF, (bf16_t*)(ws + WS_W1) + (size_t)l * DFF * DM, DM, 0, scr, r, lane); continue; } r -= 2048;
            tr_item(A->in[I_FF2] + (size_t)l * DFF * DM, DM, 0, DM, (bf16_t*)(ws + WS_W2) + (size_t)l * DM * DFF, DFF, 0, scr, r, lane);
        }
    }
    const int gt = bx * 512 + tid, NGT = G * 512;
    {
        bf16_t* WG = (bf16_t*)(ws + WS_WG);
        for (int idx = gt; idx < 2 * 8 * 256 * 64; idx += NGT) { const int i = idx & 63, n = (idx >> 6) & 255, h = (idx >> 14) & 7, l = idx >> 17, d = n >> 7, gate = (n >> 6) & 1, j = n & 63;
            const float v = (gate ? A->in[I_WX] : A->in[I_WA])[((size_t)((l * 2 + d) * 8 + h) * 64 + i) * 64 + j];
            WG[idx] = (bf16_t)(cvt_pk_bf16(v, 0.f) & 0xffffu); }
    }
    {
        for (int idx = gt; idx < 2 * 256 * 1024; idx += NGT) { const int n = idx & 1023, i = (idx >> 10) & 255, l = idx >> 18, g = i >> 6, il = i & 63;
            const float* pw = A->in[I_POOLW] + ((size_t)(l * 4 + g) * 64 + il) * 64; const float* ps = A->in[I_POOLS] + l * 256 + g * 64; const float* wb = A->in[I_BRP] + ((size_t)l * 256 + g * 64) * DM + n;
            float s = 0.f;
            for (int j = 0; j < 64; ++j) s += pw[j] * ps[j] * wb[(size_t)j * DM];
            ((bf16_t*)(ws + WS_WBR))[((size_t)l * DM + n) * YN + Y_POOL + i] = (bf16_t)(cvt_pk_bf16(s, 0.f) & 0xffffu); }
    }
    {
        bf16_t* DF = (bf16_t*)(ws + WS_DFT);
        for (int idx = gt; idx < 2048 * 512; idx += NGT) { const int k = idx >> 9, n8 = (idx & 511) * 8; float v[8];
#pragma unroll
            for (int e = 0; e < 8; ++e) { const int np = n8 + e; if (np < 2048) v[e] = cospif((float)((k * np) & 2047) * (1.f / 1024.f)); else v[e] = -sinpif((float)((k * (np - 2048)) & 2047) * (1.f / 1024.f)); }
            u32x4 o; o.x = cvt_pk_bf16(v[0], v[1]); o.y = cvt_pk_bf16(v[2], v[3]); o.z = cvt_pk_bf16(v[4], v[5]); o.w = cvt_pk_bf16(v[6], v[7]);
            *(u32x4*)(DF + (size_t)k * 4096 + n8) = o; }
        bf16_t* DC = (bf16_t*)(ws + WS_DFTC);
        for (int idx = gt; idx < 256 * 64; idx += NGT) { const int k = idx >> 6, n8 = (idx & 63) * 8; float v[8];
#pragma unroll
            for (int e = 0; e < 8; ++e) { const int np = n8 + e; if (np < 256) v[e] = cospif((float)((k * np) & 255) * (1.f / 128.f)); else v[e] = -sinpif((float)((k * (np - 256)) & 255) * (1.f / 128.f)); }
            u32x4 o; o.x = cvt_pk_bf16(v[0], v[1]); o.y = cvt_pk_bf16(v[2], v[3]); o.z = cvt_pk_bf16(v[4], v[5]); o.w = cvt_pk_bf16(v[6], v[7]);
            *(u32x4*)(DC + (size_t)k * 4096 + n8) = o; }
    }
}

__device__ __forceinline__ void norm_phase(ArgP A, int l, int ch, bool second, int G, const int tid) {
    const int lane = tid & 63, wave = tid >> 6;
    unsigned char* ws = A->ws;
    const int nrows = (second && l == 1) ? RL : RT;
    const float* gn = (second ? A->in[I_G2] : A->in[I_G1]) + l * DM;
    const float* MOD = (const float*)(ws + WS_MOD);
    bf16_t* U = (bf16_t*)(ws + WS_U);
    for (int r = blockIdx.x * 8 + wave; r < nrows; r += G * 8) {
        const float* src; int bidx;
        if (r < RL) { const size_t grow = (size_t)ch * RL + r; src = ((!second && l == 0) ? A->in[I_X] : (const float*)A->out) + grow * DM; bidx = ch * NB + (r >> 11); }
        else { const size_t grow = (size_t)ch * RC + (r - RL); src = ((!second && l == 0) ? A->in[I_CTX] : (const float*)(ws + WS_CTXW)) + grow * DM; bidx = 32; }
        const float* sh = MOD + (size_t)((l * 33 + bidx) * 6 + (second ? 3 : 0)) * DM; const float* sc = sh + DM;
        f32x4 v[4]; float s = 0.f;
#pragma unroll
        for (int j = 0; j < 4; ++j) { v[j] = *(const f32x4*)(src + 4 * (lane + 64 * j)); s += (v[j][0] * v[j][0] + v[j][1] * v[j][1]) + (v[j][2] * v[j][2] + v[j][3] * v[j][3]); }
        const float rstd = 1.0f / sqrtf(wave_sum(s) * (1.f / DM) + 1e-6f);
#pragma unroll
        for (int j = 0; j < 4; ++j) { const int col = 4 * (lane + 64 * j);
            const f32x4 gg = *(const f32x4*)(gn + col), s1 = *(const f32x4*)(sc + col), s0 = *(const f32x4*)(sh + col);
            const f32x4 o = (v[j] * rstd) * gg * (s1 + 1.0f) + s0;
            u32x2 w; w.x = cvt_pk_bf16(o[0], o[1]); w.y = cvt_pk_bf16(o[2], o[3]);
            *(u32x2*)(U + (size_t)r * DM + col) = w; }
    }
}
__device__ __forceinline__ void final_norm(ArgP A, int G, const int tid) {
    const int lane = tid & 63, wave = tid >> 6;
    const float* gn = A->in[I_GF];
    for (int r = blockIdx.x * 8 + wave; r < NBATCH * SEQ; r += G * 8) {
        float* p = A->out + (size_t)r * DM;
        f32x4 v[4]; float s = 0.f;
#pragma unroll
        for (int j = 0; j < 4; ++j) { v[j] = *(const f32x4*)(p + 4 * (lane + 64 * j)); s += (v[j][0] * v[j][0] + v[j][1] * v[j][1]) + (v[j][2] * v[j][2] + v[j][3] * v[j][3]); }
        const float rstd = 1.0f / sqrtf(wave_sum(s) * (1.f / DM) + 1e-6f);
#pragma unroll
        for (int j = 0; j < 4; ++j) { const int col = 4 * (lane + 64 * j); const f32x4 gg = *(const f32x4*)(gn + col); *(f32x4*)(p + col) = (v[j] * rstd) * gg; }
    }
}

__device__ __forceinline__ void unpack8(const u32x4 w, float (&f)[8]) {
#pragma unroll
    for (int e = 0; e < 4; ++e) { f[2 * e] = bf_lo(w[e]); f[2 * e + 1] = bf_hi(w[e]); }
}
__device__ __forceinline__ u32x4 pack8(const float (&f)[8]) { u32x4 o; o.x = cvt_pk_bf16(f[0], f[1]); o.y = cvt_pk_bf16(f[2], f[3]); o.z = cvt_pk_bf16(f[4], f[5]); o.w = cvt_pk_bf16(f[6], f[7]); return o; }

__device__ __forceinline__ void lru_item(ArgP A, int l, int it, bool pass2, LAS unsigned char* lds, const int tid) {
    const int lane = tid & 63, wid = tid >> 6;
    unsigned char* ws = A->ws;
    const int head = it & 7, rest = it >> 3;
    int sc, bl;
    if (!pass2 || l == 0) { sc = rest % NSC; bl = rest / NSC; } else { sc = 4 + (rest & 31); bl = rest >> 5; }
    const bool isctx = sc < 4; const int c = isctx ? sc : sc - 4, Lseq = isctx ? CTXL : SEQ, rowbase = isctx ? RL + bl * CTXL : bl * SEQ, t0 = c * 64;
    const bf16_t* Z = (const bf16_t*)(ws + WS_Z);
    LAS float* xaf = (LAS float*)lds;
    LAS bf16_t* xab = (LAS bf16_t*)(lds + 17408);
    LAS float* hbuf = (LAS float*)(lds + 32768);
    {
        const int t = tid >> 3, i8 = (tid & 7) * 8, tok = t0 + t, Cc = head * 64 + i8;
        float acc[8];
        { const f32x4 b0 = *(const f32x4*)(A->in[I_CONVB] + l * DLRU + Cc), b1 = *(const f32x4*)(A->in[I_CONVB] + l * DLRU + Cc + 4);
#pragma unroll
          for (int e = 0; e < 4; ++e) { acc[e] = b0[e]; acc[4 + e] = b1[e]; } }
#pragma unroll
        for (int k = 0; k < 4; ++k) { const int tt = tok + k - 2;
            if (tt >= 0 && tt < Lseq) { float z[8]; unpack8(*(const u32x4*)(Z + (size_t)(rowbase + tt) * ZN + Cc), z);
                const float* cw = A->in[I_CONVW] + (size_t)(l * 4 + k) * DLRU + Cc; const f32x4 c0 = *(const f32x4*)cw, c1 = *(const f32x4*)(cw + 4);
#pragma unroll
                for (int e = 0; e < 4; ++e) { acc[e] += z[e] * c0[e]; acc[4 + e] += z[4 + e] * c1[e]; } } }
        *(LAS f32x4*)(xaf + t * 68 + i8) = (f32x4){acc[0], acc[1], acc[2], acc[3]}; *(LAS f32x4*)(xaf + t * 68 + i8 + 4) = (f32x4){acc[4], acc[5], acc[6], acc[7]};
        *(LAS u32x4*)(xab + t * 72 + i8) = pack8(acc);
    }
    __syncthreads();
    {
        const int d = wid >> 2, g = wid & 3, fr = lane & 15, fq = lane >> 4;
        const bf16_t* wb = (const bf16_t*)(ws + WS_WG) + ((size_t)((l * 8 + head) * 256 + d * 128 + 16 * g + fr)) * 64 + 8 * fq;
        bf16x8 wR[2], wG[2];
#pragma unroll
        for (int ks = 0; ks < 2; ++ks) { wR[ks] = *(const bf16x8*)(wb + 32 * ks); wG[ks] = *(const bf16x8*)(wb + 64 * 64 + 32 * ks); }
        const int cb = head * 64 + 16 * g + 4 * fq;
        const f32x4 ba = *(const f32x4*)(A->in[I_BA] + (l * 2 + d) * DLRU + cb), bxv = *(const f32x4*)(A->in[I_BX] + (l * 2 + d) * DLRU + cb), lam = *(const f32x4*)(A->in[I_LAM] + (l * 2 + d) * DLRU + cb);
        f32x4 sp8;
#pragma unroll
        for (int e = 0; e < 4; ++e) sp8[e] = 8.0f * log1pf(__expf(-lam[e]));
        const int p = (d == 0) ? sc : (isctx ? 3 - c : 4 + 31 - c);
        float* SA = (float*)(ws + WS_SUMA) + ((size_t)(bl * 2 + d) * NSC) * DLRU + cb; float* SH = (float*)(ws + WS_SUMH) + ((size_t)(bl * 2 + d) * NSC) * DLRU + cb;
        f32x4 hin = (f32x4){0.f, 0.f, 0.f, 0.f}, Atot = (f32x4){1.f, 1.f, 1.f, 1.f}, Htot = (f32x4){0.f, 0.f, 0.f, 0.f};
        if (pass2) for (int pp = 0; pp < p; ++pp) { const f32x4 a4 = *(const f32x4*)(SA + (size_t)pp * DLRU), h4 = *(const f32x4*)(SH + (size_t)pp * DLRU); hin = a4 * hin + h4; }
        const int lastl = (lane & 48) | (d ? 0 : 15);
#pragma unroll
        for (int q = 0; q < 4; ++q) { const int tt = d ? 3 - q : q;
            f32x4 aR = (f32x4){0.f, 0.f, 0.f, 0.f}, aG = (f32x4){0.f, 0.f, 0.f, 0.f};
#pragma unroll
            for (int ks = 0; ks < 2; ++ks) { const bf16x8 bfrag = *(const LAS bf16x8*)(xab + (16 * tt + fr) * 72 + 8 * fq + 32 * ks);
                aR = __builtin_amdgcn_mfma_f32_16x16x32_bf16(wR[ks], bfrag, aR, 0, 0, 0); aG = __builtin_amdgcn_mfma_f32_16x16x32_bf16(wG[ks], bfrag, aG, 0, 0, 0); }
            const f32x4 xv = *(const LAS f32x4*)(xaf + (16 * tt + fr) * 68 + 16 * g + 4 * fq);
            f32x4 hv;
#pragma unroll
            for (int e = 0; e < 4; ++e) {
                const float r = sigm(aR[e] + ba[e]), gi = sigm(aG[e] + bxv[e]);
                const float la = -r * sp8[e], a = __expf(la), x2 = -2.0f * la;
                const float om = x2 < 0.1f ? x2 * (1.0f - x2 * (0.5f - x2 * (0.16666667f - x2 * 0.041666668f))) : 1.0f - a * a;
                float Av = a, Bv = sqrtf(om) * gi * xv[e];
#pragma unroll
                for (int off = 1; off < 16; off <<= 1) { const int src = d ? lane + off : lane - off; const float Ap = __shfl(Av, src), Bp = __shfl(Bv, src);
                    const bool valid = d ? (fr + off < 16) : (fr >= off); if (valid) { Bv = Av * Bp + Bv; Av = Av * Ap; } }
                if (pass2) { const float h = Av * hin[e] + Bv; hv[e] = h; hin[e] = __shfl(h, lastl); }
                else { const float AT = __shfl(Av, lastl), BT = __shfl(Bv, lastl); Htot[e] = AT * Htot[e] + BT; Atot[e] = Atot[e] * AT; }
            }
            if (pass2) *(LAS f32x4*)(hbuf + ((d * 64 + 16 * tt + fr) * 68 + 16 * g + 4 * fq)) = hv;
        }
        if (!pass2 && fr == 0) { *(f32x4*)(SA + (size_t)p * DLRU) = Atot; *(f32x4*)(SH + (size_t)p * DLRU) = Htot; }
    }
    if (pass2) {
        __syncthreads();
        const int t = tid >> 3, i8 = (tid & 7) * 8, tok = t0 + t, Cc = head * 64 + i8;
        float zg[8]; unpack8(*(const u32x4*)(Z + (size_t)(rowbase + tok) * ZN + Z_LG + Cc), zg);
        const f32x4 h00 = *(const LAS f32x4*)(hbuf + t * 68 + i8), h01 = *(const LAS f32x4*)(hbuf + t * 68 + i8 + 4), h10 = *(const LAS f32x4*)(hbuf + (64 + t) * 68 + i8), h11 = *(const LAS f32x4*)(hbuf + (64 + t) * 68 + i8 + 4);
        float y[8];
#pragma unroll
        for (int e = 0; e < 8; ++e) { const float hs = e < 4 ? h00[e & 3] + h10[e & 3] : h01[e & 3] + h11[e & 3]; const float x = zg[e];
            const float u2 = 1.5957691216057308f * (x + 0.044715f * x * x * x);
            y[e] = hs * x * sigm(u2); }
        *(u32x4*)((bf16_t*)(ws + WS_Y) + (size_t)(rowbase + tok) * YN + Cc) = pack8(y);
    }
}

__device__ __forceinline__ void seg_decode(int it, int& rowbase, int& s0, int& lob, int& hib, int& Lseq) {
    if (it < 512) { const int bl = it >> 5, sg = it & 31; rowbase = bl * SEQ; s0 = sg * 64; lob = s0; hib = s0 + 64; Lseq = SEQ; }
    else { const int j = it - 512, bl = j >> 2, q = j & 3; rowbase = RL + bl * CTXL; s0 = q * 64; lob = 0; hib = CTXL; Lseq = CTXL; }
}
__device__ __forceinline__ void pool_item(ArgP A, int it, LAS unsigned char* lds, const int tid) {
    unsigned char* ws = A->ws;
    int rowbase, s0, lob, hib, Lseq; seg_decode(it, rowbase, s0, lob, hib, Lseq);
    const bf16_t* Z = (const bf16_t*)(ws + WS_Z);
    LAS float* tile = (LAS float*)lds;
    { const int rr = tid >> 5, c8 = (tid & 31) * 8;
#pragma unroll
      for (int ps = 0; ps < 5; ++ps) { const int jr = ps * 16 + rr, tok = s0 - 8 + jr;
          if (tok >= lob && tok < hib) { float z[8]; unpack8(*(const u32x4*)(Z + (size_t)(rowbase + tok) * ZN + Z_POOL + c8), z);
              *(LAS f32x4*)(tile + jr * 256 + c8) = (f32x4){z[0], z[1], z[2], z[3]}; *(LAS f32x4*)(tile + jr * 256 + c8 + 4) = (f32x4){z[4], z[5], z[6], z[7]}; } } }
    __syncthreads();
    const int chn = tid & 255, half = tid >> 8, w2 = 1 << (chn >> 6);
    bf16_t* Y = (bf16_t*)(ws + WS_Y);
    for (int t = half * 32; t < half * 32 + 32; ++t) { const int tok = s0 + t; const int lo = max(tok - w2, lob), hi = min(tok + w2, hib);
        float s = 0.f; for (int j = lo; j < hi; ++j) s += tile[(j - s0 + 8) * 256 + chn];
        const float pv = s / (float)(hi - lo) - tile[(t + 8) * 256 + chn];
        Y[(size_t)(rowbase + tok) * YN + Y_POOL + chn] = (bf16_t)(cvt_pk_bf16(pv, 0.f) & 0xffffu); }
}
__device__ __forceinline__ void sconv_item(ArgP A, int l, int it, const int tid) {
    unsigned char* ws = A->ws;
    int rowbase, s0, lob, hib, Lseq; seg_decode(it, rowbase, s0, lob, hib, Lseq);
    const bf16_t* Z = (const bf16_t*)(ws + WS_Z);
    const int c8 = (tid & 31) * 8, tr = tid >> 5;
    const float* sw = A->in[I_SCW] + (size_t)l * 3 * 256 + c8;
#pragma unroll
    for (int ps = 0; ps < 4; ++ps) { const int tok = s0 + ps * 16 + tr; float acc[8];
#pragma unroll
        for (int e = 0; e < 8; ++e) acc[e] = 0.f;
#pragma unroll
        for (int dt = -1; dt <= 1; ++dt) { const int tt = tok + dt;
            if (tt >= 0 && tt < Lseq) { float gc[8], hs[8]; const bf16_t* zr = Z + (size_t)(rowbase + tt) * ZN + Z_SC + c8; unpack8(*(const u32x4*)(zr + 256), gc); unpack8(*(const u32x4*)(zr + 512), hs);
                const f32x4 w0 = *(const f32x4*)(sw + (dt + 1) * 256), w1 = *(const f32x4*)(sw + (dt + 1) * 256 + 4);
#pragma unroll
                for (int e = 0; e < 4; ++e) { acc[e] += gc[e] * hs[e] * w0[e]; acc[4 + e] += gc[4 + e] * hs[4 + e] * w1[e]; } } }
        float gb[8]; unpack8(*(const u32x4*)(Z + (size_t)(rowbase + tok) * ZN + Z_SC + c8), gb);
#pragma unroll
        for (int e = 0; e < 8; ++e) acc[e] *= gb[e];
        *(u32x4*)((bf16_t*)(ws + WS_Y) + (size_t)(rowbase + tok) * YN + Y_SC + c8) = pack8(acc); }
}

__device__ __forceinline__ int fetch_item(unsigned* ctr, LAS unsigned char* lds, const int tid) {
    LAS unsigned* slot = (LAS unsigned*)(lds + QSLOT_OFF);
    __syncthreads();
    if (tid == 0) *slot = atomicAdd(ctr, 1u);
    __syncthreads();
    return (int)*slot;
}


#define XB_TMO      128
#define XB_XCNT(j)  (256  + 64 * (j))
#define XB_XSUB(j)  (1280 + 64 * (j))
#define XB_XGEN(j)  (2304 + 64 * (j))
#define XB_TOP      3328
#define XB_TOPGEN   3392
#define XCD_BAR_WORDS 3456
#define XB_SPIN_CAP (1u << 22)
__device__ __forceinline__ unsigned xb_ld(unsigned* p)              { return __hip_atomic_load(p, __ATOMIC_RELAXED, __HIP_MEMORY_SCOPE_AGENT); }
__device__ __forceinline__ unsigned xb_add(unsigned* p, unsigned v) { return __hip_atomic_fetch_add(p, v, __ATOMIC_RELAXED, __HIP_MEMORY_SCOPE_AGENT); }
__device__ __forceinline__ unsigned xb_xcc_id() { return (unsigned)__builtin_amdgcn_s_getreg((3 << 11) | 20) & 0xFu; }
#define XB_SPIN(cond, bar) do { unsigned _sp = 0; while (cond) { __builtin_amdgcn_s_sleep(1); \
    if ((++_sp & 255u) == 0u) { if (xb_ld(&(bar)[XB_TMO])) break; if (_sp > XB_SPIN_CAP) { atomicAdd(&(bar)[XB_TMO], 1u); break; } } } } while (0)
struct XcdBarrier { unsigned* bar; unsigned x; volatile LAS unsigned* st; };
__device__ __forceinline__ XcdBarrier xcd_barrier_post(unsigned* bar, volatile LAS unsigned* st) {
    XcdBarrier b; b.bar = bar; b.x = xb_xcc_id(); b.st = st;
    if (threadIdx.x == 0) (void)xb_add(&bar[XB_XCNT(b.x)], 1u);
    return b;
}
__device__ __forceinline__ void xcd_barrier_complete(unsigned* bar, unsigned x, unsigned& nloc, unsigned& nx) {
    const unsigned G = gridDim.x * gridDim.y * gridDim.z;
    unsigned sum, cnt, mine, sp = 0u;
    for (;;) {
        sum = 0u; cnt = 0u; mine = 0u;
#pragma unroll
        for (unsigned j = 0; j < 16; ++j) { const unsigned c = xb_ld(&bar[XB_XCNT(j)]); sum += c; cnt += (c > 0u) ? 1u : 0u; mine = (j == x) ? c : mine; }
        if (sum == G) break;
        __builtin_amdgcn_s_sleep(1);
        if ((++sp & 255u) == 0u) { if (xb_ld(&bar[XB_TMO])) break; if (sp > XB_SPIN_CAP) { atomicAdd(&bar[XB_TMO], 1u); break; } }
    }
    nloc = mine > 0u ? mine : 1u; nx = cnt > 0u ? cnt : 1u;
}
__device__ __forceinline__ void xcd_barrier(const XcdBarrier& b) {
    asm volatile("s_waitcnt vmcnt(0)" ::: "memory");
    __syncthreads();
    if (threadIdx.x == 0) {
        unsigned* bar = b.bar;
        __builtin_amdgcn_s_waitcnt(0);
        unsigned nloc = b.st[0], nx = b.st[1];
        if (nloc == 0u) { xcd_barrier_complete(bar, b.x, nloc, nx); b.st[0] = nloc; b.st[1] = nx; }
        const unsigned old = xb_add(&bar[XB_XSUB(b.x)], 1u);
        const unsigned gen = old / nloc;
        if (old + 1u == (gen + 1u) * nloc) {
            __builtin_amdgcn_fence(__ATOMIC_RELEASE, "agent");
            asm volatile("s_waitcnt vmcnt(0)" ::: "memory");
            const unsigned og = xb_add(&bar[XB_TOP], 1u);
            const unsigned tg = og / nx;
            if (og + 1u == (tg + 1u) * nx) xb_add(&bar[XB_TOPGEN], 1u);
            else XB_SPIN(xb_ld(&bar[XB_TOPGEN]) == tg, bar);
            __builtin_amdgcn_fence(__ATOMIC_ACQUIRE, "agent");
            xb_add(&bar[XB_XGEN(b.x)], 1u);
            asm volatile("s_waitcnt vmcnt(0)" ::: "memory");
        } else {
            XB_SPIN(xb_ld(&bar[XB_XGEN(b.x)]) == gen, bar);
            __builtin_amdgcn_fence(__ATOMIC_ACQUIRE, "agent");
            asm volatile("s_waitcnt vmcnt(0)" ::: "memory");
        }
    }
    __syncthreads();
}

template <bool COOP>
__global__ void __launch_bounds__(512, 2) fwd_kernel(Args Aparam) {
    extern __shared__ __attribute__((aligned(16))) unsigned char lds_raw[];
    LAS unsigned char* lds = (LAS unsigned char*)lds_raw;
    const int G = gridDim.x;
    ArgP A = (ArgP)__builtin_amdgcn_kernarg_segment_ptr();
    const int ph_lo = A->ph_lo, ph_hi = A->ph_hi;
    XcdBarrier xbar; xbar.bar = nullptr; xbar.x = 0; xbar.st = (volatile LAS unsigned*)(lds + QSLOT_OFF + 16);
    if constexpr (COOP) {
        if (threadIdx.x < 2) xbar.st[threadIdx.x] = 0u;
        __syncthreads();
        xbar = xcd_barrier_post((unsigned*)(A->ws + WS_CTL) + 8192, xbar.st);
    }
    for (int ph = ph_lo; ph < ph_hi; ++ph) {
        asm volatile("" : "+s"(A));
        int tid = threadIdx.x; asm volatile("" : "+v"(tid));
        unsigned* ctl = (unsigned*)(A->ws + WS_CTL);
        if (ph == 0) p0_prologue(A, lds, G, tid);
        else if (ph == NPHASE - 1) final_norm(A, G, tid);
        else {
            const int q = ph - 1, k = q % 9, lc = q / 9, l = lc >> 1, ch = lc & 1;
            if (k == 0 || k == 6) norm_phase(A, l, ch, k == 6, G, tid);
            else if (k == 3) {
                const int total = (l == 0) ? NB * NSC * 8 : NB * 32 * 8;
                for (;;) { const int it = fetch_item(ctl + 64 * ph, lds, tid); if (it >= total) break; lru_item(A, l, it, true, lds, tid); }
            } else {
                Sched S; S.kind = k; S.l = l; S.ch = ch; S.G = G; S.c = (int)blockIdx.x; S.ap = A;
                pg8::Gemm g; g.lda = (k == 2 || k == 8) ? 4096 : (k == 4 ? YN : DM); g.ldb = g.lda;
                if (k == 1 || k == 2 || k == 7) { pg8::EpiBf E; E.act = (k == 7) ? 1 : 0; pg8::gemm_phase<pg8::EpiBf, Sched>(lds, g, S, E, tid); }
                else if (k == 4) { pg8::EpiMerge E; pg8::gemm_phase<pg8::EpiMerge, Sched>(lds, g, S, E, tid); }
                else { pg8::EpiRes E; pg8::gemm_phase<pg8::EpiRes, Sched>(lds, g, S, E, tid); }
                if (k == 2) {
                    const int nseg = (l == 0) ? 576 : 512, n1 = NB * NSC * 8, total = n1 + 2 * nseg;
                    for (;;) { const int it = fetch_item(ctl + 64 * ph, lds, tid); if (it >= total) break;
                        if (it < n1) lru_item(A, l, it, false, lds, tid);
                        else if (it < n1 + nseg) pool_item(A, it - n1, lds, tid);
                        else sconv_item(A, l, it - n1 - nseg, tid); }
                }
            }
        }
        if (ph + 1 < ph_hi) { if constexpr (COOP) { if (ph == 0) cg::this_grid().sync(); else xcd_barrier(xbar); } }
    }
}

extern "C" void kernel_launch(void* const* d_in, const int* in_sizes, int n_in, void* d_out, int out_size, void* d_ws, size_t ws_size, hipStream_t stream) {
    static int grid = 0;
    if (grid == 0) {
        if (n_in != 27 || out_size != NBATCH * SEQ * DM || ws_size < WS_END) { fprintf(stderr, "kernel_launch: unexpected shapes (n_in %d out %d ws %zu)\n", n_in, out_size, ws_size); grid = -1; return; }
        int dev = 0, cus = 0, per_cu = 0;
        hipGetDevice(&dev); hipDeviceGetAttribute(&cus, hipDeviceAttributeMultiprocessorCount, dev);
        hipFuncSetAttribute((const void*)fwd_kernel<true>, hipFuncAttributeMaxDynamicSharedMemorySize, LDS_BYTES);
        hipFuncSetAttribute((const void*)fwd_kernel<false>, hipFuncAttributeMaxDynamicSharedMemorySize, LDS_BYTES);
        hipOccupancyMaxActiveBlocksPerMultiprocessor(&per_cu, (const void*)fwd_kernel<true>, 512, LDS_BYTES);
        (void)hipGetLastError();
        if (per_cu < 1) per_cu = 1;
        grid = cus * 1;
        if (grid <= 0) grid = 256;
    }
    if (grid < 0) return;
    hipMemsetAsync((char*)d_ws + WS_CTL, 0, CTL_ZERO_BYTES, stream);
    Args a{};
    for (int i = 0; i < 27; ++i) a.in[i] = (const float*)d_in[i];
    a.out = (float*)d_out; a.ws = (unsigned char*)d_ws;
#if MK_COOP
    a.ph_lo = 0; a.ph_hi = NPHASE;
    void* args[] = {&a};
    hipError_t e = hipLaunchCooperativeKernel((const void*)fwd_kernel<true>, dim3(grid), dim3(512), args, LDS_BYTES, stream);
    if (e != hipSuccess) fprintf(stderr, "cooperative launch failed: %s (grid %d)\n", hipGetErrorString(e), grid);
#else
    for (int ph = 0; ph < NPHASE; ++ph) { a.ph_lo = ph; a.ph_hi = ph + 1; hipLaunchKernelGGL(fwd_kernel<false>, dim3(grid), dim3(512), LDS_BYTES, stream, a); }
#endif
}
```

```cpp
#include <hip/hip_runtime.h>
#include <hip/hip_cooperative_groups.h>
#include <cstdio>
#include <cstdint>
namespace cg = cooperative_groups;

#ifndef MK_COOP
#define MK_COOP 1
#endif
#define PROBE_K -1

#define LAS __attribute__((address_space(3)))
typedef unsigned short bf16_t;
typedef short bf16x8 __attribute__((ext_vector_type(8)));
typedef float f32x4 __attribute__((ext_vector_type(4)));
typedef float f32x2 __attribute__((ext_vector_type(2)));
typedef unsigned u32x4 __attribute__((ext_vector_type(4)));
typedef unsigned u32x2 __attribute__((ext_vector_type(2)));

constexpr int NBATCH = 32, SEQ = 2048, CTXL = 256, DM = 1024, DEPTH = 2, DLRU = 512, NIN = 6400, DFF = 4096;
constexpr int NB = 16, NCH = 2;
constexpr int RL = NB * SEQ, RC = NB * CTXL, RT = RL + RC;
constexpr int ZN = 6144, YN = 1280;
constexpr int Z_LG = 512, Z_POOL = 1024, Z_SC = 1280, Z_GATE = 2048;
constexpr int Y_F = 512, Y_POOL = 768, Y_SC = 1024;
constexpr int NSC = 36;
constexpr size_t MiB = 1u << 20;
constexpr size_t WS_CTL = 0, CTL_ZERO_BYTES = 65536;
constexpr size_t WS_MOD = 1 * MiB, WS_WG = 3 * MiB, WS_SUMA = 4 * MiB, WS_SUMH = 7 * MiB, WS_DFTC = 10 * MiB, WS_DFT = 12 * MiB;
constexpr size_t WS_WIN = 28 * MiB, WS_WF = 52 * MiB, WS_WBR = 54 * MiB, WS_WOUT = 60 * MiB, WS_W1 = 64 * MiB, WS_W2 = 80 * MiB;
constexpr size_t WS_CTXW = 96 * MiB, WS_U = 128 * MiB, WS_MRG = 200 * MiB, WS_PT = 272 * MiB, WS_PTC = 304 * MiB, WS_Y = 336 * MiB, WS_Z = 432 * MiB;
constexpr size_t WS_HF = WS_Z + (size_t)RT * ZN * 2, WS_HB = WS_HF + (size_t)RT * DLRU * 4;
constexpr size_t WS_END = WS_HB + (size_t)RT * DLRU * 4;
static_assert(WS_END <= 1024 * MiB, "workspace map");
static_assert(WS_Y + (size_t)RT * YN * 2 <= WS_Z && WS_PTC + (size_t)NB * 256 * 4096 * 2 <= WS_Y && WS_MRG + (size_t)RT * DM * 2 <= WS_PT, "workspace map 2");
constexpr int LDS_BYTES = 147456, RING_BYTES = 131072, QSLOT_OFF = LDS_BYTES - 64;
constexpr int PH_PER = 8 + ((PROBE_K >= 0 && PROBE_K <= 8) ? 1 : 0), PH_BASE = (PROBE_K == 9) ? 2 : 1;
constexpr int NPHASE = PH_BASE + 1 + DEPTH * NCH * PH_PER;

__device__ __forceinline__ float bf_lo(unsigned w) { return __uint_as_float(w << 16); }
__device__ __forceinline__ float bf_hi(unsigned w) { return __uint_as_float(w & 0xffff0000u); }
__device__ __forceinline__ unsigned cvt_pk_bf16(float lo, float hi) { unsigned r; asm volatile("v_cvt_pk_bf16_f32 %0, %1, %2" : "=v"(r) : "v"(lo), "v"(hi)); return r; }
__device__ __forceinline__ float sigm(float x) { return __builtin_amdgcn_rcpf(1.0f + __expf(-x)); }
__device__ __forceinline__ float wave_sum(float v) {
#pragma unroll
    for (int o = 1; o < 64; o <<= 1) v += __shfl_xor(v, o);
    return v;
}
#define LDS_WAIT() asm volatile("s_waitcnt lgkmcnt(0)" ::: "memory")

namespace pg8 {
constexpr int BM = 256, BK = 64, HALF = 128, HTB = HALF * BK * 2, STAGE_BYTES = 8 * HTB, NXCD = 8, WGM = 8;
__host__ __device__ __forceinline__ int lds_byte(int r, int c) { const int st = (r >> 4) * 2 + (c >> 5), rr = r & 15, cc = c & 31, ob = rr * 64 + cc * 2; return st * 1024 + (ob ^ (((ob >> 9) & 1) << 5)); }
__host__ __device__ __forceinline__ void stage_rc(int b, int& R, int& C) { const int st = b / 1024, sb = b % 1024, swz = sb ^ (((sb >> 9) & 1) << 5); R = (st >> 1) * 16 + swz / 64; C = (st & 1) * 32 + (swz % 64) / 2; }
__host__ __device__ __forceinline__ int perm32(int rho) { const int n = rho >> 4, i = rho & 15; return 8 * (i >> 2) + 4 * n + (i & 3); }

struct Unit { const char* a; const char* b; char* dst; const char* x0; const char* x1; int nt, seg, ldc; float scale; };
struct Gemm { int lda, ldb; };

__device__ __forceinline__ bool tile_of(long L, int nM, int nN, int& pm, int& pn) {
    const int nwg = nM * nN; if (L >= nwg) return false;
    int wgid = (int)L; { const int q = nwg / NXCD, r = nwg % NXCD, xcd = wgid % NXCD, off = wgid / NXCD; wgid = (xcd < r ? xcd * (q + 1) : r * (q + 1) + (xcd - r) * q) + off; }
    const int nig = WGM * nN, gid = wgid / nig, fm = gid * WGM, gsz = (nM - fm) < WGM ? (nM - fm) : WGM;
    pm = fm + ((wgid % nig) % gsz); pn = (wgid % nig) / gsz; return true;
}

struct EpiBf {
    static constexpr bool PERM = true;
    int act;
    __device__ __forceinline__ bool operator()(f32x4 (&acc)[2][2][4][2], const Unit& u, int wr, int wc, int fr, int fq) const {
        bf16_t* base = (bf16_t*)u.dst + (size_t)(wr * 64 + fr) * u.ldc + wc * 32 + 8 * fq;
        const float sc = u.scale;
#pragma unroll
        for (int ai = 0; ai < 2; ++ai)
#pragma unroll
            for (int m = 0; m < 4; ++m) { bf16_t* rowp = base + (size_t)(ai * HALF + m * 16) * u.ldc;
#pragma unroll
                for (int bj = 0; bj < 2; ++bj) { f32x4 v0 = acc[ai][bj][m][0], v1 = acc[ai][bj][m][1];
                    if (act == 1) {
#pragma unroll
                        for (int e = 0; e < 4; ++e) { const float a = fmaxf(v0[e], 0.f), b = fmaxf(v1[e], 0.f); v0[e] = a * a; v1[e] = b * b; } }
                    v0 = v0 * sc; v1 = v1 * sc;
                    u32x4 w; w.x = cvt_pk_bf16(v0[0], v0[1]); w.y = cvt_pk_bf16(v0[2], v0[3]); w.z = cvt_pk_bf16(v1[0], v1[1]); w.w = cvt_pk_bf16(v1[2], v1[3]);
                    *(u32x4*)(rowp + bj * HALF) = w; } }
        return true;
    }
};
struct EpiRes {
    static constexpr bool PERM = false;
    __device__ __forceinline__ bool operator()(f32x4 (&acc)[2][2][4][2], const Unit& u, int wr, int wc, int fr, int fq) const {
        const float* gv = (const float*)u.x1 + wc * 32 + 4 * fq;
        f32x4 g[2][2];
#pragma unroll
        for (int bj = 0; bj < 2; ++bj)
#pragma unroll
            for (int n = 0; n < 2; ++n) g[bj][n] = *(const f32x4*)(gv + bj * HALF + n * 16);
        const size_t o0 = (size_t)(wr * 64 + fr) * DM + wc * 32 + 4 * fq;
        const float* bs = (const float*)u.x0 + o0; float* od = (float*)u.dst + o0;
#pragma unroll
        for (int ai = 0; ai < 2; ++ai)
#pragma unroll
            for (int m = 0; m < 4; ++m) { const size_t off = (size_t)(ai * HALF + m * 16) * DM;
#pragma unroll
                for (int bj = 0; bj < 2; ++bj)
#pragma unroll
                    for (int n = 0; n < 2; ++n) { const f32x4 b = *(const f32x4*)(bs + off + bj * HALF + n * 16); *(f32x4*)(od + off + bj * HALF + n * 16) = b + g[bj][n] * acc[ai][bj][m][n]; }
                if (m & 1) asm volatile("" ::: "memory"); }
        return true;
    }
};
struct EpiMerge {
    static constexpr bool PERM = true;
    __device__ __forceinline__ void apply(const bool LAST, f32x4 (&acc)[2][2][4][2], const Unit& u, int wr, int wc, int fr, int fq) const {
        const bf16_t* g0 = (const bf16_t*)u.x0 + (size_t)(wr * 64 + fr) * ZN + wc * 32 + 8 * fq;
        bf16_t* base = (bf16_t*)u.dst + (size_t)(wr * 64 + fr) * DM + wc * 32 + 8 * fq;
        const int gboff = LAST ? 0 : DM;
#pragma unroll
        for (int am = 0; am < 4; ++am) { const int ai = am >> 1, m0 = (am & 1) * 2;
            u32x4 ga[2][2], gb[2][2];
#pragma unroll
            for (int mm = 0; mm < 2; ++mm)
#pragma unroll
                for (int bj = 0; bj < 2; ++bj) { const bf16_t* rp = g0 + (size_t)(ai * HALF + (m0 + mm) * 16) * ZN + bj * HALF; ga[mm][bj] = *(const u32x4*)rp; gb[mm][bj] = *(const u32x4*)(rp + gboff); }
#pragma unroll
            for (int mm = 0; mm < 2; ++mm)
#pragma unroll
                for (int bj = 0; bj < 2; ++bj) { const int m = m0 + mm;
                    f32x4 v0 = acc[ai][bj][m][0], v1 = acc[ai][bj][m][1];
#pragma unroll
                    for (int e = 0; e < 4; ++e) {
                        const unsigned wa = ga[mm][bj][e];
                        const float a0 = fminf(fmaxf(bf_lo(wa), -30.f), 30.f), a1 = fminf(fmaxf(bf_hi(wa), -30.f), 30.f);
                        const unsigned wb = gb[mm][bj][e]; const float b0 = fminf(fmaxf(bf_lo(wb), -30.f), 30.f), b1 = fminf(fmaxf(bf_hi(wb), -30.f), 30.f);
                        const float num0 = LAST ? 1.f : 1.f + __expf(-b0), num1 = LAST ? 1.f : 1.f + __expf(-b1);
                        const float f0 = num0 * __builtin_amdgcn_rcpf(1.f + __expf(-a0)), f1 = num1 * __builtin_amdgcn_rcpf(1.f + __expf(-a1));
                        if (e < 2) { v0[2 * e] *= f0; v0[2 * e + 1] *= f1; } else { v1[2 * (e - 2)] *= f0; v1[2 * (e - 2) + 1] *= f1; }
                    }
                    acc[ai][bj][m][0] = v0; acc[ai][bj][m][1] = v1;
                    if (LAST) { u32x4 w; w.x = cvt_pk_bf16(v0[0], v0[1]); w.y = cvt_pk_bf16(v0[2], v0[3]); w.z = cvt_pk_bf16(v1[0], v1[1]); w.w = cvt_pk_bf16(v1[2], v1[3]);
                        *(u32x4*)(base + (size_t)(ai * HALF + m * 16) * DM + bj * HALF) = w; }
                }
            asm volatile("" ::: "memory");
        }
    }
    __device__ __forceinline__ bool operator()(f32x4 (&acc)[2][2][4][2], const Unit& u, int wr, int wc, int fr, int fq) const {
        const bool last = (u.seg == 3); apply(last, acc, u, wr, wc, fr, fq); return last;
    }
};

template <class Epi, class Sched>
__device__ __forceinline__ void gemm_phase(LAS unsigned char* lds, const Gemm g, const Sched& S, const Epi& E, const int tid) {
    const int wid = __builtin_amdgcn_readfirstlane(tid >> 6), lane = tid & 63, wr = wid >> 2, wc = wid & 3, fr = lane & 15, fq = lane >> 4;
    unsigned voffA[2], voffB[2];
#pragma unroll
    for (int i = 0; i < 2; ++i) { int R, C; stage_rc(tid * 16 + i * 8192, R, C); const int Rb = Epi::PERM ? ((R & ~31) + perm32(R & 31)) : R;
        voffA[i] = (unsigned)(R * g.lda + C) * 2u; voffB[i] = (unsigned)(Rb * g.ldb + C) * 2u; }
    const size_t kstep = (size_t)(BK * 2);
    const size_t hstepA = (size_t)HALF * g.lda * 2, hstepB = (size_t)HALF * g.ldb * 2;
    const unsigned ldsw = (unsigned)wid * 1024u;
    const int aoff = lds_byte(wr * 64 + fr, fq * 8), boff = lds_byte(wc * 32 + fr, fq * 8);
#define PG8_SA(b, h) (((b) * 2 + (h)) * HTB)
#define PG8_SB(b, h) ((4 + (b) * 2 + (h)) * HTB)
#define PG8_STAGE(bufoff, gbase, voff) do { _Pragma("unroll") for (int _i = 0; _i < 2; ++_i) \
        __builtin_amdgcn_global_load_lds((const unsigned*)((const char*)(gbase) + (voff)[_i]), (LAS unsigned*)(lds + (bufoff) + ldsw + _i * 8192), 16, 0, 0); } while (0)
#define PG8_LDA(dst, b, h) do { _Pragma("unroll") for (int m = 0; m < 4; ++m) _Pragma("unroll") for (int k = 0; k < 2; ++k) dst[m][k] = *(const LAS bf16x8*)(lds + PG8_SA(b, h) + aoff + m * 2048 + k * 1024); } while (0)
#define PG8_LDB(dst, b, h) do { _Pragma("unroll") for (int n = 0; n < 2; ++n) _Pragma("unroll") for (int k = 0; k < 2; ++k) dst[n][k] = *(const LAS bf16x8*)(lds + PG8_SB(b, h) + boff + n * 2048 + k * 1024); } while (0)
#define PG8_MMA(ai, bj, At, Bt) do { __builtin_amdgcn_s_setprio(1); _Pragma("unroll") for (int m = 0; m < 4; ++m) _Pragma("unroll") for (int n = 0; n < 2; ++n) _Pragma("unroll") for (int k = 0; k < 2; ++k) \
        acc[ai][bj][m][n] = __builtin_amdgcn_mfma_f32_16x16x32_bf16(Bt[n][k], At[m][k], acc[ai][bj][m][n], 0, 0, 0); __builtin_amdgcn_s_setprio(0); } while (0)
#define PG8_WAIT_V(n) asm volatile("s_waitcnt vmcnt(" #n ")" ::: "memory")
#define PG8_WAIT_L(n) asm volatile("s_waitcnt lgkmcnt(" #n ")" ::: "memory")
#define PG8_BAR __builtin_amdgcn_s_barrier()
#define PG8_SCHED __builtin_amdgcn_sched_barrier(0)
    Unit cur, nxt; int ui = 0;
    if (!S.next(0, cur)) return;
    f32x4 acc[2][2][4][2];
#pragma unroll
    for (int a = 0; a < 2; ++a)
#pragma unroll
        for (int b = 0; b < 2; ++b)
#pragma unroll
            for (int m = 0; m < 4; ++m)
#pragma unroll
                for (int n = 0; n < 2; ++n) acc[a][b][m][n] = (f32x4){0.f, 0.f, 0.f, 0.f};
    bf16x8 At[4][2], B0[2][2], B1[2][2];
    const char* cA = cur.a; const char* cB = cur.b;
    PG8_STAGE(PG8_SB(0, 0), cB, voffB); PG8_STAGE(PG8_SB(0, 1), cB + hstepB, voffB); PG8_STAGE(PG8_SA(0, 0), cA, voffA); PG8_STAGE(PG8_SA(0, 1), cA + hstepA, voffA);
    if (wr == 1) PG8_BAR;
    PG8_WAIT_V(2); PG8_BAR;
    PG8_STAGE(PG8_SB(1, 0), cB + kstep, voffB); PG8_STAGE(PG8_SA(1, 0), cA + kstep, voffA); PG8_STAGE(PG8_SB(1, 1), cB + hstepB + kstep, voffB);
    PG8_WAIT_V(6); PG8_BAR;
    for (;;) {
        const bool has_next = S.next(ui + 1, nxt);
        const char* nA = has_next ? nxt.a : cA; const char* nB = has_next ? nxt.b : cB;
        const int nt = cur.nt;
        for (int t = 0; t < nt; t += 2) {
            const bool last = (t == nt - 2);
            const char* a1 = cA + (size_t)(t + 1) * kstep;
            const char* a2 = last ? nA : cA + (size_t)(t + 2) * kstep; const char* b2 = last ? nB : cB + (size_t)(t + 2) * kstep;
            const char* a3 = a2 + kstep; const char* b3 = b2 + kstep;
            PG8_LDB(B0, 0, 0); PG8_LDB(B1, 0, 1); PG8_SCHED; PG8_LDA(At, 0, 0); PG8_STAGE(PG8_SA(1, 1), a1 + hstepA, voffA);
            PG8_WAIT_V(8); PG8_WAIT_L(0); PG8_BAR; PG8_MMA(0, 0, At, B0); PG8_MMA(0, 1, At, B1); PG8_BAR; PG8_SCHED;
            PG8_LDA(At, 0, 1); PG8_STAGE(PG8_SB(0, 0), b2, voffB); PG8_STAGE(PG8_SB(0, 1), b2 + hstepB, voffB); PG8_STAGE(PG8_SA(0, 0), a2, voffA);
            PG8_WAIT_V(8); PG8_WAIT_L(0); PG8_BAR; PG8_MMA(1, 0, At, B0); PG8_MMA(1, 1, At, B1); PG8_BAR; PG8_SCHED;
            PG8_LDB(B0, 1, 0); PG8_LDB(B1, 1, 1); PG8_SCHED; PG8_LDA(At, 1, 0); PG8_STAGE(PG8_SA(0, 1), a2 + hstepA, voffA);
            PG8_WAIT_V(8); PG8_WAIT_L(0); PG8_BAR; PG8_MMA(0, 0, At, B0); PG8_MMA(0, 1, At, B1); PG8_BAR; PG8_SCHED;
            PG8_LDA(At, 1, 1); PG8_STAGE(PG8_SB(1, 0), b3, voffB); PG8_STAGE(PG8_SB(1, 1), b3 + hstepB, voffB); PG8_STAGE(PG8_SA(1, 0), a3, voffA);
            PG8_WAIT_V(8); PG8_WAIT_L(0); PG8_BAR; PG8_MMA(1, 0, At, B0); PG8_MMA(1, 1, At, B1); PG8_BAR; PG8_SCHED;
        }
        if (wr == 0) PG8_BAR;
        const bool zero = E(acc, cur, wr, wc, fr, fq);
        if (!has_next) break;
        if (zero) {
#pragma unroll
            for (int a = 0; a < 2; ++a)
#pragma unroll
                for (int b = 0; b < 2; ++b)
#pragma unroll
                    for (int m = 0; m < 4; ++m)
#pragma unroll
                        for (int n = 0; n < 2; ++n) acc[a][b][m][n] = (f32x4){0.f, 0.f, 0.f, 0.f};
        }
        cur = nxt; cA = nA; cB = nB; ++ui;
        if (wr == 1) PG8_BAR;
    }
    PG8_WAIT_V(0);
    PG8_BAR;
#undef PG8_SA
#undef PG8_SB
#undef PG8_STAGE
#undef PG8_LDA
#undef PG8_LDB
#undef PG8_MMA
#undef PG8_WAIT_V
#undef PG8_WAIT_L
#undef PG8_BAR
#undef PG8_SCHED
}
}

struct Args { const float* in[27]; float* out; unsigned char* ws; int ph_lo, ph_hi; };
typedef const __attribute__((address_space(4))) Args* ArgP;
enum { I_X = 0, I_C, I_CTX, I_CCTX, I_WMOD, I_BMOD, I_G1, I_G2, I_WIN, I_CONVW, I_CONVB, I_WA, I_BA, I_WX, I_BX, I_LAM, I_POOLW, I_POOLS, I_SCW,
       I_BRL, I_BRF, I_BRP, I_BRS, I_WOUT, I_FF1, I_FF2, I_GF };

struct Sched {
    int kind, l, ch, G, c;
    ArgP ap;
    __device__ __forceinline__ bool next(int i, pg8::Unit& u) const {
        unsigned char* ws = ap->ws;
        const long L = (long)i * G + c;
        const int nM = (l == 0) ? RT / 256 : RL / 256;
        u.x0 = nullptr; u.x1 = nullptr; u.seg = 0; u.scale = 1.f;
        int pm, pn;
        if (kind == 1) {
            const char* U = (const char*)(ws + WS_U);
            const int nZ = nM * 24;
            long L2 = L - nZ; bool isz = false;
            if (L < nZ) { pg8::tile_of(L, nM, 24, pm, pn); isz = true; }
            else if (l == 1) { if (L2 < 32) { pm = 128 + (int)(L2 >> 1); pn = (int)(L2 & 1); isz = true; } else L2 -= 32; }
            if (isz) {
                u.a = U + (size_t)pm * 256 * DM * 2; u.b = (const char*)(ws + WS_WIN) + ((size_t)l * ZN + (size_t)pn * 256) * DM * 2; u.nt = 16;
                u.dst = (char*)(ws + WS_Z) + ((size_t)pm * 256 * ZN + (size_t)pn * 256) * 2; u.ldc = ZN; return true;
            }
            if (L2 >= 2 * nM) return false;
            const int seg = (int)(L2 & 1), tt = (int)(L2 >> 1);
            u.a = (const char*)(ws + WS_WF) + ((size_t)l * 512 + (size_t)seg * 256) * DM * 2; u.b = U + (size_t)tt * 256 * DM * 2; u.nt = 16; u.ldc = 4096;
            if (tt < 128) u.dst = (char*)(ws + WS_PT) + ((size_t)(tt >> 3) * 256 * 4096 + (size_t)seg * 2048 + (size_t)(tt & 7) * 256) * 2;
            else u.dst = (char*)(ws + WS_PTC) + ((size_t)(tt - 128) * 256 * 4096 + (size_t)seg * 256) * 2;
            return true;
        }
        if (kind == 7) {
            if (!pg8::tile_of(L, nM, 16, pm, pn)) return false;
            u.a = (const char*)(ws + WS_U) + (size_t)pm * 256 * DM * 2; u.b = (const char*)(ws + WS_W1) + ((size_t)l * DFF + (size_t)pn * 256) * DM * 2; u.nt = 16;
            u.dst = (char*)(ws + WS_Z) + ((size_t)pm * 256 * DFF + (size_t)pn * 256) * 2; u.ldc = DFF; return true;
        }
        if (kind == 2) {
            if (L < 128) { const int b_ = (int)(L >> 3), kt = (int)(L & 7);
                u.a = (const char*)(ws + WS_DFT) + (size_t)kt * 256 * 4096 * 2; u.b = (const char*)(ws + WS_PT) + (size_t)b_ * 256 * 4096 * 2; u.nt = 64;
                u.dst = (char*)(ws + WS_Y) + ((size_t)(b_ * SEQ + kt * 256) * YN + Y_F) * 2; u.ldc = YN; u.scale = 0.001381067932004975f  ; return true; }
            if (l == 0 && L < 144) { const int j = (int)L - 128;
                u.a = (const char*)(ws + WS_DFTC); u.b = (const char*)(ws + WS_PTC) + (size_t)j * 256 * 4096 * 2; u.nt = 8;
                u.dst = (char*)(ws + WS_Y) + ((size_t)(RL + j * 256) * YN + Y_F) * 2; u.ldc = YN; u.scale = 1.f / 256.f; return true; }
            return false;
        }
        if (kind == 4) {
            const int seg = i & 3; const long T = (long)(i >> 2) * G + c;
            if (!pg8::tile_of(T, nM, 4, pm, pn)) return false;
            const int coff = seg == 0 ? 0 : (256 + 256 * seg);
            u.a = (const char*)(ws + WS_Y) + ((size_t)pm * 256 * YN + coff) * 2; u.b = (const char*)(ws + WS_WBR) + (((size_t)l * DM + (size_t)pn * 256) * YN + coff) * 2;
            u.nt = seg == 0 ? 8 : 4; u.seg = seg; u.ldc = DM;
            u.dst = (char*)(ws + WS_MRG) + ((size_t)pm * 256 * DM + (size_t)pn * 256) * 2;
            u.x0 = (const char*)(ws + WS_Z) + ((size_t)pm * 256 * ZN + Z_GATE + seg * DM + pn * 256) * 2;
            return true;
        }
        if (!pg8::tile_of(L, nM, 4, pm, pn)) return false;
        if (kind == 5) { u.a = (const char*)(ws + WS_MRG) + (size_t)pm * 256 * DM * 2; u.b = (const char*)(ws + WS_WOUT) + ((size_t)l * DM + (size_t)pn * 256) * DM * 2; u.nt = 16; }
        else { u.a = (const char*)(ws + WS_Z) + (size_t)pm * 256 * DFF * 2; u.b = (const char*)(ws + WS_W2) + ((size_t)l * DM + (size_t)pn * 256) * DFF * 2; u.nt = 64; }
        int bidx; size_t eoff;
        if (pm < 128) { eoff = ((size_t)(ch * RL + pm * 256) * DM + pn * 256) * 4; bidx = ch * NB + (pm >> 3);
            char* out = (char*)ap->out; u.dst = out + eoff; u.x0 = (kind == 5 && l == 0) ? (const char*)ap->in[I_X] + eoff : (const char*)out + eoff; }
        else { eoff = ((size_t)(ch * RC + (pm - 128) * 256) * DM + pn * 256) * 4; bidx = 32;
            u.dst = (char*)(ws + WS_CTXW) + eoff; u.x0 = (kind == 5) ? (const char*)ap->in[I_CTX] + eoff : (const char*)(ws + WS_CTXW) + eoff; }
        u.x1 = (const char*)(ws + WS_MOD) + ((size_t)((l * 33 + bidx) * 6 + (kind == 5 ? 2 : 5)) * DM + pn * 256) * 4;
        u.ldc = DM;
        return true;
    }
};

__device__ __forceinline__ void tr_item(const float* W, int ldw, int col0, int ncols, bf16_t* WT, int ldt, int koff, LAS float* scr, int item, int lane) {
    const int nblk = ncols / 32, kb = item / nblk, nb = item % nblk, k0 = 64 * kb, n0 = 32 * nb;
#pragma unroll 8
    for (int i = 0; i < 32; ++i) { const int kk = 2 * i + (lane >> 5); scr[kk * 33 + (lane & 31)] = W[(size_t)(k0 + kk) * ldw + col0 + n0 + (lane & 31)]; }
    LDS_WAIT(); asm volatile("" ::: "memory");
    const int c = lane & 7;
#pragma unroll
    for (int j = 0; j < 4; ++j) { const int n = (lane >> 3) + 8 * j; const LAS float* s = scr + (8 * c) * 33 + n;
        u32x4 o; o.x = cvt_pk_bf16(s[0 * 33], s[1 * 33]); o.y = cvt_pk_bf16(s[2 * 33], s[3 * 33]); o.z = cvt_pk_bf16(s[4 * 33], s[5 * 33]); o.w = cvt_pk_bf16(s[6 * 33], s[7 * 33]);
        *(u32x4*)(WT + (size_t)(n0 + n) * ldt + koff + k0 + 8 * c) = o; }
    LDS_WAIT(); asm volatile("" ::: "memory");
}

__device__ __forceinline__ void p0_prologue(ArgP A, LAS unsigned char* lds, int G, const int tid) {
    const int lane = tid & 63, wave = tid >> 6, bx = blockIdx.x;
    unsigned char* ws = A->ws;
    if (bx < 192) {
        const int l = bx / 96, cb = bx % 96, n = cb * 64 + lane;
        LAS float* sl = (LAS float*)lds;
        for (int idx = tid; idx < 33 * 1024; idx += 512) { const int bb = idx >> 10, k = idx & 1023; const float v = bb < 32 ? A->in[I_C][bb * 1024 + k] : A->in[I_CCTX][k]; sl[idx] = v * sigm(v); }
        __syncthreads();
        float acc[33];
#pragma unroll
        for (int bb = 0; bb < 33; ++bb) acc[bb] = 0.f;
        const float* wp = A->in[I_WMOD] + ((size_t)l * 1024 + wave * 128) * 6144 + n;
        for (int k4 = 0; k4 < 32; ++k4) {
            const float w0 = wp[(size_t)(4 * k4 + 0) * 6144], w1 = wp[(size_t)(4 * k4 + 1) * 6144], w2 = wp[(size_t)(4 * k4 + 2) * 6144], w3 = wp[(size_t)(4 * k4 + 3) * 6144];
#pragma unroll
            for (int bb = 0; bb < 33; ++bb) { const f32x4 s = *(const LAS f32x4*)(sl + bb * 1024 + wave * 128 + 4 * k4); acc[bb] += s[0] * w0 + s[1] * w1 + s[2] * w2 + s[3] * w3; }
        }
        __syncthreads();
        LAS float* red = (LAS float*)lds;
#pragma unroll
        for (int bb = 0; bb < 33; ++bb) red[(wave * 33 + bb) * 64 + lane] = acc[bb];
        __syncthreads();
        float* MOD = (float*)(ws + WS_MOD);
        for (int idx = tid; idx < 33 * 64; idx += 512) { const int bb = idx >> 6, ln = idx & 63; float s = A->in[I_BMOD][l * 6144 + cb * 64 + ln];
#pragma unroll
            for (int w = 0; w < 8; ++w) s += red[(w * 33 + bb) * 64 + ln];
            MOD[(size_t)(l * 33 + bb) * 6144 + cb * 64 + ln] = s; }
        __syncthreads();
    } else if (bx < 224) {
        const int it = bx - 192, l = it >> 4, k0 = (it & 15) * 64;
        LAS float* wt = (LAS float*)lds;
        LAS float* tab = (LAS float*)(lds + 65536);
        for (int idx = tid; idx < 64 * 256; idx += 512) { const int kk = idx >> 8, c = idx & 255; wt[idx] = A->in[I_WIN][((size_t)l * 1024 + k0 + kk) * NIN + 1024 + c]; }
        { const int i = tid & 255; tab[tid] = (tid < 256) ? cospif((float)i / 128.f) : sinpif((float)i / 128.f); }
        __syncthreads();
        const int m = tid & 255; const LAS float* tb = tab + (tid >> 8) * 256;
        bf16_t* WF = (bf16_t*)(ws + WS_WF) + ((size_t)l * 512 + tid) * DM + k0;
        for (int kg = 0; kg < 8; ++kg) {
            float a[8];
#pragma unroll
            for (int q = 0; q < 8; ++q) a[q] = 0.f;
            for (int c = 0; c < 256; ++c) { const float tv = tb[(m * c) & 255];
#pragma unroll
                for (int q = 0; q < 8; ++q) a[q] += wt[(kg * 8 + q) * 256 + c] * tv; }
            u32x4 o; o.x = cvt_pk_bf16(a[0], a[1]); o.y = cvt_pk_bf16(a[2], a[3]); o.z = cvt_pk_bf16(a[4], a[5]); o.w = cvt_pk_bf16(a[6], a[7]);
            *(u32x4*)(WF + kg * 8) = o;
        }
        __syncthreads();
    }
    {
        LAS float* scr = (LAS float*)(lds + wave * 16384);
        const int gw = wave * G + bx, NGW = G * 8;
        for (int it = gw; it < 16384; it += NGW) {
            const int l = it >> 13; int r = it & 8191;
            const float* win = A->in[I_WIN] + (size_t)l * 1024 * NIN;
            bf16_t* WIN = (bf16_t*)(ws + WS_WIN) + (size_t)l * ZN * DM;
            bf16_t* WBR = (bf16_t*)(ws + WS_WBR) + (size_t)l * DM * YN;
            if (r < 512) { tr_item(win, NIN, 0, 1024, WIN, DM, 0, scr, r, lane); continue; } r -= 512;
            if (r < 2560) { tr_item(win, NIN, 1280, 5120, WIN + (size_t)1024 * DM, DM, 0, scr, r, lane); continue; } r -= 2560;
            if (r < 256) { tr_item(A->in[I_BRL] + (size_t)l * 512 * DM, DM, 0, DM, WBR, YN, 0, scr, r, lane); continue; } r -= 256;
            if (r < 128) { tr_item(A->in[I_BRF] + (size_t)l * 256 * DM, DM, 0, DM, WBR, YN, Y_F, scr, r, lane); continue; } r -= 128;
            if (r < 128) { tr_item(A->in[I_BRS] + (size_t)l * 256 * DM, DM, 0, DM, WBR, YN, Y_SC, scr, r, lane); continue; } r -= 128;
            if (r < 512) { tr_item(A->in[I_WOUT] + (size_t)l * DM * DM, DM, 0, DM, (bf16_t*)(ws + WS_WOUT) + (size_t)l * DM * DM, DM, 0, scr, r, lane); continue; } r -= 512;
            if (r < 2048) { tr_item(A->in[I_FF1] + (size_t)l * DM * DFF, DFF, 0, DFF, (bf16_t*)(ws + WS_W1) + (size_t)l * DFF * DM, DM, 0, scr, r, lane); continue; } r -= 2048;
            tr_item(A->in[I_FF2] + (size_t)l * DFF * DM, DM, 0, DM, (bf16_t*)(ws + WS_W2) + (size_t)l * DM * DFF, DFF, 0, scr, r, lane);
        }
    }
    const int gt = bx * 512 + tid, NGT = G * 512;
    {
        bf16_t* WG = (bf16_t*)(ws + WS_WG);
        for (int idx = gt; idx < 2 * 8 * 256 * 64; idx += NGT) { const int i = idx & 63, n = (idx >> 6) & 255, h = (idx >> 14) & 7, l = idx >> 17, d = n >> 7, gate = (n >> 6) & 1, j = n & 63;
            const float v = (gate ? A->in[I_WX] : A->in[I_WA])[((size_t)((l * 2 + d) * 8 + h) * 64 + i) * 64 + j];
            WG[idx] = (bf16_t)(cvt_pk_bf16(v, 0.f) & 0xffffu); }
    }
    {
        for (int idx = gt; idx < 2 * 256 * 1024; idx += NGT) { const int n = idx & 1023, i = (idx >> 10) & 255, l = idx >> 18, g = i >> 6, il = i & 63;
            const float* pw = A->in[I_POOLW] + ((size_t)(l * 4 + g) * 64 + il) * 64; const float* ps = A->in[I_POOLS] + l * 256 + g * 64; const float* wb = A->in[I_BRP] + ((size_t)l * 256 + g * 64) * DM + n;
            float s = 0.f;
            for (int j = 0; j < 64; ++j) s += pw[j] * ps[j] * wb[(size_t)j * DM];
            ((bf16_t*)(ws + WS_WBR))[((size_t)l * DM + n) * YN + Y_POOL + i] = (bf16_t)(cvt_pk_bf16(s, 0.f) & 0xffffu); }
    }
    {
        bf16_t* DF = (bf16_t*)(ws + WS_DFT);
        for (int idx = gt; idx < 2048 * 512; idx += NGT) { const int k = idx >> 9, n8 = (idx & 511) * 8; float v[8];
#pragma unroll
            for (int e = 0; e < 8; ++e) { const int np = n8 + e; if (np < 2048) v[e] = cospif((float)((k * np) & 2047) * (1.f / 1024.f)); else v[e] = -sinpif((float)((k * (np - 2048)) & 2047) * (1.f / 1024.f)); }
            u32x4 o; o.x = cvt_pk_bf16(v[0], v[1]); o.y = cvt_pk_bf16(v[2], v[3]); o.z = cvt_pk_bf16(v[4], v[5]); o.w = cvt_pk_bf16(v[6], v[7]);
            *(u32x4*)(DF + (size_t)k * 4096 + n8) = o; }
        bf16_t* DC = (bf16_t*)(ws + WS_DFTC);
        for (int idx = gt; idx < 256 * 64; idx += NGT) { const int k = idx >> 6, n8 = (idx & 63) * 8; float v[8];
#pragma unroll
            for (int e = 0; e < 8; ++e) { const int np = n8 + e; if (np < 256) v[e] = cospif((float)((k * np) & 255) * (1.f / 128.f)); else v[e] = -sinpif((float)((k * (np - 256)) & 255) * (1.f / 128.f)); }
            u32x4 o; o.x = cvt_pk_bf16(v[0], v[1]); o.y = cvt_pk_bf16(v[2], v[3]); o.z = cvt_pk_bf16(v[4], v[5]); o.w = cvt_pk_bf16(v[6], v[7]);
            *(u32x4*)(DC + (size_t)k * 4096 + n8) = o; }
    }
}

__device__ __forceinline__ void norm_phase(ArgP A, int l, int ch, bool second, int G, const int tid) {
    const int lane = tid & 63, wave = tid >> 6;
    unsigned char* ws = A->ws;
    const int nrows = (second && l == 1) ? RL : RT;
    const float* gn = (second ? A->in[I_G2] : A->in[I_G1]) + l * DM;
    const float* MOD = (const float*)(ws + WS_MOD);
    bf16_t* U = (bf16_t*)(ws + WS_U);
    for (int r = blockIdx.x * 8 + wave; r < nrows; r += G * 8) {
        const float* src; int bidx;
        if (r < RL) { const size_t grow = (size_t)ch * RL + r; src = ((!second && l == 0) ? A->in[I_X] : (const float*)A->out) + grow * DM; bidx = ch * NB + (r >> 11); }
        else { const size_t grow = (size_t)ch * RC + (r - RL); src = ((!second && l == 0) ? A->in[I_CTX] : (const float*)(ws + WS_CTXW)) + grow * DM; bidx = 32; }
        const float* sh = MOD + (size_t)((l * 33 + bidx) * 6 + (second ? 3 : 0)) * DM; const float* sc = sh + DM;
        f32x4 v[4]; float s = 0.f;
#pragma unroll
        for (int j = 0; j < 4; ++j) { v[j] = *(const f32x4*)(src + 4 * (lane + 64 * j)); s += (v[j][0] * v[j][0] + v[j][1] * v[j][1]) + (v[j][2] * v[j][2] + v[j][3] * v[j][3]); }
        const float rstd = 1.0f / sqrtf(wave_sum(s) * (1.f / DM) + 1e-6f);
#pragma unroll
        for (int j = 0; j < 4; ++j) { const int col = 4 * (lane + 64 * j);
            const f32x4 gg = *(const f32x4*)(gn + col), s1 = *(const f32x4*)(sc + col), s0 = *(const f32x4*)(sh + col);
            const f32x4 o = (v[j] * rstd) * gg * (s1 + 1.0f) + s0;
            u32x2 w; w.x = cvt_pk_bf16(o[0], o[1]); w.y = cvt_pk_bf16(o[2], o[3]);
            *(u32x2*)(U + (size_t)r * DM + col) = w; }
    }
}
__device__ __forceinline__ void final_norm(ArgP A, int G, const int tid) {
    const int lane = tid & 63, wave = tid >> 6;
    const float* gn = A->in[I_GF];
    for (int r = blockIdx.x * 8 + wave; r < NBATCH * SEQ; r += G * 8) {
        float* p = A->out + (size_t)r * DM;
        f32x4 v[4]; float s = 0.f;
#pragma unroll
        for (int j = 0; j < 4; ++j) { v[j] = *(const f32x4*)(p + 4 * (lane + 64 * j)); s += (v[j][0] * v[j][0] + v[j][1] * v[j][1]) + (v[j][2] * v[j][2] + v[j][3] * v[j][3]); }
        const float rstd = 1.0f / sqrtf(wave_sum(s) * (1.f / DM) + 1e-6f);
#pragma unroll
        for (int j = 0; j < 4; ++j) { const int col = 4 * (lane + 64 * j); const f32x4 gg = *(const f32x4*)(gn + col); *(f32x4*)(p + col) = (v[j] * rstd) * gg; }
    }
}

__device__ __forceinline__ void unpack8(const u32x4 w, float (&f)[8]) {
#pragma unroll
    for (int e = 0; e < 4; ++e) { f[2 * e] = bf_lo(w[e]); f[2 * e + 1] = bf_hi(w[e]); }
}
__device__ __forceinline__ u32x4 pack8(const float (&f)[8]) { u32x4 o; o.x = cvt_pk_bf16(f[0], f[1]); o.y = cvt_pk_bf16(f[2], f[3]); o.z = cvt_pk_bf16(f[4], f[5]); o.w = cvt_pk_bf16(f[6], f[7]); return o; }

__device__ __forceinline__ void lru_item(ArgP A, int l, int it, bool pass2, LAS unsigned char* lds, const int tid) {
    const int lane = tid & 63, wid = tid >> 6;
    unsigned char* ws = A->ws;
    const int head = it & 7, rest = it >> 3;
    int sc, bl;
    if (!pass2 || l == 0) { sc = rest % NSC; bl = rest / NSC; } else { sc = 4 + (rest & 31); bl = rest >> 5; }
    const bool isctx = sc < 4; const int c = isctx ? sc : sc - 4, Lseq = isctx ? CTXL : SEQ, rowbase = isctx ? RL + bl * CTXL : bl * SEQ, t0 = c * 64;
    const bf16_t* Z = (const bf16_t*)(ws + WS_Z);
    LAS float* xaf = (LAS float*)lds;
    LAS bf16_t* xab = (LAS bf16_t*)(lds + 17408);
    LAS float* hbuf = (LAS float*)(lds + 32768);
    {
        const int t = tid >> 3, i8 = (tid & 7) * 8, tok = t0 + t, Cc = head * 64 + i8;
        float acc[8];
        { const f32x4 b0 = *(const f32x4*)(A->in[I_CONVB] + l * DLRU + Cc), b1 = *(const f32x4*)(A->in[I_CONVB] + l * DLRU + Cc + 4);
#pragma unroll
          for (int e = 0; e < 4; ++e) { acc[e] = b0[e]; acc[4 + e] = b1[e]; } }
#pragma unroll
        for (int k = 0; k < 4; ++k) { const int tt = tok + k - 2;
            if (tt >= 0 && tt < Lseq) { float z[8]; unpack8(*(const u32x4*)(Z + (size_t)(rowbase + tt) * ZN + Cc), z);
                const float* cw = A->in[I_CONVW] + (size_t)(l * 4 + k) * DLRU + Cc; const f32x4 c0 = *(const f32x4*)cw, c1 = *(const f32x4*)(cw + 4);
#pragma unroll
                for (int e = 0; e < 4; ++e) { acc[e] += z[e] * c0[e]; acc[4 + e] += z[4 + e] * c1[e]; } } }
        *(LAS f32x4*)(xaf + t * 68 + i8) = (f32x4){acc[0], acc[1], acc[2], acc[3]}; *(LAS f32x4*)(xaf + t * 68 + i8 + 4) = (f32x4){acc[4], acc[5], acc[6], acc[7]};
        *(LAS u32x4*)(xab + t * 72 + i8) = pack8(acc);
    }
    __syncthreads();
    {
        const int d = wid >> 2, g = wid & 3, fr = lane & 15, fq = lane >> 4;
        const bf16_t* wb = (const bf16_t*)(ws + WS_WG) + ((size_t)((l * 8 + head) * 256 + d * 128 + 16 * g + fr)) * 64 + 8 * fq;
        bf16x8 wR[2], wG[2];
#pragma unroll
        for (int ks = 0; ks < 2; ++ks) { wR[ks] = *(const bf16x8*)(wb + 32 * ks); wG[ks] = *(const bf16x8*)(wb + 64 * 64 + 32 * ks); }
        const int cb = head * 64 + 16 * g + 4 * fq;
        const f32x4 ba = *(const f32x4*)(A->in[I_BA] + (l * 2 + d) * DLRU + cb), bxv = *(const f32x4*)(A->in[I_BX] + (l * 2 + d) * DLRU + cb), lam = *(const f32x4*)(A->in[I_LAM] + (l * 2 + d) * DLRU + cb);
        f32x4 sp8;
#pragma unroll
        for (int e = 0; e < 4; ++e) sp8[e] = 8.0f * log1pf(__expf(-lam[e]));
        const int p = (d == 0) ? sc : (isctx ? 3 - c : 4 + 31 - c);
        float* SA = (float*)(ws + WS_SUMA) + ((size_t)(bl * 2 + d) * NSC) * DLRU + cb; float* SH = (float*)(ws + WS_SUMH) + ((size_t)(bl * 2 + d) * NSC) * DLRU + cb;
        f32x4 hin = (f32x4){0.f, 0.f, 0.f, 0.f}, Atot = (f32x4){1.f, 1.f, 1.f, 1.f}, Htot = (f32x4){0.f, 0.f, 0.f, 0.f};
        if (pass2) for (int pp = 0; pp < p; ++pp) { const f32x4 a4 = *(const f32x4*)(SA + (size_t)pp * DLRU), h4 = *(const f32x4*)(SH + (size_t)pp * DLRU); hin = a4 * hin + h4; }
        const int lastl = (lane & 48) | (d ? 0 : 15);
#pragma unroll
        for (int q = 0; q < 4; ++q) { const int tt = d ? 3 - q : q;
            f32x4 aR = (f32x4){0.f, 0.f, 0.f, 0.f}, aG = (f32x4){0.f, 0.f, 0.f, 0.f};
#pragma unroll
            for (int ks = 0; ks < 2; ++ks) { const bf16x8 bfrag = *(const LAS bf16x8*)(xab + (16 * tt + fr) * 72 + 8 * fq + 32 * ks);
                aR = __builtin_amdgcn_mfma_f32_16x16x32_bf16(wR[ks], bfrag, aR, 0, 0, 0); aG = __builtin_amdgcn_mfma_f32_16x16x32_bf16(wG[ks], bfrag, aG, 0, 0, 0); }
            const f32x4 xv = *(const LAS f32x4*)(xaf + (16 * tt + fr) * 68 + 16 * g + 4 * fq);
            f32x4 hv;
#pragma unroll
            for (int e = 0; e < 4; ++e) {
                const float r = sigm(aR[e] + ba[e]), gi = sigm(aG[e] + bxv[e]);
                const float la = -r * sp8[e], a = __expf(la), x2 = -2.0f * la;
                const float om = x2 < 0.1f ? x2 * (1.0f - x2 * (0.5f - x2 * (0.16666667f - x2 * 0.041666668f))) : 1.0f - a * a;
                float Av = a, Bv = sqrtf(om) * gi * xv[e];
#pragma unroll
                for (int off = 1; off < 16; off <<= 1) { const int src = d ? lane + off : lane - off; const float Ap = __shfl(Av, src), Bp = __shfl(Bv, src);
                    const bool valid = d ? (fr + off < 16) : (fr >= off); if (valid) { Bv = Av * Bp + Bv; Av = Av * Ap; } }
                if (pass2) { const float h = Av * hin[e] + Bv; hv[e] = h; hin[e] = __shfl(h, lastl); }
                else { const float AT = __shfl(Av, lastl), BT = __shfl(Bv, lastl); Htot[e] = AT * Htot[e] + BT; Atot[e] = Atot[e] * AT; }
            }
            if (pass2) *(LAS f32x4*)(hbuf + ((d * 64 + 16 * tt + fr) * 68 + 16 * g + 4 * fq)) = hv;
        }
        if (!pass2 && fr == 0) { *(f32x4*)(SA + (size_t)p * DLRU) = Atot; *(f32x4*)(SH + (size_t)p * DLRU) = Htot; }
    }
    if (pass2) {
        __syncthreads();
        const int t = tid >> 3, i8 = (tid & 7) * 8, tok = t0 + t, Cc = head * 64 + i8;
        float zg[8]; unpack8(*(const u32x4*)(Z + (size_t)(rowbase + tok) * ZN + Z_LG + Cc), zg);
        const f32x4 h00 = *(const LAS f32x4*)(hbuf + t * 68 + i8), h01 = *(const LAS f32x4*)(hbuf + t * 68 + i8 + 4), h10 = *(const LAS f32x4*)(hbuf + (64 + t) * 68 + i8), h11 = *(const LAS f32x4*)(hbuf + (64 + t) * 68 + i8 + 4);
        float y[8];
#pragma unroll
        for (int e = 0; e < 8; ++e) { const float hs = e < 4 ? h00[e & 3] + h10[e & 3] : h01[e & 3] + h11[e & 3]; const float x = zg[e];
            const float u2 = 1.5957691216057308f * (x + 0.044715f * x * x * x);
            y[e] = hs * x * sigm(u2); }
        *(u32x4*)((bf16_t*)(ws + WS_Y) + (size_t)(rowbase + tok) * YN + Cc) = pack8(y);
    }
}

__device__ __forceinline__ void sweep_chunk(int d, int j, int bl, int& rowbase, int& t0, int& Lseq, bool& isctx) {
    isctx = j < 4; const int c = isctx ? (d ? 3 - j : j) : (d ? 35 - j : j - 4);
    Lseq = isctx ? CTXL : SEQ; rowbase = isctx ? RL + bl * CTXL : bl * SEQ; t0 = c * 64;
}
__device__ __forceinline__ void lru_sweep(ArgP A, int l, int item, LAS unsigned char* lds, const int tid) {
    unsigned char* ws = A->ws;
    const int lane = tid & 63, wid = tid >> 6, d = wid >> 2, g = wid & 3, fr = lane & 15, fq = lane >> 4, hl = tid & 255;
    const int head = item & 7, bl = item >> 3;
    const bf16_t* Z = (const bf16_t*)(ws + WS_Z);
    LAS float* cwl = (LAS float*)(lds + 106496);
    __syncthreads();
    if (tid < 256) cwl[tid] = A->in[I_CONVW][(size_t)(l * 4 + (tid >> 6)) * DLRU + head * 64 + (tid & 63)];
    else if (tid < 320) cwl[tid] = A->in[I_CONVB][l * DLRU + head * 64 + (tid - 256)];
    const bf16_t* wb = (const bf16_t*)(ws + WS_WG) + ((size_t)((l * 8 + head) * 256 + d * 128 + 16 * g + fr)) * 64 + 8 * fq;
    bf16x8 wR[2], wG[2];
#pragma unroll
    for (int ks = 0; ks < 2; ++ks) { wR[ks] = *(const bf16x8*)(wb + 32 * ks); wG[ks] = *(const bf16x8*)(wb + 64 * 64 + 32 * ks); }
    const int cb = head * 64 + 16 * g + 4 * fq;
    const f32x4 ba = *(const f32x4*)(A->in[I_BA] + (l * 2 + d) * DLRU + cb), bxv = *(const f32x4*)(A->in[I_BX] + (l * 2 + d) * DLRU + cb), lam = *(const f32x4*)(A->in[I_LAM] + (l * 2 + d) * DLRU + cb);
    f32x4 sp8;
#pragma unroll
    for (int e = 0; e < 4; ++e) sp8[e] = 8.0f * log1pf(__expf(-lam[e]));
    float* HX = (float*)(ws + (d ? WS_HB : WS_HF));
    const int lastl = (lane & 48) | (d ? 0 : 15);
    const int ct = hl >> 2, ci = (hl & 3) * 16;
    f32x4 hin = (f32x4){0.f, 0.f, 0.f, 0.f};
    u32x4 zc[4][2];
    { int rowbase, t0, Lseq; bool isctx; sweep_chunk(d, 0, bl, rowbase, t0, Lseq, isctx);
#pragma unroll
      for (int k = 0; k < 4; ++k) { const int tt = t0 + ct + k - 2; zc[k][0] = (u32x4){0u, 0u, 0u, 0u}; zc[k][1] = (u32x4){0u, 0u, 0u, 0u};
          if (tt >= 0 && tt < Lseq) { const bf16_t* zr = Z + (size_t)(rowbase + tt) * ZN + head * 64 + ci; zc[k][0] = *(const u32x4*)zr; zc[k][1] = *(const u32x4*)(zr + 8); } } }
    __syncthreads();
    for (int j = 0; j < NSC; ++j) {
        int rowbase, t0, Lseq; bool isctx; sweep_chunk(d, j, bl, rowbase, t0, Lseq, isctx);
        u32x4 zn[4][2];
#pragma unroll
        for (int k = 0; k < 4; ++k) { zn[k][0] = (u32x4){0u, 0u, 0u, 0u}; zn[k][1] = (u32x4){0u, 0u, 0u, 0u}; }
        if (j + 1 < NSC) { int rb2, t02, Ls2; bool ic2; sweep_chunk(d, j + 1, bl, rb2, t02, Ls2, ic2);
#pragma unroll
            for (int k = 0; k < 4; ++k) { const int tt = t02 + ct + k - 2;
                if (tt >= 0 && tt < Ls2) { const bf16_t* zr = Z + (size_t)(rb2 + tt) * ZN + head * 64 + ci; zn[k][0] = *(const u32x4*)zr; zn[k][1] = *(const u32x4*)(zr + 8); } } }
        LAS float* xaf = (LAS float*)(lds + d * 53248 + (j & 1) * 26624);
        LAS bf16_t* xab = (LAS bf16_t*)(lds + d * 53248 + (j & 1) * 26624 + 17408);
        {
            float acc[16];
#pragma unroll
            for (int q4 = 0; q4 < 4; ++q4) { const f32x4 b = *(const LAS f32x4*)(cwl + 256 + ci + 4 * q4);
#pragma unroll
                for (int e = 0; e < 4; ++e) acc[4 * q4 + e] = b[e]; }
#pragma unroll
            for (int k = 0; k < 4; ++k) { float z[16]; { float t8[8]; unpack8(zc[k][0], t8);
#pragma unroll
                    for (int e = 0; e < 8; ++e) z[e] = t8[e]; unpack8(zc[k][1], t8);
#pragma unroll
                    for (int e = 0; e < 8; ++e) z[8 + e] = t8[e]; }
#pragma unroll
                for (int q4 = 0; q4 < 4; ++q4) { const f32x4 w = *(const LAS f32x4*)(cwl + k * 64 + ci + 4 * q4);
#pragma unroll
                    for (int e = 0; e < 4; ++e) acc[4 * q4 + e] += z[4 * q4 + e] * w[e]; } }
#pragma unroll
            for (int q4 = 0; q4 < 4; ++q4) *(LAS f32x4*)(xaf + ct * 68 + ci + 4 * q4) = (f32x4){acc[4 * q4], acc[4 * q4 + 1], acc[4 * q4 + 2], acc[4 * q4 + 3]};
            { float t8[8];
#pragma unroll
              for (int e = 0; e < 8; ++e) t8[e] = acc[e];
              *(LAS u32x4*)(xab + ct * 72 + ci) = pack8(t8);
#pragma unroll
              for (int e = 0; e < 8; ++e) t8[e] = acc[8 + e];
              *(LAS u32x4*)(xab + ct * 72 + ci + 8) = pack8(t8); }
        }
        __syncthreads();
        const bool wr_h = !(l == 1 && isctx);
#pragma unroll
        for (int q = 0; q < 4; ++q) { const int tt = d ? 3 - q : q;
            f32x4 aR = (f32x4){0.f, 0.f, 0.f, 0.f}, aG = (f32x4){0.f, 0.f, 0.f, 0.f};
#pragma unroll
            for (int ks = 0; ks < 2; ++ks) { const bf16x8 bfrag = *(const LAS bf16x8*)(xab + (16 * tt + fr) * 72 + 8 * fq + 32 * ks);
                aR = __builtin_amdgcn_mfma_f32_16x16x32_bf16(wR[ks], bfrag, aR, 0, 0, 0); aG = __builtin_amdgcn_mfma_f32_16x16x32_bf16(wG[ks], bfrag, aG, 0, 0, 0); }
            const f32x4 xv = *(const LAS f32x4*)(xaf + (16 * tt + fr) * 68 + 16 * g + 4 * fq);
            f32x4 hv;
#pragma unroll
            for (int e = 0; e < 4; ++e) {
                const float r = sigm(aR[e] + ba[e]), gi = sigm(aG[e] + bxv[e]);
                const float la = -r * sp8[e], a = __expf(la), x2 = -2.0f * la;
                const float om = x2 < 0.1f ? x2 * (1.0f - x2 * (0.5f - x2 * (0.16666667f - x2 * 0.041666668f))) : 1.0f - a * a;
                float Av = a, Bv = sqrtf(om) * gi * xv[e];
#pragma unroll
                for (int off = 1; off < 16; off <<= 1) { const int src = d ? lane + off : lane - off; const float Ap = __shfl(Av, src), Bp = __shfl(Bv, src);
                    const bool valid = d ? (fr + off < 16) : (fr >= off); if (valid) { Bv = Av * Bp + Bv; Av = Av * Ap; } }
                const float h = Av * hin[e] + Bv; hv[e] = h; hin[e] = __shfl(h, lastl);
            }
            if (wr_h) *(f32x4*)(HX + (size_t)(rowbase + t0 + 16 * tt + fr) * DLRU + cb) = hv;
        }
#pragma unroll
        for (int k = 0; k < 4; ++k) { zc[k][0] = zn[k][0]; zc[k][1] = zn[k][1]; }
    }
    asm volatile("s_waitcnt vmcnt(0)" ::: "memory");
    __syncthreads();
    {
        const float* HF = (const float*)(ws + WS_HF); const float* HB = (const float*)(ws + WS_HB);
        const int t = tid >> 3, i8 = (tid & 7) * 8, Cc = head * 64 + i8;
        for (int sc = (l == 0 ? 0 : 4); sc < NSC; ++sc) {
            const int row = (sc < 4 ? RL + bl * CTXL + sc * 64 : bl * SEQ + (sc - 4) * 64) + t;
            float zg[8]; unpack8(*(const u32x4*)(Z + (size_t)row * ZN + Z_LG + Cc), zg);
            const f32x4 f0 = *(const f32x4*)(HF + (size_t)row * DLRU + Cc), f1 = *(const f32x4*)(HF + (size_t)row * DLRU + Cc + 4), b0 = *(const f32x4*)(HB + (size_t)row * DLRU + Cc), b1 = *(const f32x4*)(HB + (size_t)row * DLRU + Cc + 4);
            float y[8];
#pragma unroll
            for (int e = 0; e < 8; ++e) { const float hs = e < 4 ? f0[e & 3] + b0[e & 3] : f1[e & 3] + b1[e & 3]; const float x = zg[e];
                const float u2 = 1.5957691216057308f * (x + 0.044715f * x * x * x);
                y[e] = hs * x * sigm(u2); }
            *(u32x4*)((bf16_t*)(ws + WS_Y) + (size_t)row * YN + Cc) = pack8(y);
        }
    }
}

__device__ __forceinline__ void seg_decode(int it, int& rowbase, int& s0, int& lob, int& hib, int& Lseq) {
    if (it < 512) { const int bl = it >> 5, sg = it & 31; rowbase = bl * SEQ; s0 = sg * 64; lob = s0; hib = s0 + 64; Lseq = SEQ; }
    else { const int j = it - 512, bl = j >> 2, q = j & 3; rowbase = RL + bl * CTXL; s0 = q * 64; lob = 0; hib = CTXL; Lseq = CTXL; }
}
__device__ __forceinline__ void pool_item(ArgP A, int it, LAS unsigned char* lds, const int tid) {
    unsigned char* ws = A->ws;
    int rowbase, s0, lob, hib, Lseq; seg_decode(it, rowbase, s0, lob, hib, Lseq);
    const bf16_t* Z = (const bf16_t*)(ws + WS_Z);
    LAS float* tile = (LAS float*)lds;
    { const int rr = tid >> 5, c8 = (tid & 31) * 8;
#pragma unroll
      for (int ps = 0; ps < 5; ++ps) { const int jr = ps * 16 + rr, tok = s0 - 8 + jr;
          if (tok >= lob && tok < hib) { float z[8]; unpack8(*(const u32x4*)(Z + (size_t)(rowbase + tok) * ZN + Z_POOL + c8), z);
              *(LAS f32x4*)(tile + jr * 256 + c8) = (f32x4){z[0], z[1], z[2], z[3]}; *(LAS f32x4*)(tile + jr * 256 + c8 + 4) = (f32x4){z[4], z[5], z[6], z[7]}; } } }
    __syncthreads();
    const int chn = tid & 255, half = tid >> 8, w2 = 1 << (chn >> 6);
    bf16_t* Y = (bf16_t*)(ws + WS_Y);
    for (int t = half * 32; t < half * 32 + 32; ++t) { const int tok = s0 + t; const int lo = max(tok - w2, lob), hi = min(tok + w2, hib);
        float s = 0.f; for (int j = lo; j < hi; ++j) s += tile[(j - s0 + 8) * 256 + chn];
        const float pv = s / (float)(hi - lo) - tile[(t + 8) * 256 + chn];
        Y[(size_t)(rowbase + tok) * YN + Y_POOL + chn] = (bf16_t)(cvt_pk_bf16(pv, 0.f) & 0xffffu); }
}
__device__ __forceinline__ void sconv_item(ArgP A, int l, int it, const int tid) {
    unsigned char* ws = A->ws;
    int rowbase, s0, lob, hib, Lseq; seg_decode(it, rowbase, s0, lob, hib, Lseq);
    const bf16_t* Z = (const bf16_t*)(ws + WS_Z);
    const int c8 = (tid & 31) * 8, tr = tid >> 5;
    const float* sw = A->in[I_SCW] + (size_t)l * 3 * 256 + c8;
#pragma unroll
    for (int ps = 0; ps < 4; ++ps) { const int tok = s0 + ps * 16 + tr; float acc[8];
#pragma unroll
        for (int e = 0; e < 8; ++e) acc[e] = 0.f;
#pragma unroll
        for (int dt = -1; dt <= 1; ++dt) { const int tt = tok + dt;
            if (tt >= 0 && tt < Lseq) { float gc[8], hs[8]; const bf16_t* zr = Z + (size_t)(rowbase + tt) * ZN + Z_SC + c8; unpack8(*(const u32x4*)(zr + 256), gc); unpack8(*(const u32x4*)(zr + 512), hs);
                const f32x4 w0 = *(const f32x4*)(sw + (dt + 1) * 256), w1 = *(const f32x4*)(sw + (dt + 1) * 256 + 4);
#pragma unroll
                for (int e = 0; e < 4; ++e) { acc[e] += gc[e] * hs[e] * w0[e]; acc[4 + e] += gc[4 + e] * hs[4 + e] * w1[e]; } } }
        float gb[8]; unpack8(*(const u32x4*)(Z + (size_t)(rowbase + tok) * ZN + Z_SC + c8), gb);
#pragma unroll
        for (int e = 0; e < 8; ++e) acc[e] *= gb[e];
        *(u32x4*)((bf16_t*)(ws + WS_Y) + (size_t)(rowbase + tok) * YN + Y_SC + c8) = pack8(acc); }
}

__device__ __forceinline__ int fetch_item(unsigned* ctr, LAS unsigned char* lds, const int tid) {
    LAS unsigned* slot = (LAS unsigned*)(lds + QSLOT_OFF);
    __syncthreads();
    if (tid == 0) *slot = atomicAdd(ctr, 1u);
    __syncthreads();
    return (int)*slot;
}


#define XB_TMO      128
#define XB_XCNT(j)  (256  + 64 * (j))
#define XB_XSUB(j)  (1280 + 64 * (j))
#define XB_XGEN(j)  (2304 + 64 * (j))
#define XB_TOP      3328
#define XB_TOPGEN   3392
#define XCD_BAR_WORDS 3456
#define XB_SPIN_CAP (1u << 22)
__device__ __forceinline__ unsigned xb_ld(unsigned* p)              { return __hip_atomic_load(p, __ATOMIC_RELAXED, __HIP_MEMORY_SCOPE_AGENT); }
__device__ __forceinline__ unsigned xb_add(unsigned* p, unsigned v) { return __hip_atomic_fetch_add(p, v, __ATOMIC_RELAXED, __HIP_MEMORY_SCOPE_AGENT); }
__device__ __forceinline__ unsigned xb_xcc_id() { return (unsigned)__builtin_amdgcn_s_getreg((3 << 11) | 20) & 0xFu; }
#define XB_SPIN(cond, bar) do { unsigned _sp = 0; while (cond) { __builtin_amdgcn_s_sleep(1); \
    if ((++_sp & 255u) == 0u) { if (xb_ld(&(bar)[XB_TMO])) break; if (_sp > XB_SPIN_CAP) { atomicAdd(&(bar)[XB_TMO], 1u); break; } } } } while (0)
struct XcdBarrier { unsigned* bar; unsigned x; volatile LAS unsigned* st; };
__device__ __forceinline__ XcdBarrier xcd_barrier_post(unsigned* bar, volatile LAS unsigned* st) {
    XcdBarrier b; b.bar = bar; b.x = xb_xcc_id(); b.st = st;
    if (threadIdx.x == 0) (void)xb_add(&bar[XB_XCNT(b.x)], 1u);
    return b;
}
__device__ __forceinline__ void xcd_barrier_complete(unsigned* bar, unsigned x, unsigned& nloc, unsigned& nx) {
    const unsigned G = gridDim.x * gridDim.y * gridDim.z;
    unsigned sum, cnt, mine, sp = 0u;
    for (;;) {
        sum = 0u; cnt = 0u; mine = 0u;
#pragma unroll
        for (unsigned j = 0; j < 16; ++j) { const unsigned c = xb_ld(&bar[XB_XCNT(j)]); sum += c; cnt += (c > 0u) ? 1u : 0u; mine = (j == x) ? c : mine; }
        if (sum == G) break;
        __builtin_amdgcn_s_sleep(1);
        if ((++sp & 255u) == 0u) { if (xb_ld(&bar[XB_TMO])) break; if (sp > XB_SPIN_CAP) { atomicAdd(&bar[XB_TMO], 1u); break; } }
    }
    nloc = mine > 0u ? mine : 1u; nx = cnt > 0u ? cnt : 1u;
}
__device__ __forceinline__ void xcd_barrier(const XcdBarrier& b) {
    asm volatile("s_waitcnt vmcnt(0)" ::: "memory");
    __syncthreads();
    if (threadIdx.x == 0) {
        unsigned* bar = b.bar;
        __builtin_amdgcn_s_waitcnt(0);
        unsigned nloc = b.st[0], nx = b.st[1];
        if (nloc == 0u) { xcd_barrier_complete(bar, b.x, nloc, nx); b.st[0] = nloc; b.st[1] = nx; }
        const unsigned old = xb_add(&bar[XB_XSUB(b.x)], 1u);
        const unsigned gen = old / nloc;
        if (old + 1u == (gen + 1u) * nloc) {
            __builtin_amdgcn_fence(__ATOMIC_RELEASE, "agent");
            asm volatile("s_waitcnt vmcnt(0)" ::: "memory");
            const unsigned og = xb_add(&bar[XB_TOP], 1u);
            const unsigned tg = og / nx;
            if (og + 1u == (tg + 1u) * nx) xb_add(&bar[XB_TOPGEN], 1u);
            else XB_SPIN(xb_ld(&bar[XB_TOPGEN]) == tg, bar);
            __builtin_amdgcn_fence(__ATOMIC_ACQUIRE, "agent");
            xb_add(&bar[XB_XGEN(b.x)], 1u);
            asm volatile("s_waitcnt vmcnt(0)" ::: "memory");
        } else {
            XB_SPIN(xb_ld(&bar[XB_XGEN(b.x)]) == gen, bar);
            __builtin_amdgcn_fence(__ATOMIC_ACQUIRE, "agent");
            asm volatile("s_waitcnt vmcnt(0)" ::: "memory");
        }
    }
    __syncthreads();
}

template <bool COOP>
__global__ void __launch_bounds__(512, 2) fwd_kernel(Args Aparam) {
    extern __shared__ __attribute__((aligned(16))) unsigned char lds_raw[];
    LAS unsigned char* lds = (LAS unsigned char*)lds_raw;
    const int G = gridDim.x;
    ArgP A = (ArgP)__builtin_amdgcn_kernarg_segment_ptr();
    const int ph_lo = A->ph_lo, ph_hi = A->ph_hi;
    XcdBarrier xbar; xbar.bar = nullptr; xbar.x = 0; xbar.st = (volatile LAS unsigned*)(lds + QSLOT_OFF + 16);
    if constexpr (COOP) {
        if (threadIdx.x < 2) xbar.st[threadIdx.x] = 0u;
        __syncthreads();
        xbar = xcd_barrier_post((unsigned*)(A->ws + WS_CTL) + 8192, xbar.st);
    }
    for (int ph = ph_lo; ph < ph_hi; ++ph) {
        asm volatile("" : "+s"(A));
        int tid = threadIdx.x; asm volatile("" : "+v"(tid));
        unsigned* ctl = (unsigned*)(A->ws + WS_CTL);
        if (ph < PH_BASE) p0_prologue(A, lds, G, tid);
        else if (ph == NPHASE - 1) final_norm(A, G, tid);
        else {
            const int q = ph - PH_BASE, kj = q % PH_PER, lc = q / PH_PER, l = lc >> 1, ch = lc & 1;
            const int PKJ = PROBE_K < 3 ? PROBE_K : PROBE_K - 1;
            const int kq = (PROBE_K >= 0 && PROBE_K <= 8 && kj > PKJ) ? kj - 1 : kj;
            const int k = kq < 3 ? kq : kq + 1;
            if (k == 0 || k == 6) norm_phase(A, l, ch, k == 6, G, tid);
            else {
                Sched S; S.kind = k; S.l = l; S.ch = ch; S.G = G; S.c = (int)blockIdx.x; S.ap = A;
                pg8::Gemm g; g.lda = (k == 2 || k == 8) ? 4096 : (k == 4 ? YN : DM); g.ldb = g.lda;
                if (k == 1 || k == 2 || k == 7) { pg8::EpiBf E; E.act = (k == 7) ? 1 : 0; pg8::gemm_phase<pg8::EpiBf, Sched>(lds, g, S, E, tid); }
                else if (k == 4) { pg8::EpiMerge E; pg8::gemm_phase<pg8::EpiMerge, Sched>(lds, g, S, E, tid); }
                else { pg8::EpiRes E; pg8::gemm_phase<pg8::EpiRes, Sched>(lds, g, S, E, tid); }
                if (k == 2) {
                    for (int it = (int)blockIdx.x - (G >> 1); it >= 0 && it < NB * 8; it += G - (G >> 1)) lru_sweep(A, l, it, lds, tid);
                    const int nseg = (l == 0) ? 576 : 512, total = 2 * nseg;
                    for (;;) { const int it = fetch_item(ctl + 64 * ph, lds, tid); if (it >= total) break;
                        if (it < nseg) pool_item(A, it, lds, tid);
                        else sconv_item(A, l, it - nseg, tid); }
                }
            }
        }
        if (ph + 1 < ph_hi) { if constexpr (COOP) { if (ph == 0) cg::this_grid().sync(); else xcd_barrier(xbar); } }
    }
}

extern "C" void kernel_launch(void* const* d_in, const int* in_sizes, int n_in, void* d_out, int out_size, void* d_ws, size_t ws_size, hipStream_t stream) {
    static int grid = 0;
    if (grid == 0) {
        if (n_in != 27 || out_size != NBATCH * SEQ * DM || ws_size < WS_END) { fprintf(stderr, "kernel_launch: unexpected shapes (n_in %d out %d ws %zu)\n", n_in, out_size, ws_size); grid = -1; return; }
        int dev = 0, cus = 0, per_cu = 0;
        hipGetDevice(&dev); hipDeviceGetAttribute(&cus, hipDeviceAttributeMultiprocessorCount, dev);
        hipFuncSetAttribute((const void*)fwd_kernel<true>, hipFuncAttributeMaxDynamicSharedMemorySize, LDS_BYTES);
        hipFuncSetAttribute((const void*)fwd_kernel<false>, hipFuncAttributeMaxDynamicSharedMemorySize, LDS_BYTES);
        hipOccupancyMaxActiveBlocksPerMultiprocessor(&per_cu, (const void*)fwd_kernel<true>, 512, LDS_BYTES);
        (void)hipGetLastError();
        if (per_cu < 1) per_cu = 1;
        grid = cus * 1;
        if (grid <= 0) grid = 256;
    }
    if (grid < 0) return;
    hipMemsetAsync((char*)d_ws + WS_CTL, 0, CTL_ZERO_BYTES, stream);
    Args a{};
    for (int i = 0; i < 27; ++i) a.in[i] = (const float*)d_in[i];
    a.out = (float*)d_out; a.ws = (unsigned char*)d_ws;
#if MK_COOP
    a.ph_lo = 0; a.ph_hi = NPHASE;
    void* args[] = {&a};
    hipError_t e = hipLaunchCooperativeKernel((const void*)fwd_kernel<true>, dim3(grid), dim3(512), args, LDS_BYTES, stream);
    if (e != hipSuccess) fprintf(stderr, "cooperative launch failed: %s (grid %d)\n", hipGetErrorString(e), grid);
#else
    for (int ph = 0; ph < NPHASE; ++ph) { a.ph_lo = ph; a.ph_hi = ph + 1; hipLaunchKernelGGL(fwd_kernel<false>, dim3(grid), dim3(512), LDS_BYTES, stream, a); }
#endif
}
```

```cpp
#include <hip/hip_runtime.h>
#include <hip/hip_cooperative_groups.h>
#include <cstdio>
#include <cstdint>
namespace cg = cooperative_groups;

#ifndef MK_COOP
#define MK_COOP 1
#endif
#define PROBE_SUB 7
#define PROBE_K -1

#define LAS __attribute__((address_space(3)))
typedef unsigned short bf16_t;
typedef short bf16x8 __attribute__((ext_vector_type(8)));
typedef float f32x4 __attribute__((ext_vector_type(4)));
typedef float f32x2 __attribute__((ext_vector_type(2)));
typedef unsigned u32x4 __attribute__((ext_vector_type(4)));
typedef unsigned u32x2 __attribute__((ext_vector_type(2)));

constexpr int NBATCH = 32, SEQ = 2048, CTXL = 256, DM = 1024, DEPTH = 2, DLRU = 512, NIN = 6400, DFF = 4096;
constexpr int NB = 16, NCH = 2;
constexpr int RL = NB * SEQ, RC = NB * CTXL, RT = RL + RC;
constexpr int ZN = 6144, YN = 1280;
constexpr int Z_LG = 512, Z_POOL = 1024, Z_SC = 1280, Z_GATE = 2048;
constexpr int Y_F = 512, Y_POOL = 768, Y_SC = 1024;
constexpr int NSC = 36;
constexpr size_t MiB = 1u << 20;
constexpr size_t WS_CTL = 0, CTL_ZERO_BYTES = 65536;
constexpr size_t WS_MOD = 1 * MiB, WS_WG = 3 * MiB, WS_SUMA = 4 * MiB, WS_SUMH = 7 * MiB, WS_DFTC = 10 * MiB, WS_DFT = 12 * MiB;
constexpr size_t WS_WIN = 28 * MiB, WS_WF = 52 * MiB, WS_WBR = 54 * MiB, WS_WOUT = 60 * MiB, WS_W1 = 64 * MiB, WS_W2 = 80 * MiB;
constexpr size_t WS_CTXW = 96 * MiB, WS_U = 128 * MiB, WS_MRG = 200 * MiB, WS_PT = 272 * MiB, WS_PTC = 304 * MiB, WS_Y = 336 * MiB, WS_Z = 432 * MiB;
constexpr size_t WS_HF = WS_Z + (size_t)RT * ZN * 2, WS_HB = WS_HF + (size_t)RT * DLRU * 4;
constexpr size_t WS_END = WS_HB + (size_t)RT * DLRU * 4;
static_assert(WS_END <= 1024 * MiB, "workspace map");
static_assert(WS_Y + (size_t)RT * YN * 2 <= WS_Z && WS_PTC + (size_t)NB * 256 * 4096 * 2 <= WS_Y && WS_MRG + (size_t)RT * DM * 2 <= WS_PT, "workspace map 2");
constexpr int LDS_BYTES = 147456, RING_BYTES = 131072, QSLOT_OFF = LDS_BYTES - 64;
constexpr int PH_PER = 7 + ((PROBE_K >= 1 && PROBE_K <= 8) ? 1 : 0), PH_BASE = (PROBE_K == 9) ? 2 : 1;
constexpr int NPHASE = PH_BASE + 2 + DEPTH * NCH * PH_PER;

__device__ __forceinline__ float bf_lo(unsigned w) { return __uint_as_float(w << 16); }
__device__ __forceinline__ float bf_hi(unsigned w) { return __uint_as_float(w & 0xffff0000u); }
__device__ __forceinline__ unsigned cvt_pk_bf16(float lo, float hi) { unsigned r; asm volatile("v_cvt_pk_bf16_f32 %0, %1, %2" : "=v"(r) : "v"(lo), "v"(hi)); return r; }
__device__ __forceinline__ float sigm(float x) { return __builtin_amdgcn_rcpf(1.0f + __expf(-x)); }
__device__ __forceinline__ float wave_sum(float v) {
#pragma unroll
    for (int o = 1; o < 64; o <<= 1) v += __shfl_xor(v, o);
    return v;
}
#define LDS_WAIT() asm volatile("s_waitcnt lgkmcnt(0)" ::: "memory")
#define DPP_SHR(ident, v, N) __builtin_bit_cast(float, __builtin_amdgcn_update_dpp(__builtin_bit_cast(int, (float)(ident)), __builtin_bit_cast(int, (float)(v)), 0x110 + (N), 0xf, 0xf, false))
#define SCAN_STEP(N) do { const float Ap_ = DPP_SHR(1.0f, Av, N), Bp_ = DPP_SHR(0.0f, Bv, N); Bv = Av * Bp_ + Bv; Av = Av * Ap_; } while (0)

namespace pg8 {
constexpr int BM = 256, BK = 64, HALF = 128, HTB = HALF * BK * 2, STAGE_BYTES = 8 * HTB, NXCD = 8, WGM = 8;
__host__ __device__ __forceinline__ int lds_byte(int r, int c) { const int st = (r >> 4) * 2 + (c >> 5), rr = r & 15, cc = c & 31, ob = rr * 64 + cc * 2; return st * 1024 + (ob ^ (((ob >> 9) & 1) << 5)); }
__host__ __device__ __forceinline__ void stage_rc(int b, int& R, int& C) { const int st = b / 1024, sb = b % 1024, swz = sb ^ (((sb >> 9) & 1) << 5); R = (st >> 1) * 16 + swz / 64; C = (st & 1) * 32 + (swz % 64) / 2; }
__host__ __device__ __forceinline__ int perm32(int rho) { const int n = rho >> 4, i = rho & 15; return 8 * (i >> 2) + 4 * n + (i & 3); }

struct Unit { const char* a; const char* b; char* dst; const char* x0; const char* x1; int nt, seg, ldc; float scale; };
struct Gemm { int lda, ldb; };

__device__ __forceinline__ bool tile_of(long L, int nM, int nN, int& pm, int& pn) {
    const int nwg = nM * nN; if (L >= nwg) return false;
    int wgid = (int)L; { const int q = nwg / NXCD, r = nwg % NXCD, xcd = wgid % NXCD, off = wgid / NXCD; wgid = (xcd < r ? xcd * (q + 1) : r * (q + 1) + (xcd - r) * q) + off; }
    const int nig = WGM * nN, gid = wgid / nig, fm = gid * WGM, gsz = (nM - fm) < WGM ? (nM - fm) : WGM;
    pm = fm + ((wgid % nig) % gsz); pn = (wgid % nig) / gsz; return true;
}

struct EpiBf {
    static constexpr bool PERM = true;
    int act;
    __device__ __forceinline__ bool operator()(f32x4 (&acc)[2][2][4][2], const Unit& u, int wr, int wc, int fr, int fq) const {
        bf16_t* base = (bf16_t*)u.dst + (size_t)(wr * 64 + fr) * u.ldc + wc * 32 + 8 * fq;
        const float sc = u.scale;
#pragma unroll
        for (int ai = 0; ai < 2; ++ai)
#pragma unroll
            for (int m = 0; m < 4; ++m) { bf16_t* rowp = base + (size_t)(ai * HALF + m * 16) * u.ldc;
#pragma unroll
                for (int bj = 0; bj < 2; ++bj) { f32x4 v0 = acc[ai][bj][m][0], v1 = acc[ai][bj][m][1];
                    if (u.seg == 2) {
#pragma unroll
                        for (int e = 0; e < 4; ++e) { v0[e] = 1.0f + __builtin_amdgcn_exp2f(fminf(v0[e] * -1.4426950408889634f, 40.f)); v1[e] = 1.0f + __builtin_amdgcn_exp2f(fminf(v1[e] * -1.4426950408889634f, 40.f)); } }
                    if (act == 1) {
#pragma unroll
                        for (int e = 0; e < 4; ++e) { const float a = fmaxf(v0[e], 0.f), b = fmaxf(v1[e], 0.f); v0[e] = a * a; v1[e] = b * b; } }
                    v0 = v0 * sc; v1 = v1 * sc;
                    u32x4 w; w.x = cvt_pk_bf16(v0[0], v0[1]); w.y = cvt_pk_bf16(v0[2], v0[3]); w.z = cvt_pk_bf16(v1[0], v1[1]); w.w = cvt_pk_bf16(v1[2], v1[3]);
                    *(u32x4*)(rowp + bj * HALF) = w; } }
        return true;
    }
};
struct EpiRes {
    static constexpr bool PERM = false;
    __device__ __forceinline__ bool operator()(f32x4 (&acc)[2][2][4][2], const Unit& u, int wr, int wc, int fr, int fq) const {
        const float* gv = (const float*)u.x1 + wc * 32 + 4 * fq;
        f32x4 g[2][2];
#pragma unroll
        for (int bj = 0; bj < 2; ++bj)
#pragma unroll
            for (int n = 0; n < 2; ++n) g[bj][n] = *(const f32x4*)(gv + bj * HALF + n * 16);
        const size_t o0 = (size_t)(wr * 64 + fr) * DM + wc * 32 + 4 * fq;
        const float* bs = (const float*)u.x0 + o0; float* od = (float*)u.dst + o0;
        f32x4 bc[2][2];
#pragma unroll
        for (int bj = 0; bj < 2; ++bj)
#pragma unroll
            for (int n = 0; n < 2; ++n) bc[bj][n] = *(const f32x4*)(bs + bj * HALF + n * 16);
#pragma unroll
        for (int am = 0; am < 8; ++am) { const int ai = am >> 2, m = am & 3; const size_t off = (size_t)(ai * HALF + m * 16) * DM;
            f32x4 bn[2][2];
            if (am < 7) { const size_t offn = (size_t)(((am + 1) >> 2) * HALF + ((am + 1) & 3) * 16) * DM;
#pragma unroll
                for (int bj = 0; bj < 2; ++bj)
#pragma unroll
                    for (int n = 0; n < 2; ++n) bn[bj][n] = *(const f32x4*)(bs + offn + bj * HALF + n * 16); }
#pragma unroll
            for (int bj = 0; bj < 2; ++bj)
#pragma unroll
                for (int n = 0; n < 2; ++n) *(f32x4*)(od + off + bj * HALF + n * 16) = bc[bj][n] + g[bj][n] * acc[ai][bj][m][n];
            if (am < 7) {
#pragma unroll
                for (int bj = 0; bj < 2; ++bj)
#pragma unroll
                    for (int n = 0; n < 2; ++n) bc[bj][n] = bn[bj][n]; }
        }
        return true;
    }
};
struct EpiMerge {
    static constexpr bool PERM = true;
    __device__ __forceinline__ void apply(const bool LAST, f32x4 (&acc)[2][2][4][2], const Unit& u, int wr, int wc, int fr, int fq) const {
        const bf16_t* g0 = (const bf16_t*)u.x0 + (size_t)(wr * 64 + fr) * ZN + wc * 32 + 8 * fq;
        bf16_t* base = (bf16_t*)u.dst + (size_t)(wr * 64 + fr) * DM + wc * 32 + 8 * fq;
        const int gboff = LAST ? 0 : DM;
        u32x4 ga[2][2][2], gb[2][2][2];
#pragma unroll
        for (int mm = 0; mm < 2; ++mm)
#pragma unroll
            for (int bj = 0; bj < 2; ++bj) { const bf16_t* rp = g0 + (size_t)(mm * 16) * ZN + bj * HALF; ga[0][mm][bj] = *(const u32x4*)rp; gb[0][mm][bj] = *(const u32x4*)(rp + gboff); }
#pragma unroll
        for (int am = 0; am < 4; ++am) { const int ai = am >> 1, m0 = (am & 1) * 2, cb_ = am & 1, nb_ = cb_ ^ 1;
            if (am < 3) { const int ai2 = (am + 1) >> 1, m02 = ((am + 1) & 1) * 2;
#pragma unroll
                for (int mm = 0; mm < 2; ++mm)
#pragma unroll
                    for (int bj = 0; bj < 2; ++bj) { const bf16_t* rp = g0 + (size_t)(ai2 * HALF + (m02 + mm) * 16) * ZN + bj * HALF; ga[nb_][mm][bj] = *(const u32x4*)rp; gb[nb_][mm][bj] = *(const u32x4*)(rp + gboff); } }
            asm volatile("" ::: "memory");
#pragma unroll
            for (int mm = 0; mm < 2; ++mm)
#pragma unroll
                for (int bj = 0; bj < 2; ++bj) { const int m = m0 + mm;
                    f32x4 v0 = acc[ai][bj][m][0], v1 = acc[ai][bj][m][1];
#pragma unroll
                    for (int e = 0; e < 4; ++e) {
                        const unsigned wa = ga[cb_][mm][bj][e], wb = gb[cb_][mm][bj][e];
                        const float f0 = (LAST ? 1.f : bf_lo(wb)) * __builtin_amdgcn_rcpf(bf_lo(wa)), f1 = (LAST ? 1.f : bf_hi(wb)) * __builtin_amdgcn_rcpf(bf_hi(wa));
                        if (e < 2) { v0[2 * e] *= f0; v0[2 * e + 1] *= f1; } else { v1[2 * (e - 2)] *= f0; v1[2 * (e - 2) + 1] *= f1; }
                    }
                    acc[ai][bj][m][0] = v0; acc[ai][bj][m][1] = v1;
                    if (LAST) { u32x4 w; w.x = cvt_pk_bf16(v0[0], v0[1]); w.y = cvt_pk_bf16(v0[2], v0[3]); w.z = cvt_pk_bf16(v1[0], v1[1]); w.w = cvt_pk_bf16(v1[2], v1[3]);
                        *(u32x4*)(base + (size_t)(ai * HALF + m * 16) * DM + bj * HALF) = w; }
                }
        }
    }
    __device__ __forceinline__ bool operator()(f32x4 (&acc)[2][2][4][2], const Unit& u, int wr, int wc, int fr, int fq) const {
        const bool last = (u.seg == 3); apply(last, acc, u, wr, wc, fr, fq); return last;
    }
};

template <class Epi, class Sched>
__device__ __forceinline__ void gemm_phase(LAS unsigned char* lds, const Gemm g, const Sched& S, const Epi& E, const int tid) {
    const int wid = __builtin_amdgcn_readfirstlane(tid >> 6), lane = tid & 63, wr = wid >> 2, wc = wid & 3, fr = lane & 15, fq = lane >> 4;
    unsigned voffA[2], voffB[2];
#pragma unroll
    for (int i = 0; i < 2; ++i) { int R, C; stage_rc(tid * 16 + i * 8192, R, C); const int Rb = Epi::PERM ? ((R & ~31) + perm32(R & 31)) : R;
        voffA[i] = (unsigned)(R * g.lda + C) * 2u; voffB[i] = (unsigned)(Rb * g.ldb + C) * 2u; }
    const size_t kstep = (size_t)(BK * 2);
    const size_t hstepA = (size_t)HALF * g.lda * 2, hstepB = (size_t)HALF * g.ldb * 2;
    const unsigned ldsw = (unsigned)wid * 1024u;
    const int aoff = lds_byte(wr * 64 + fr, fq * 8), boff = lds_byte(wc * 32 + fr, fq * 8);
#define PG8_SA(b, h) (((b) * 2 + (h)) * HTB)
#define PG8_SB(b, h) ((4 + (b) * 2 + (h)) * HTB)
#define PG8_STAGE(bufoff, gbase, voff) do { _Pragma("unroll") for (int _i = 0; _i < 2; ++_i) \
        __builtin_amdgcn_global_load_lds((const unsigned*)((const char*)(gbase) + (voff)[_i]), (LAS unsigned*)(lds + (bufoff) + ldsw + _i * 8192), 16, 0, 0); } while (0)
#define PG8_LDA(dst, b, h) do { _Pragma("unroll") for (int m = 0; m < 4; ++m) _Pragma("unroll") for (int k = 0; k < 2; ++k) dst[m][k] = *(const LAS bf16x8*)(lds + PG8_SA(b, h) + aoff + m * 2048 + k * 1024); } while (0)
#define PG8_LDB(dst, b, h) do { _Pragma("unroll") for (int n = 0; n < 2; ++n) _Pragma("unroll") for (int k = 0; k < 2; ++k) dst[n][k] = *(const LAS bf16x8*)(lds + PG8_SB(b, h) + boff + n * 2048 + k * 1024); } while (0)
#define PG8_MMA(ai, bj, At, Bt) do { __builtin_amdgcn_s_setprio(1); _Pragma("unroll") for (int m = 0; m < 4; ++m) _Pragma("unroll") for (int n = 0; n < 2; ++n) _Pragma("unroll") for (int k = 0; k < 2; ++k) \
        acc[ai][bj][m][n] = __builtin_amdgcn_mfma_f32_16x16x32_bf16(Bt[n][k], At[m][k], acc[ai][bj][m][n], 0, 0, 0); __builtin_amdgcn_s_setprio(0); } while (0)
#define PG8_WAIT_V(n) asm volatile("s_waitcnt vmcnt(" #n ")" ::: "memory")
#define PG8_WAIT_L(n) asm volatile("s_waitcnt lgkmcnt(" #n ")" ::: "memory")
#define PG8_BAR __builtin_amdgcn_s_barrier()
#define PG8_SCHED __builtin_amdgcn_sched_barrier(0)
    Unit cur, nxt; int ui = 0;
    if (!S.next(0, cur)) return;
    f32x4 acc[2][2][4][2];
#pragma unroll
    for (int a = 0; a < 2; ++a)
#pragma unroll
        for (int b = 0; b < 2; ++b)
#pragma unroll
            for (int m = 0; m < 4; ++m)
#pragma unroll
                for (int n = 0; n < 2; ++n) acc[a][b][m][n] = (f32x4){0.f, 0.f, 0.f, 0.f};
    bf16x8 At[4][2], B0[2][2], B1[2][2];
    const char* cA = cur.a; const char* cB = cur.b;
    PG8_STAGE(PG8_SB(0, 0), cB, voffB); PG8_STAGE(PG8_SB(0, 1), cB + hstepB, voffB); PG8_STAGE(PG8_SA(0, 0), cA, voffA); PG8_STAGE(PG8_SA(0, 1), cA + hstepA, voffA);
    if (wr == 1) PG8_BAR;
    PG8_WAIT_V(2); PG8_BAR;
    PG8_STAGE(PG8_SB(1, 0), cB + kstep, voffB); PG8_STAGE(PG8_SA(1, 0), cA + kstep, voffA); PG8_STAGE(PG8_SB(1, 1), cB + hstepB + kstep, voffB);
    PG8_WAIT_V(6); PG8_BAR;
    for (;;) {
        const bool has_next = S.next(ui + 1, nxt);
        const char* nA = has_next ? nxt.a : cA; const char* nB = has_next ? nxt.b : cB;
        const int nt = cur.nt;
        for (int t = 0; t < nt; t += 2) {
            const bool last = (t == nt - 2);
            const char* a1 = cA + (size_t)(t + 1) * kstep;
            const char* a2 = last ? nA : cA + (size_t)(t + 2) * kstep; const char* b2 = last ? nB : cB + (size_t)(t + 2) * kstep;
            const char* a3 = a2 + kstep; const char* b3 = b2 + kstep;
            PG8_LDB(B0, 0, 0); PG8_LDB(B1, 0, 1); PG8_SCHED; PG8_LDA(At, 0, 0); PG8_STAGE(PG8_SA(1, 1), a1 + hstepA, voffA);
            PG8_WAIT_V(8); PG8_WAIT_L(0); PG8_BAR; PG8_MMA(0, 0, At, B0); PG8_MMA(0, 1, At, B1); PG8_BAR; PG8_SCHED;
            PG8_LDA(At, 0, 1); PG8_STAGE(PG8_SB(0, 0), b2, voffB); PG8_STAGE(PG8_SB(0, 1), b2 + hstepB, voffB); PG8_STAGE(PG8_SA(0, 0), a2, voffA);
            PG8_WAIT_V(8); PG8_WAIT_L(0); PG8_BAR; PG8_MMA(1, 0, At, B0); PG8_MMA(1, 1, At, B1); PG8_BAR; PG8_SCHED;
            PG8_LDB(B0, 1, 0); PG8_LDB(B1, 1, 1); PG8_SCHED; PG8_LDA(At, 1, 0); PG8_STAGE(PG8_SA(0, 1), a2 + hstepA, voffA);
            PG8_WAIT_V(8); PG8_WAIT_L(0); PG8_BAR; PG8_MMA(0, 0, At, B0); PG8_MMA(0, 1, At, B1); PG8_BAR; PG8_SCHED;
            PG8_LDA(At, 1, 1); PG8_STAGE(PG8_SB(1, 0), b3, voffB); PG8_STAGE(PG8_SB(1, 1), b3 + hstepB, voffB); PG8_STAGE(PG8_SA(1, 0), a3, voffA);
            PG8_WAIT_V(8); PG8_WAIT_L(0); PG8_BAR; PG8_MMA(1, 0, At, B0); PG8_MMA(1, 1, At, B1); PG8_BAR; PG8_SCHED;
        }
        if (wr == 0) PG8_BAR;
        const bool zero = E(acc, cur, wr, wc, fr, fq);
        if (!has_next) break;
        if (zero) {
#pragma unroll
            for (int a = 0; a < 2; ++a)
#pragma unroll
                for (int b = 0; b < 2; ++b)
#pragma unroll
                    for (int m = 0; m < 4; ++m)
#pragma unroll
                        for (int n = 0; n < 2; ++n) acc[a][b][m][n] = (f32x4){0.f, 0.f, 0.f, 0.f};
        }
        cur = nxt; cA = nA; cB = nB; ++ui;
        if (wr == 1) PG8_BAR;
    }
    PG8_WAIT_V(0);
    PG8_BAR;
#undef PG8_SA
#undef PG8_SB
#undef PG8_STAGE
#undef PG8_LDA
#undef PG8_LDB
#undef PG8_MMA
#undef PG8_WAIT_V
#undef PG8_WAIT_L
#undef PG8_BAR
#undef PG8_SCHED
}
}

struct Args { const float* in[27]; float* out; unsigned char* ws; int ph_lo, ph_hi; };
typedef const __attribute__((address_space(4))) Args* ArgP;
enum { I_X = 0, I_C, I_CTX, I_CCTX, I_WMOD, I_BMOD, I_G1, I_G2, I_WIN, I_CONVW, I_CONVB, I_WA, I_BA, I_WX, I_BX, I_LAM, I_POOLW, I_POOLS, I_SCW,
       I_BRL, I_BRF, I_BRP, I_BRS, I_WOUT, I_FF1, I_FF2, I_GF };

struct Sched {
    int kind, l, ch, G, c;
    ArgP ap;
    __device__ __forceinline__ bool next(int i, pg8::Unit& u) const {
        unsigned char* ws = ap->ws;
        const long L = (long)i * G + c;
        const int nM = (l == 0) ? RT / 256 : RL / 256;
        u.x0 = nullptr; u.x1 = nullptr; u.seg = 0; u.scale = 1.f;
        int pm, pn;
        if (kind == 1) {
            const char* U = (const char*)(ws + WS_U);
            const int nZ = nM * 24;
            long L2 = L - nZ; bool isz = false;
            if (L < nZ) { pg8::tile_of(L, nM, 24, pm, pn); isz = true; }
            else if (l == 1) { if (L2 < 32) { pm = 128 + (int)(L2 >> 1); pn = (int)(L2 & 1); isz = true; } else L2 -= 32; }
            if (isz) {
                u.a = U + (size_t)pm * 256 * DM * 2; u.b = (const char*)(ws + WS_WIN) + ((size_t)l * ZN + (size_t)pn * 256) * DM * 2; u.nt = 16;
                u.dst = (char*)(ws + WS_Z) + ((size_t)pm * 256 * ZN + (size_t)pn * 256) * 2; u.ldc = ZN; u.seg = (pn >= 8) ? 2 : 0; return true;
            }
            if (L2 >= 2 * nM) return false;
            const int seg = (int)(L2 & 1), tt = (int)(L2 >> 1);
            u.a = (const char*)(ws + WS_WF) + ((size_t)l * 512 + (size_t)seg * 256) * DM * 2; u.b = U + (size_t)tt * 256 * DM * 2; u.nt = 16; u.ldc = 4096;
            if (tt < 128) u.dst = (char*)(ws + WS_PT) + ((size_t)(tt >> 3) * 256 * 4096 + (size_t)seg * 2048 + (size_t)(tt & 7) * 256) * 2;
            else u.dst = (char*)(ws + WS_PTC) + ((size_t)(tt - 128) * 256 * 4096 + (size_t)seg * 256) * 2;
            return true;
        }
        if (kind == 7) {
            if (!pg8::tile_of(L, nM, 16, pm, pn)) return false;
            u.a = (const char*)(ws + WS_U) + (size_t)pm * 256 * DM * 2; u.b = (const char*)(ws + WS_W1) + ((size_t)l * DFF + (size_t)pn * 256) * DM * 2; u.nt = 16;
            u.dst = (char*)(ws + WS_Z) + ((size_t)pm * 256 * DFF + (size_t)pn * 256) * 2; u.ldc = DFF; return true;
        }
        if (kind == 2) {
            if (L < 128) { const int b_ = (int)(L >> 3), kt = (int)(L & 7);
                u.a = (const char*)(ws + WS_DFT) + (size_t)kt * 256 * 4096 * 2; u.b = (const char*)(ws + WS_PT) + (size_t)b_ * 256 * 4096 * 2; u.nt = 64;
                u.dst = (char*)(ws + WS_Y) + ((size_t)(b_ * SEQ + kt * 256) * YN + Y_F) * 2; u.ldc = YN; u.scale = 0.001381067932004975f  ; return true; }
            if (l == 0 && L < 144) { const int j = (int)L - 128;
                u.a = (const char*)(ws + WS_DFTC); u.b = (const char*)(ws + WS_PTC) + (size_t)j * 256 * 4096 * 2; u.nt = 8;
                u.dst = (char*)(ws + WS_Y) + ((size_t)(RL + j * 256) * YN + Y_F) * 2; u.ldc = YN; u.scale = 1.f / 256.f; return true; }
            return false;
        }
        if (kind == 4) {
            const int seg = i & 3; const long T = (long)(i >> 2) * G + c;
            if (!pg8::tile_of(T, nM, 4, pm, pn)) return false;
            const int coff = seg == 0 ? 0 : (256 + 256 * seg);
            u.a = (const char*)(ws + WS_Y) + ((size_t)pm * 256 * YN + coff) * 2; u.b = (const char*)(ws + WS_WBR) + (((size_t)l * DM + (size_t)pn * 256) * YN + coff) * 2;
            u.nt = seg == 0 ? 8 : 4; u.seg = seg; u.ldc = DM;
            u.dst = (char*)(ws + WS_MRG) + ((size_t)pm * 256 * DM + (size_t)pn * 256) * 2;
            u.x0 = (const char*)(ws + WS_Z) + ((size_t)pm * 256 * ZN + Z_GATE + seg * DM + pn * 256) * 2;
            return true;
        }
        if (!pg8::tile_of(L, nM, 4, pm, pn)) return false;
        if (kind == 5) { u.a = (const char*)(ws + WS_MRG) + (size_t)pm * 256 * DM * 2; u.b = (const char*)(ws + WS_WOUT) + ((size_t)l * DM + (size_t)pn * 256) * DM * 2; u.nt = 16; }
        else { u.a = (const char*)(ws + WS_Z) + (size_t)pm * 256 * DFF * 2; u.b = (const char*)(ws + WS_W2) + ((size_t)l * DM + (size_t)pn * 256) * DFF * 2; u.nt = 64; }
        int bidx; size_t eoff;
        if (pm < 128) { eoff = ((size_t)(ch * RL + pm * 256) * DM + pn * 256) * 4; bidx = ch * NB + (pm >> 3);
            char* out = (char*)ap->out; u.dst = out + eoff; u.x0 = (kind == 5 && l == 0) ? (const char*)ap->in[I_X] + eoff : (const char*)out + eoff; }
        else { eoff = ((size_t)(ch * RC + (pm - 128) * 256) * DM + pn * 256) * 4; bidx = 32;
            u.dst = (char*)(ws + WS_CTXW) + eoff; u.x0 = (kind == 5) ? (const char*)ap->in[I_CTX] + eoff : (const char*)(ws + WS_CTXW) + eoff; }
        u.x1 = (const char*)(ws + WS_MOD) + ((size_t)((l * 33 + bidx) * 6 + (kind == 5 ? 2 : 5)) * DM + pn * 256) * 4;
        u.ldc = DM;
        return true;
    }
};

__device__ __forceinline__ void tr_item(const float* W, int ldw, int col0, int ncols, bf16_t* WT, int ldt, int koff, LAS float* scr, int item, int lane) {
    const int nblk = ncols / 32, kb = item / nblk, nb = item % nblk, k0 = 64 * kb, n0 = 32 * nb;
#pragma unroll 8
    for (int i = 0; i < 32; ++i) { const int kk = 2 * i + (lane >> 5); scr[kk * 33 + (lane & 31)] = W[(size_t)(k0 + kk) * ldw + col0 + n0 + (lane & 31)]; }
    LDS_WAIT(); asm volatile("" ::: "memory");
    const int c = lane & 7;
#pragma unroll
    for (int j = 0; j < 4; ++j) { const int n = (lane >> 3) + 8 * j; const LAS float* s = scr + (8 * c) * 33 + n;
        u32x4 o; o.x = cvt_pk_bf16(s[0 * 33], s[1 * 33]); o.y = cvt_pk_bf16(s[2 * 33], s[3 * 33]); o.z = cvt_pk_bf16(s[4 * 33], s[5 * 33]); o.w = cvt_pk_bf16(s[6 * 33], s[7 * 33]);
        *(u32x4*)(WT + (size_t)(n0 + n) * ldt + koff + k0 + 8 * c) = o; }
    LDS_WAIT(); asm volatile("" ::: "memory");
}

__device__ __forceinline__ void p0_prologue(ArgP A, LAS unsigned char* lds, int G, const int tid) {
    const int lane = tid & 63, wave = tid >> 6, bx = blockIdx.x;
    unsigned char* ws = A->ws;
    if (bx < 192) {
        const int l = bx / 96, cb = bx % 96, n = cb * 64 + lane;
        LAS float* sl = (LAS float*)lds;
        for (int idx = tid; idx < 33 * 1024; idx += 512) { const int bb = idx >> 10, k = idx & 1023; const float v = bb < 32 ? A->in[I_C][bb * 1024 + k] : A->in[I_CCTX][k]; sl[idx] = v * sigm(v); }
        __syncthreads();
        float acc[33];
#pragma unroll
        for (int bb = 0; bb < 33; ++bb) acc[bb] = 0.f;
        const float* wp = A->in[I_WMOD] + ((size_t)l * 1024 + wave * 128) * 6144 + n;
        for (int k4 = 0; k4 < 32; ++k4) {
            const float w0 = wp[(size_t)(4 * k4 + 0) * 6144], w1 = wp[(size_t)(4 * k4 + 1) * 6144], w2 = wp[(size_t)(4 * k4 + 2) * 6144], w3 = wp[(size_t)(4 * k4 + 3) * 6144];
#pragma unroll
            for (int bb = 0; bb < 33; ++bb) { const f32x4 s = *(const LAS f32x4*)(sl + bb * 1024 + wave * 128 + 4 * k4); acc[bb] += s[0] * w0 + s[1] * w1 + s[2] * w2 + s[3] * w3; }
        }
        __syncthreads();
        LAS float* red = (LAS float*)lds;
#pragma unroll
        for (int bb = 0; bb < 33; ++bb) red[(wave * 33 + bb) * 64 + lane] = acc[bb];
        __syncthreads();
        float* MOD = (float*)(ws + WS_MOD);
        for (int idx = tid; idx < 33 * 64; idx += 512) { const int bb = idx >> 6, ln = idx & 63; float s = A->in[I_BMOD][l * 6144 + cb * 64 + ln];
#pragma unroll
            for (int w = 0; w < 8; ++w) s += red[(w * 33 + bb) * 64 + ln];
            MOD[(size_t)(l * 33 + bb) * 6144 + cb * 64 + ln] = s; }
        __syncthreads();
    } else if (bx < 224) {
        const int it = bx - 192, l = it >> 4, k0 = (it & 15) * 64;
        LAS float* wt = (LAS float*)lds;
        LAS float* tab = (LAS float*)(lds + 65536);
        for (int idx = tid; idx < 64 * 256; idx += 512) { const int kk = idx >> 8, c = idx & 255; wt[idx] = A->in[I_WIN][((size_t)l * 1024 + k0 + kk) * NIN + 1024 + c]; }
        { const int i = tid & 255; tab[tid] = (tid < 256) ? cospif((float)i / 128.f) : sinpif((float)i / 128.f); }
        __syncthreads();
        const int m = tid & 255; const LAS float* tb = tab + (tid >> 8) * 256;
        bf16_t* WF = (bf16_t*)(ws + WS_WF) + ((size_t)l * 512 + tid) * DM + k0;
        for (int kg = 0; kg < 8; ++kg) {
            float a[8];
#pragma unroll
            for (int q = 0; q < 8; ++q) a[q] = 0.f;
            for (int c = 0; c < 256; ++c) { const float tv = tb[(m * c) & 255];
#pragma unroll
                for (int q = 0; q < 8; ++q) a[q] += wt[(kg * 8 + q) * 256 + c] * tv; }
            u32x4 o; o.x = cvt_pk_bf16(a[0], a[1]); o.y = cvt_pk_bf16(a[2], a[3]); o.z = cvt_pk_bf16(a[4], a[5]); o.w = cvt_pk_bf16(a[6], a[7]);
            *(u32x4*)(WF + kg * 8) = o;
        }
        __syncthreads();
    }
    {
        LAS float* scr = (LAS float*)(lds + wave * 16384);
        const int gw = wave * G + bx, NGW = G * 8;
        for (int it = gw; it < 16384; it += NGW) {
            const int l = it >> 13; int r = it & 8191;
            const float* win = A->in[I_WIN] + (size_t)l * 1024 * NIN;
            bf16_t* WIN = (bf16_t*)(ws + WS_WIN) + (size_t)l * ZN * DM;
            bf16_t* WBR = (bf16_t*)(ws + WS_WBR) + (size_t)l * DM * YN;
            if (r < 512) { tr_item(win, NIN, 0, 1024, WIN, DM, 0, scr, r, lane); continue; } r -= 512;
            if (r < 2560) { tr_item(win, NIN, 1280, 5120, WIN + (size_t)1024 * DM, DM, 0, scr, r, lane); continue; } r -= 2560;
            if (r < 256) { tr_item(A->in[I_BRL] + (size_t)l * 512 * DM, DM, 0, DM, WBR, YN, 0, scr, r, lane); continue; } r -= 256;
            if (r < 128) { tr_item(A->in[I_BRF] + (size_t)l * 256 * DM, DM, 0, DM, WBR, YN, Y_F, scr, r, lane); continue; } r -= 128;
            if (r < 128) { tr_item(A->in[I_BRS] + (size_t)l * 256 * DM, DM, 0, DM, WBR, YN, Y_SC, scr, r, lane); continue; } r -= 128;
            if (r < 512) { tr_item(A->in[I_WOUT] + (size_t)l * DM * DM, DM, 0, DM, (bf16_t*)(ws + WS_WOUT) + (size_t)l * DM * DM, DM, 0, scr, r, lane); continue; } r -= 512;
            if (r < 2048) { tr_item(A->in[I_FF1] + (size_t)l * DM * DFF, DFF, 0, DFF, (bf16_t*)(ws + WS_W1) + (size_t)l * DFF * DM, DM, 0, scr, r, lane); continue; } r -= 2048;
            tr_item(A->in[I_FF2] + (size_t)l * DFF * DM, DM, 0, DM, (bf16_t*)(ws + WS_W2) + (size_t)l * DM * DFF, DFF, 0, scr, r, lane);
        }
    }
    const int gt = bx * 512 + tid, NGT = G * 512;
    {
        bf16_t* WG = (bf16_t*)(ws + WS_WG);
        for (int idx = gt; idx < 2 * 8 * 256 * 64; idx += NGT) { const int i = idx & 63, n = (idx >> 6) & 255, h = (idx >> 14) & 7, l = idx >> 17, d = n >> 7, gate = (n >> 6) & 1, j = n & 63;
            const float v = (gate ? A->in[I_WX] : A->in[I_WA])[((size_t)((l * 2 + d) * 8 + h) * 64 + i) * 64 + j];
            WG[idx] = (bf16_t)(cvt_pk_bf16(v, 0.f) & 0xffffu); }
    }
    {
        for (int idx = gt; idx < 2 * 256 * 1024; idx += NGT) { const int n = idx & 1023, i = (idx >> 10) & 255, l = idx >> 18, g = i >> 6, il = i & 63;
            const float* pw = A->in[I_POOLW] + ((size_t)(l * 4 + g) * 64 + il) * 64; const float* ps = A->in[I_POOLS] + l * 256 + g * 64; const float* wb = A->in[I_BRP] + ((size_t)l * 256 + g * 64) * DM + n;
            float s = 0.f;
            for (int j = 0; j < 64; ++j) s += pw[j] * ps[j] * wb[(size_t)j * DM];
            ((bf16_t*)(ws + WS_WBR))[((size_t)l * DM + n) * YN + Y_POOL + i] = (bf16_t)(cvt_pk_bf16(s, 0.f) & 0xffffu); }
    }
    {
        bf16_t* DF = (bf16_t*)(ws + WS_DFT);
        for (int idx = gt; idx < 2048 * 512; idx += NGT) { const int k = idx >> 9, n8 = (idx & 511) * 8; float v[8];
#pragma unroll
            for (int e = 0; e < 8; ++e) { const int np = n8 + e; if (np < 2048) v[e] = cospif((float)((k * np) & 2047) * (1.f / 1024.f)); else v[e] = -sinpif((float)((k * (np - 2048)) & 2047) * (1.f / 1024.f)); }
            u32x4 o; o.x = cvt_pk_bf16(v[0], v[1]); o.y = cvt_pk_bf16(v[2], v[3]); o.z = cvt_pk_bf16(v[4], v[5]); o.w = cvt_pk_bf16(v[6], v[7]);
            *(u32x4*)(DF + (size_t)k * 4096 + n8) = o; }
        bf16_t* DC = (bf16_t*)(ws + WS_DFTC);
        for (int idx = gt; idx < 256 * 64; idx += NGT) { const int k = idx >> 6, n8 = (idx & 63) * 8; float v[8];
#pragma unroll
            for (int e = 0; e < 8; ++e) { const int np = n8 + e; if (np < 256) v[e] = cospif((float)((k * np) & 255) * (1.f / 128.f)); else v[e] = -sinpif((float)((k * (np - 256)) & 255) * (1.f / 128.f)); }
            u32x4 o; o.x = cvt_pk_bf16(v[0], v[1]); o.y = cvt_pk_bf16(v[2], v[3]); o.z = cvt_pk_bf16(v[4], v[5]); o.w = cvt_pk_bf16(v[6], v[7]);
            *(u32x4*)(DC + (size_t)k * 4096 + n8) = o; }
    }
}

__device__ __forceinline__ void norm_phase(ArgP A, int l, int ch, bool second, int r_begin, int r_end, int r_step, const int tid) {
    const int lane = tid & 63, wave = tid >> 6;
    unsigned char* ws = A->ws;
    const int nrows = (second && l == 1) ? RL : RT, rend = r_end < nrows ? r_end : nrows;
    const float* gn = (second ? A->in[I_G2] : A->in[I_G1]) + l * DM;
    const float* MOD = (const float*)(ws + WS_MOD);
    bf16_t* U = (bf16_t*)(ws + WS_U);
    for (int r0 = r_begin + wave; r0 < rend; r0 += 2 * r_step) {
        const float* src[2]; const float* sh[2]; int rr[2]; bool ok[2];
#pragma unroll
        for (int q = 0; q < 2; ++q) { const int rq = r0 + q * r_step; ok[q] = rq < rend; const int r = ok[q] ? rq : r0; rr[q] = r; int bidx;
            if (r < RL) { const size_t grow = (size_t)ch * RL + r; src[q] = ((!second && l == 0) ? A->in[I_X] : (const float*)A->out) + grow * DM; bidx = ch * NB + (r >> 11); }
            else { const size_t grow = (size_t)ch * RC + (r - RL); src[q] = ((!second && l == 0) ? A->in[I_CTX] : (const float*)(ws + WS_CTXW)) + grow * DM; bidx = 32; }
            sh[q] = MOD + (size_t)((l * 33 + bidx) * 6 + (second ? 3 : 0)) * DM; }
        f32x4 v[2][4]; float s[2] = {0.f, 0.f};
#pragma unroll
        for (int q = 0; q < 2; ++q)
#pragma unroll
            for (int j = 0; j < 4; ++j) v[q][j] = *(const f32x4*)(src[q] + 4 * (lane + 64 * j));
#pragma unroll
        for (int q = 0; q < 2; ++q) {
#pragma unroll
            for (int j = 0; j < 4; ++j) s[q] += (v[q][j][0] * v[q][j][0] + v[q][j][1] * v[q][j][1]) + (v[q][j][2] * v[q][j][2] + v[q][j][3] * v[q][j][3]);
            s[q] = 1.0f / sqrtf(wave_sum(s[q]) * (1.f / DM) + 1e-6f); }
#pragma unroll
        for (int q = 0; q < 2; ++q) { if (!ok[q]) continue;
#pragma unroll
            for (int j = 0; j < 4; ++j) { const int col = 4 * (lane + 64 * j);
                const f32x4 gg = *(const f32x4*)(gn + col), s1 = *(const f32x4*)(sh[q] + DM + col), s0 = *(const f32x4*)(sh[q] + col);
                const f32x4 o = (v[q][j] * s[q]) * gg * (s1 + 1.0f) + s0;
                u32x2 w; w.x = cvt_pk_bf16(o[0], o[1]); w.y = cvt_pk_bf16(o[2], o[3]);
                *(u32x2*)(U + (size_t)rr[q] * DM + col) = w; } }
    }
}
__device__ __forceinline__ void final_norm(ArgP A, int G, const int tid) {
    const int lane = tid & 63, wave = tid >> 6;
    const float* gn = A->in[I_GF];
    for (int r0 = blockIdx.x * 8 + wave; r0 < NBATCH * SEQ; r0 += 2 * G * 8) {
        float* p[2]; f32x4 v[2][4]; float s[2] = {0.f, 0.f};
#pragma unroll
        for (int q = 0; q < 2; ++q) { int r = r0 + q * G * 8; if (r >= NBATCH * SEQ) r = r0; p[q] = A->out + (size_t)r * DM;
#pragma unroll
            for (int j = 0; j < 4; ++j) v[q][j] = *(const f32x4*)(p[q] + 4 * (lane + 64 * j)); }
#pragma unroll
        for (int q = 0; q < 2; ++q) {
#pragma unroll
            for (int j = 0; j < 4; ++j) s[q] += (v[q][j][0] * v[q][j][0] + v[q][j][1] * v[q][j][1]) + (v[q][j][2] * v[q][j][2] + v[q][j][3] * v[q][j][3]);
            s[q] = 1.0f / sqrtf(wave_sum(s[q]) * (1.f / DM) + 1e-6f); }
#pragma unroll
        for (int q = 0; q < 2; ++q)
#pragma unroll
            for (int j = 0; j < 4; ++j) { const int col = 4 * (lane + 64 * j); const f32x4 gg = *(const f32x4*)(gn + col); *(f32x4*)(p[q] + col) = (v[q][j] * s[q]) * gg; }
    }
}

__device__ __forceinline__ void unpack8(const u32x4 w, float (&f)[8]) {
#pragma unroll
    for (int e = 0; e < 4; ++e) { f[2 * e] = bf_lo(w[e]); f[2 * e + 1] = bf_hi(w[e]); }
}
__device__ __forceinline__ u32x4 pack8(const float (&f)[8]) { u32x4 o; o.x = cvt_pk_bf16(f[0], f[1]); o.y = cvt_pk_bf16(f[2], f[3]); o.z = cvt_pk_bf16(f[4], f[5]); o.w = cvt_pk_bf16(f[6], f[7]); return o; }

__device__ __forceinline__ void lru_item(ArgP A, int l, int it, bool pass2, LAS unsigned char* lds, const int tid) {
    const int lane = tid & 63, wid = tid >> 6;
    unsigned char* ws = A->ws;
    const int head = it & 7, rest = it >> 3;
    int sc, bl;
    if (!pass2 || l == 0) { sc = rest % NSC; bl = rest / NSC; } else { sc = 4 + (rest & 31); bl = rest >> 5; }
    const bool isctx = sc < 4; const int c = isctx ? sc : sc - 4, Lseq = isctx ? CTXL : SEQ, rowbase = isctx ? RL + bl * CTXL : bl * SEQ, t0 = c * 64;
    const bf16_t* Z = (const bf16_t*)(ws + WS_Z);
    LAS float* xaf = (LAS float*)lds;
    LAS bf16_t* xab = (LAS bf16_t*)(lds + 17408);
    LAS float* hbuf = (LAS float*)(lds + 32768);
    {
        const int t = tid >> 3, i8 = (tid & 7) * 8, tok = t0 + t, Cc = head * 64 + i8;
        float acc[8];
        { const f32x4 b0 = *(const f32x4*)(A->in[I_CONVB] + l * DLRU + Cc), b1 = *(const f32x4*)(A->in[I_CONVB] + l * DLRU + Cc + 4);
#pragma unroll
          for (int e = 0; e < 4; ++e) { acc[e] = b0[e]; acc[4 + e] = b1[e]; } }
#pragma unroll
        for (int k = 0; k < 4; ++k) { const int tt = tok + k - 2;
            if (tt >= 0 && tt < Lseq) { float z[8]; unpack8(*(const u32x4*)(Z + (size_t)(rowbase + tt) * ZN + Cc), z);
                const float* cw = A->in[I_CONVW] + (size_t)(l * 4 + k) * DLRU + Cc; const f32x4 c0 = *(const f32x4*)cw, c1 = *(const f32x4*)(cw + 4);
#pragma unroll
                for (int e = 0; e < 4; ++e) { acc[e] += z[e] * c0[e]; acc[4 + e] += z[4 + e] * c1[e]; } } }
        *(LAS f32x4*)(xaf + t * 68 + i8) = (f32x4){acc[0], acc[1], acc[2], acc[3]}; *(LAS f32x4*)(xaf + t * 68 + i8 + 4) = (f32x4){acc[4], acc[5], acc[6], acc[7]};
        *(LAS u32x4*)(xab + t * 72 + i8) = pack8(acc);
    }
    __syncthreads();
    {
        const int d = wid >> 2, g = wid & 3, fr = lane & 15, fq = lane >> 4;
        const bf16_t* wb = (const bf16_t*)(ws + WS_WG) + ((size_t)((l * 8 + head) * 256 + d * 128 + 16 * g + fr)) * 64 + 8 * fq;
        bf16x8 wR[2], wG[2];
#pragma unroll
        for (int ks = 0; ks < 2; ++ks) { wR[ks] = *(const bf16x8*)(wb + 32 * ks); wG[ks] = *(const bf16x8*)(wb + 64 * 64 + 32 * ks); }
        const int cb = head * 64 + 16 * g + 4 * fq;
        const f32x4 ba = *(const f32x4*)(A->in[I_BA] + (l * 2 + d) * DLRU + cb), bxv = *(const f32x4*)(A->in[I_BX] + (l * 2 + d) * DLRU + cb), lam = *(const f32x4*)(A->in[I_LAM] + (l * 2 + d) * DLRU + cb);
        f32x4 sp8;
#pragma unroll
        for (int e = 0; e < 4; ++e) sp8[e] = 8.0f * log1pf(__expf(-lam[e]));
        const int p = (d == 0) ? sc : (isctx ? 3 - c : 4 + 31 - c);
        float* SA = (float*)(ws + WS_SUMA) + ((size_t)(bl * 2 + d) * NSC) * DLRU + cb; float* SH = (float*)(ws + WS_SUMH) + ((size_t)(bl * 2 + d) * NSC) * DLRU + cb;
        f32x4 hin = (f32x4){0.f, 0.f, 0.f, 0.f}, Atot = (f32x4){1.f, 1.f, 1.f, 1.f}, Htot = (f32x4){0.f, 0.f, 0.f, 0.f};
        if (pass2) for (int pp = 0; pp < p; ++pp) { const f32x4 a4 = *(const f32x4*)(SA + (size_t)pp * DLRU), h4 = *(const f32x4*)(SH + (size_t)pp * DLRU); hin = a4 * hin + h4; }
        const int lastl = (lane & 48) | (d ? 0 : 15);
#pragma unroll
        for (int q = 0; q < 4; ++q) { const int tt = d ? 3 - q : q;
            f32x4 aR = (f32x4){0.f, 0.f, 0.f, 0.f}, aG = (f32x4){0.f, 0.f, 0.f, 0.f};
#pragma unroll
            for (int ks = 0; ks < 2; ++ks) { const bf16x8 bfrag = *(const LAS bf16x8*)(xab + (16 * tt + fr) * 72 + 8 * fq + 32 * ks);
                aR = __builtin_amdgcn_mfma_f32_16x16x32_bf16(wR[ks], bfrag, aR, 0, 0, 0); aG = __builtin_amdgcn_mfma_f32_16x16x32_bf16(wG[ks], bfrag, aG, 0, 0, 0); }
            const f32x4 xv = *(const LAS f32x4*)(xaf + (16 * tt + fr) * 68 + 16 * g + 4 * fq);
            f32x4 hv;
#pragma unroll
            for (int e = 0; e < 4; ++e) {
                const float r = sigm(aR[e] + ba[e]), gi = sigm(aG[e] + bxv[e]);
                const float la = -r * sp8[e], a = __expf(la), x2 = -2.0f * la;
                const float om = x2 < 0.1f ? x2 * (1.0f - x2 * (0.5f - x2 * (0.16666667f - x2 * 0.041666668f))) : 1.0f - a * a;
                float Av = a, Bv = sqrtf(om) * gi * xv[e];
#pragma unroll
                for (int off = 1; off < 16; off <<= 1) { const int src = d ? lane + off : lane - off; const float Ap = __shfl(Av, src), Bp = __shfl(Bv, src);
                    const bool valid = d ? (fr + off < 16) : (fr >= off); if (valid) { Bv = Av * Bp + Bv; Av = Av * Ap; } }
                if (pass2) { const float h = Av * hin[e] + Bv; hv[e] = h; hin[e] = __shfl(h, lastl); }
                else { const float AT = __shfl(Av, lastl), BT = __shfl(Bv, lastl); Htot[e] = AT * Htot[e] + BT; Atot[e] = Atot[e] * AT; }
            }
            if (pass2) *(LAS f32x4*)(hbuf + ((d * 64 + 16 * tt + fr) * 68 + 16 * g + 4 * fq)) = hv;
        }
        if (!pass2 && fr == 0) { *(f32x4*)(SA + (size_t)p * DLRU) = Atot; *(f32x4*)(SH + (size_t)p * DLRU) = Htot; }
    }
    if (pass2) {
        __syncthreads();
        const int t = tid >> 3, i8 = (tid & 7) * 8, tok = t0 + t, Cc = head * 64 + i8;
        float zg[8]; unpack8(*(const u32x4*)(Z + (size_t)(rowbase + tok) * ZN + Z_LG + Cc), zg);
        const f32x4 h00 = *(const LAS f32x4*)(hbuf + t * 68 + i8), h01 = *(const LAS f32x4*)(hbuf + t * 68 + i8 + 4), h10 = *(const LAS f32x4*)(hbuf + (64 + t) * 68 + i8), h11 = *(const LAS f32x4*)(hbuf + (64 + t) * 68 + i8 + 4);
        float y[8];
#pragma unroll
        for (int e = 0; e < 8; ++e) { const float hs = e < 4 ? h00[e & 3] + h10[e & 3] : h01[e & 3] + h11[e & 3]; const float x = zg[e];
            const float u2 = 1.5957691216057308f * (x + 0.044715f * x * x * x);
            y[e] = hs * x * sigm(u2); }
        *(u32x4*)((bf16_t*)(ws + WS_Y) + (size_t)(rowbase + tok) * YN + Cc) = pack8(y);
    }
}

__device__ __forceinline__ void sweep_chunk(int d, int j, int bl, int& rowbase, int& t0, int& Lseq, bool& isctx) {
    isctx = j < 4; const int c = isctx ? (d ? 3 - j : j) : (d ? 35 - j : j - 4);
    Lseq = isctx ? CTXL : SEQ; rowbase = isctx ? RL + bl * CTXL : bl * SEQ; t0 = c * 64;
}
__device__ __forceinline__ void lru_sweep(ArgP A, int l, int item, LAS unsigned char* lds, const int tid) {
    unsigned char* ws = A->ws;
    const int lane = tid & 63, wid = tid >> 6, d = wid >> 2, g = wid & 3, fr = lane & 15, fq = lane >> 4, hl = tid & 255;
    const int head = item & 7, bl = item >> 3;
    const bf16_t* Z = (const bf16_t*)(ws + WS_Z);
    LAS float* cwl = (LAS float*)(lds + 106496);
    __syncthreads();
    if (tid < 256) cwl[tid] = A->in[I_CONVW][(size_t)(l * 4 + (tid >> 6)) * DLRU + head * 64 + (tid & 63)];
    else if (tid < 320) cwl[tid] = A->in[I_CONVB][l * DLRU + head * 64 + (tid - 256)];
    const bf16_t* wb = (const bf16_t*)(ws + WS_WG) + ((size_t)((l * 8 + head) * 256 + d * 128 + 16 * g + fr)) * 64 + 8 * fq;
    bf16x8 wR[2], wG[2];
#pragma unroll
    for (int ks = 0; ks < 2; ++ks) { wR[ks] = *(const bf16x8*)(wb + 32 * ks); wG[ks] = *(const bf16x8*)(wb + 64 * 64 + 32 * ks); }
    const int cb = head * 64 + 16 * g + 4 * fq;
    const f32x4 ba = *(const f32x4*)(A->in[I_BA] + (l * 2 + d) * DLRU + cb), bxv = *(const f32x4*)(A->in[I_BX] + (l * 2 + d) * DLRU + cb), lam = *(const f32x4*)(A->in[I_LAM] + (l * 2 + d) * DLRU + cb);
    const float LOG2E = 1.4426950408889634f;
    f32x4 spl2; const f32x4 nba = ba * (-LOG2E), nbx = bxv * (-LOG2E);
#pragma unroll
    for (int e = 0; e < 4; ++e) { const float sp8 = 8.0f * log1pf(__expf(-lam[e])); spl2[e] = sp8 * LOG2E; }
    float* HX = (float*)(ws + (d ? WS_HB : WS_HF));
    const int lastl = lane | 15;
    const int ct = hl >> 2, ci = (hl & 3) * 16;
    f32x4 hin = (f32x4){0.f, 0.f, 0.f, 0.f};
#define SWEEP_LOAD(zr, jj) do { int rb_, t0_, Ls_; bool ic_; sweep_chunk(d, (jj) < NSC ? (jj) : NSC - 1, bl, rb_, t0_, Ls_, ic_); \
        _Pragma("unroll") for (int k = 0; k < 4; ++k) { const int tt_ = t0_ + ct + k - 2; const bool ok_ = (tt_ >= 0 && tt_ < Ls_); const int tc_ = ok_ ? tt_ : t0_ + ct; \
            const bf16_t* zp_ = Z + (size_t)(rb_ + tc_) * ZN + head * 64 + ci; const u32x4 l0_ = *(const u32x4*)zp_, l1_ = *(const u32x4*)(zp_ + 8); const unsigned mk_ = ok_ ? 0xffffffffu : 0u; \
            zr[k][0] = l0_ & mk_; zr[k][1] = l1_ & mk_; } } while (0)
#define SWEEP_CONV(zr, bufi) do { LAS float* xaf_ = (LAS float*)(lds + d * 53248 + (bufi) * 26624); LAS bf16_t* xab_ = (LAS bf16_t*)(lds + d * 53248 + (bufi) * 26624 + 17408); \
        _Pragma("unroll") for (int hf_ = 0; hf_ < 2; ++hf_) { float acc[8]; \
            { const f32x4 b0_ = *(const LAS f32x4*)(cwl + 256 + ci + 8 * hf_), b1_ = *(const LAS f32x4*)(cwl + 256 + ci + 8 * hf_ + 4); _Pragma("unroll") for (int e = 0; e < 4; ++e) { acc[e] = b0_[e]; acc[4 + e] = b1_[e]; } } \
            _Pragma("unroll") for (int k = 0; k < 4; ++k) { float z[8]; unpack8(zr[k][hf_], z); \
                const f32x4 w0_ = *(const LAS f32x4*)(cwl + k * 64 + ci + 8 * hf_), w1_ = *(const LAS f32x4*)(cwl + k * 64 + ci + 8 * hf_ + 4); \
                _Pragma("unroll") for (int e = 0; e < 4; ++e) { acc[e] += z[e] * w0_[e]; acc[4 + e] += z[4 + e] * w1_[e]; } } \
            *(LAS f32x4*)(xaf_ + ct * 68 + ci + 8 * hf_) = (f32x4){acc[0], acc[1], acc[2], acc[3]}; *(LAS f32x4*)(xaf_ + ct * 68 + ci + 8 * hf_ + 4) = (f32x4){acc[4], acc[5], acc[6], acc[7]}; \
            *(LAS u32x4*)(xab_ + ct * 72 + ci + 8 * hf_) = pack8(acc); } } while (0)
#define SCAN_LVL(N) "v_fmac_f32_dpp %0, %0, %4 row_shr:" #N " row_mask:0xf bank_mask:0xf\n\tv_fmac_f32_dpp %1, %1, %5 row_shr:" #N " row_mask:0xf bank_mask:0xf\n\t" \
                    "v_fmac_f32_dpp %2, %2, %6 row_shr:" #N " row_mask:0xf bank_mask:0xf\n\tv_fmac_f32_dpp %3, %3, %7 row_shr:" #N " row_mask:0xf bank_mask:0xf\n\t" \
                    "v_mul_f32_dpp %4, %4, %4 row_shr:" #N " row_mask:0xf bank_mask:0xf\n\tv_mul_f32_dpp %5, %5, %5 row_shr:" #N " row_mask:0xf bank_mask:0xf\n\t" \
                    "v_mul_f32_dpp %6, %6, %6 row_shr:" #N " row_mask:0xf bank_mask:0xf\n\tv_mul_f32_dpp %7, %7, %7 row_shr:" #N " row_mask:0xf bank_mask:0xf\n\t"
#define SWEEP_SCAN \
        _Pragma("unroll") \
        for (int q = 0; q < 4; ++q) { const int tt = d ? 3 - q : q, trow = 16 * tt + (d ? 15 - fr : fr); \
            f32x4 aR = (f32x4){0.f, 0.f, 0.f, 0.f}, aG = (f32x4){0.f, 0.f, 0.f, 0.f}; \
        _Pragma("unroll") \
            for (int ks = 0; ks < 2; ++ks) { const bf16x8 bfrag = *(const LAS bf16x8*)(xab + trow * 72 + 8 * fq + 32 * ks); \
                aR = __builtin_amdgcn_mfma_f32_16x16x32_bf16(wR[ks], bfrag, aR, 0, 0, 0); aG = __builtin_amdgcn_mfma_f32_16x16x32_bf16(wG[ks], bfrag, aG, 0, 0, 0); } \
            const f32x4 xv = *(const LAS f32x4*)(xaf + trow * 68 + 16 * g + 4 * fq); \
            f32x4 Av, Bv; \
            { \
                const f32x4 tR = aR * (-LOG2E) + nba, tG = aG * (-LOG2E) + nbx; \
                f32x4 eR, eG; \
        _Pragma("unroll") \
                for (int e = 0; e < 4; ++e) { eR[e] = __builtin_amdgcn_exp2f(tR[e]); eG[e] = __builtin_amdgcn_exp2f(tG[e]); } \
                eR = eR + 1.0f; eG = eG + 1.0f; \
                f32x4 r, gi; \
        _Pragma("unroll") \
                for (int e = 0; e < 4; ++e) { r[e] = __builtin_amdgcn_rcpf(eR[e]); gi[e] = __builtin_amdgcn_rcpf(eG[e]); } \
                const f32x4 ta = r * spl2, x2 = ta * 1.3862943611198906f; \
        _Pragma("unroll") \
                for (int e = 0; e < 4; ++e) Av[e] = __builtin_amdgcn_exp2f(-ta[e]); \
                const f32x4 pser = x2 * (x2 * (x2 * 0.16666667f - 0.5f) + 1.0f), om1 = 1.0f - Av * Av; \
                f32x4 sq; \
        _Pragma("unroll") \
                for (int e = 0; e < 4; ++e) sq[e] = __builtin_amdgcn_sqrtf(x2[e] < 0.02f ? pser[e] : om1[e]); \
                Bv = sq * gi * xv; \
            } \
            { \
                float B0 = Bv[0], B1 = Bv[1], B2 = Bv[2], B3 = Bv[3], A0 = Av[0], A1 = Av[1], A2 = Av[2], A3 = Av[3]; \
                asm volatile("s_nop 1\n\t" SCAN_LVL(1) SCAN_LVL(2) SCAN_LVL(4) SCAN_LVL(8) "s_nop 1" \
                    : "+v"(B0), "+v"(B1), "+v"(B2), "+v"(B3), "+v"(A0), "+v"(A1), "+v"(A2), "+v"(A3)); \
                Av = (f32x4){A0, A1, A2, A3}; Bv = (f32x4){B0, B1, B2, B3}; \
            } \
            const f32x4 hq = Av * hin + Bv; *(f32x4*)(HX + (size_t)(rowbase + t0 + trow) * DLRU + cb) = hq; \
        _Pragma("unroll") \
            for (int e = 0; e < 4; ++e) hin[e] = __shfl(hq[e], lastl); \
        }
    __syncthreads();
    u32x4 za[4][2], zb[4][2];
    { SWEEP_LOAD(zb, 0); SWEEP_LOAD(za, 1); SWEEP_CONV(zb, 0); }
    __syncthreads();
#define SWEEP_STEP(jj, ZL, ZC) do { const int j = (jj); \
        int rowbase, t0, Lseq; bool isctx; sweep_chunk(d, j, bl, rowbase, t0, Lseq, isctx); \
        SWEEP_LOAD(ZL, j + 2); \
        const LAS float* xaf = (const LAS float*)(lds + d * 53248 + (j & 1) * 26624); \
        const LAS bf16_t* xab = (const LAS bf16_t*)(lds + d * 53248 + (j & 1) * 26624 + 17408); \
        SWEEP_SCAN \
        if (j + 1 < NSC) SWEEP_CONV(ZC, (j + 1) & 1); \
        __syncthreads(); } while (0)
    for (int j2 = 0; j2 < NSC; j2 += 2) { SWEEP_STEP(j2, zb, za); SWEEP_STEP(j2 + 1, za, zb); }
#undef SWEEP_STEP
#undef SWEEP_SCAN
#undef SCAN_LVL
#undef SWEEP_LOAD
#undef SWEEP_CONV
    asm volatile("s_waitcnt vmcnt(0)" ::: "memory");
    __syncthreads();
    {
        const float* HF = (const float*)(ws + WS_HF); const float* HB = (const float*)(ws + WS_HB);
        const int t = tid >> 3, i8 = (tid & 7) * 8, Cc = head * 64 + i8;
        for (int sc0 = (l == 0 ? 0 : 4); sc0 < NSC; sc0 += 4) {
            u32x4 zgw[4]; f32x4 f0[4], f1[4], b0[4], b1[4]; int rows[4];
#pragma unroll
            for (int u = 0; u < 4; ++u) { const int sc = sc0 + u; const int row = (sc < 4 ? RL + bl * CTXL + sc * 64 : bl * SEQ + (sc - 4) * 64) + t; rows[u] = row;
                zgw[u] = *(const u32x4*)(Z + (size_t)row * ZN + Z_LG + Cc);
                f0[u] = *(const f32x4*)(HF + (size_t)row * DLRU + Cc); f1[u] = *(const f32x4*)(HF + (size_t)row * DLRU + Cc + 4);
                b0[u] = *(const f32x4*)(HB + (size_t)row * DLRU + Cc); b1[u] = *(const f32x4*)(HB + (size_t)row * DLRU + Cc + 4); }
#pragma unroll
            for (int u = 0; u < 4; ++u) { float zg[8]; unpack8(zgw[u], zg); float y[8];
#pragma unroll
                for (int e = 0; e < 8; ++e) { const float hs = e < 4 ? f0[u][e & 3] + b0[u][e & 3] : f1[u][e & 3] + b1[u][e & 3]; const float x = zg[e];
                    const float u2 = 1.5957691216057308f * (x + 0.044715f * x * x * x);
                    y[e] = hs * x * sigm(u2); }
                *(u32x4*)((bf16_t*)(ws + WS_Y) + (size_t)rows[u] * YN + Cc) = pack8(y); }
        }
    }
}

__device__ __forceinline__ void seg_decode(int it, int& rowbase, int& s0, int& lob, int& hib, int& Lseq) {
    if (it < 512) { const int bl = it >> 5, sg = it & 31; rowbase = bl * SEQ; s0 = sg * 64; lob = s0; hib = s0 + 64; Lseq = SEQ; }
    else { const int j = it - 512, bl = j >> 2, q = j & 3; rowbase = RL + bl * CTXL; s0 = q * 64; lob = 0; hib = CTXL; Lseq = CTXL; }
}
__device__ __forceinline__ void pool_item(ArgP A, int it, LAS unsigned char* lds, const int tid) {
    unsigned char* ws = A->ws;
    int rowbase, s0, lob, hib, Lseq; seg_decode(it, rowbase, s0, lob, hib, Lseq);
    const bf16_t* Z = (const bf16_t*)(ws + WS_Z);
    LAS float* tile = (LAS float*)lds;
    { const int rr = tid >> 5, c8 = (tid & 31) * 8;
#pragma unroll
      for (int ps = 0; ps < 5; ++ps) { const int jr = ps * 16 + rr, tok = s0 - 8 + jr;
          if (tok >= lob && tok < hib) { float z[8]; unpack8(*(const u32x4*)(Z + (size_t)(rowbase + tok) * ZN + Z_POOL + c8), z);
              *(LAS f32x4*)(tile + jr * 256 + c8) = (f32x4){z[0], z[1], z[2], z[3]}; *(LAS f32x4*)(tile + jr * 256 + c8 + 4) = (f32x4){z[4], z[5], z[6], z[7]}; } } }
    __syncthreads();
    const int chn = tid & 255, half = tid >> 8, w2 = 1 << (chn >> 6);
    bf16_t* Y = (bf16_t*)(ws + WS_Y);
    for (int t = half * 32; t < half * 32 + 32; ++t) { const int tok = s0 + t; const int lo = max(tok - w2, lob), hi = min(tok + w2, hib);
        float s = 0.f; for (int j = lo; j < hi; ++j) s += tile[(j - s0 + 8) * 256 + chn];
        const float pv = s / (float)(hi - lo) - tile[(t + 8) * 256 + chn];
        Y[(size_t)(rowbase + tok) * YN + Y_POOL + chn] = (bf16_t)(cvt_pk_bf16(pv, 0.f) & 0xffffu); }
}
__device__ __forceinline__ void sconv_item(ArgP A, int l, int it, const int tid) {
    unsigned char* ws = A->ws;
    int rowbase, s0, lob, hib, Lseq; seg_decode(it, rowbase, s0, lob, hib, Lseq);
    const bf16_t* Z = (const bf16_t*)(ws + WS_Z);
    const int c8 = (tid & 31) * 8, tr = tid >> 5;
    const float* sw = A->in[I_SCW] + (size_t)l * 3 * 256 + c8;
#pragma unroll
    for (int ps = 0; ps < 4; ++ps) { const int tok = s0 + ps * 16 + tr; float acc[8];
#pragma unroll
        for (int e = 0; e < 8; ++e) acc[e] = 0.f;
#pragma unroll
        for (int dt = -1; dt <= 1; ++dt) { const int tt = tok + dt;
            if (tt >= 0 && tt < Lseq) { float gc[8], hs[8]; const bf16_t* zr = Z + (size_t)(rowbase + tt) * ZN + Z_SC + c8; unpack8(*(const u32x4*)(zr + 256), gc); unpack8(*(const u32x4*)(zr + 512), hs);
                const f32x4 w0 = *(const f32x4*)(sw + (dt + 1) * 256), w1 = *(const f32x4*)(sw + (dt + 1) * 256 + 4);
#pragma unroll
                for (int e = 0; e < 4; ++e) { acc[e] += gc[e] * hs[e] * w0[e]; acc[4 + e] += gc[4 + e] * hs[4 + e] * w1[e]; } } }
        float gb[8]; unpack8(*(const u32x4*)(Z + (size_t)(rowbase + tok) * ZN + Z_SC + c8), gb);
#pragma unroll
        for (int e = 0; e < 8; ++e) acc[e] *= gb[e];
        *(u32x4*)((bf16_t*)(ws + WS_Y) + (size_t)(rowbase + tok) * YN + Y_SC + c8) = pack8(acc); }
}

__device__ __forceinline__ int fetch_item(unsigned* ctr, LAS unsigned char* lds, const int tid) {
    LAS unsigned* slot = (LAS unsigned*)(lds + QSLOT_OFF);
    __syncthreads();
    if (tid == 0) *slot = atomicAdd(ctr, 1u);
    __syncthreads();
    return (int)*slot;
}


#define XB_TMO      128
#define XB_XCNT(j)  (256  + 64 * (j))
#define XB_XSUB(j)  (1280 + 64 * (j))
#define XB_XGEN(j)  (2304 + 64 * (j))
#define XB_TOP      3328
#define XB_TOPGEN   3392
#define XCD_BAR_WORDS 3456
#define XB_SPIN_CAP (1u << 22)
__device__ __forceinline__ unsigned xb_ld(unsigned* p)              { return __hip_atomic_load(p, __ATOMIC_RELAXED, __HIP_MEMORY_SCOPE_AGENT); }
__device__ __forceinline__ unsigned xb_add(unsigned* p, unsigned v) { return __hip_atomic_fetch_add(p, v, __ATOMIC_RELAXED, __HIP_MEMORY_SCOPE_AGENT); }
__device__ __forceinline__ unsigned xb_xcc_id() { return (unsigned)__builtin_amdgcn_s_getreg((3 << 11) | 20) & 0xFu; }
#define XB_SPIN(cond, bar) do { unsigned _sp = 0; while (cond) { __builtin_amdgcn_s_sleep(1); \
    if ((++_sp & 255u) == 0u) { if (xb_ld(&(bar)[XB_TMO])) break; if (_sp > XB_SPIN_CAP) { atomicAdd(&(bar)[XB_TMO], 1u); break; } } } } while (0)
struct XcdBarrier { unsigned* bar; unsigned x; volatile LAS unsigned* st; };
__device__ __forceinline__ XcdBarrier xcd_barrier_post(unsigned* bar, volatile LAS unsigned* st) {
    XcdBarrier b; b.bar = bar; b.x = xb_xcc_id(); b.st = st;
    if (threadIdx.x == 0) (void)xb_add(&bar[XB_XCNT(b.x)], 1u);
    return b;
}
__device__ __forceinline__ void xcd_barrier_complete(unsigned* bar, unsigned x, unsigned& nloc, unsigned& nx) {
    const unsigned G = gridDim.x * gridDim.y * gridDim.z;
    unsigned sum, cnt, mine, sp = 0u;
    for (;;) {
        sum = 0u; cnt = 0u; mine = 0u;
#pragma unroll
        for (unsigned j = 0; j < 16; ++j) { const unsigned c = xb_ld(&bar[XB_XCNT(j)]); sum += c; cnt += (c > 0u) ? 1u : 0u; mine = (j == x) ? c : mine; }
        if (sum == G) break;
        __builtin_amdgcn_s_sleep(1);
        if ((++sp & 255u) == 0u) { if (xb_ld(&bar[XB_TMO])) break; if (sp > XB_SPIN_CAP) { atomicAdd(&bar[XB_TMO], 1u); break; } }
    }
    nloc = mine > 0u ? mine : 1u; nx = cnt > 0u ? cnt : 1u;
}
__device__ __forceinline__ void xcd_barrier(const XcdBarrier& b) {
    asm volatile("s_waitcnt vmcnt(0)" ::: "memory");
    __syncthreads();
    if (threadIdx.x == 0) {
        unsigned* bar = b.bar;
        __builtin_amdgcn_s_waitcnt(0);
        unsigned nloc = b.st[0], nx = b.st[1];
        if (nloc == 0u) { xcd_barrier_complete(bar, b.x, nloc, nx); b.st[0] = nloc; b.st[1] = nx; }
        const unsigned old = xb_add(&bar[XB_XSUB(b.x)], 1u);
        const unsigned gen = old / nloc;
        if (old + 1u == (gen + 1u) * nloc) {
            __builtin_amdgcn_fence(__ATOMIC_RELEASE, "agent");
            asm volatile("s_waitcnt vmcnt(0)" ::: "memory");
            const unsigned og = xb_add(&bar[XB_TOP], 1u);
            const unsigned tg = og / nx;
            if (og + 1u == (tg + 1u) * nx) xb_add(&bar[XB_TOPGEN], 1u);
            else XB_SPIN(xb_ld(&bar[XB_TOPGEN]) == tg, bar);
            __builtin_amdgcn_fence(__ATOMIC_ACQUIRE, "agent");
            xb_add(&bar[XB_XGEN(b.x)], 1u);
            asm volatile("s_waitcnt vmcnt(0)" ::: "memory");
        } else {
            XB_SPIN(xb_ld(&bar[XB_XGEN(b.x)]) == gen, bar);
            __builtin_amdgcn_fence(__ATOMIC_ACQUIRE, "agent");
            asm volatile("s_waitcnt vmcnt(0)" ::: "memory");
        }
    }
    __syncthreads();
}

template <bool COOP>
__global__ void __launch_bounds__(512, 2) fwd_kernel(Args Aparam) {
    extern __shared__ __attribute__((aligned(16))) unsigned char lds_raw[];
    LAS unsigned char* lds = (LAS unsigned char*)lds_raw;
    const int G = gridDim.x;
    ArgP A = (ArgP)__builtin_amdgcn_kernarg_segment_ptr();
    const int ph_lo = A->ph_lo, ph_hi = A->ph_hi;
    XcdBarrier xbar; xbar.bar = nullptr; xbar.x = 0; xbar.st = (volatile LAS unsigned*)(lds + QSLOT_OFF + 16);
    if constexpr (COOP) {
        if (threadIdx.x < 2) xbar.st[threadIdx.x] = 0u;
        __syncthreads();
        xbar = xcd_barrier_post((unsigned*)(A->ws + WS_CTL) + 8192, xbar.st);
    }
    for (int ph = ph_lo; ph < ph_hi; ++ph) {
        asm volatile("" : "+s"(A));
        int tid = threadIdx.x; asm volatile("" : "+v"(tid));
        unsigned* ctl = (unsigned*)(A->ws + WS_CTL);
        if (ph < PH_BASE) p0_prologue(A, lds, G, tid);
        else if (ph == NPHASE - 1) final_norm(A, G, tid);
        else if (ph == PH_BASE) norm_phase(A, 0, 0, false, (int)blockIdx.x * 8, RT, G * 8, tid);
        else {
            const int q = ph - PH_BASE - 1, kj = q % PH_PER, lc = q / PH_PER, l = lc >> 1, ch = lc & 1;
            const int PKJ = PROBE_K < 3 ? PROBE_K - 1 : PROBE_K - 2;
            const int kq = (PROBE_K >= 1 && PROBE_K <= 8 && kj > PKJ) ? kj - 1 : kj;
            const int k = kq < 2 ? kq + 1 : kq + 2;
            const int sub = (PROBE_K >= 1 && PROBE_K <= 8 && kj == PKJ + 1) ? PROBE_SUB : 7;
            if (k == 6) norm_phase(A, l, ch, true, (int)blockIdx.x * 8, RT, G * 8, tid);
            else {
                Sched S; S.kind = k; S.l = l; S.ch = ch; S.G = G; S.c = (int)blockIdx.x; S.ap = A;
                pg8::Gemm g; g.lda = (k == 2 || k == 8) ? 4096 : (k == 4 ? YN : DM); g.ldb = g.lda;
                if (k == 2 && !(sub & 1)) {} else if (k == 1 || k == 2 || k == 7) { pg8::EpiBf E; E.act = (k == 7) ? 1 : 0; pg8::gemm_phase<pg8::EpiBf, Sched>(lds, g, S, E, tid); }
                else if (k == 4) { pg8::EpiMerge E; pg8::gemm_phase<pg8::EpiMerge, Sched>(lds, g, S, E, tid); }
                else { pg8::EpiRes E; pg8::gemm_phase<pg8::EpiRes, Sched>(lds, g, S, E, tid); }
                if (k == 8 && lc + 1 < DEPTH * NCH) {
                    const int l2 = (lc + 1) >> 1, ch2 = (lc + 1) & 1;
                    for (;;) { const int it = fetch_item(ctl + 64 * ph, lds, tid); if (it >= RT / 64) break; norm_phase(A, l2, ch2, false, it * 64, it * 64 + 64, 8, tid); }
                }
                if (k == 2) {
                    if (sub & 2) for (int it = (int)blockIdx.x - (G >> 1); it >= 0 && it < NB * 8; it += G - (G >> 1)) lru_sweep(A, l, it, lds, tid);
                    const int nseg = (l == 0) ? 576 : 512, total = (sub & 4) ? 2 * nseg : 0;
                    for (;;) { const int it = fetch_item(ctl + 64 * ph, lds, tid); if (it >= total) break;
                        if (it < nseg) pool_item(A, it, lds, tid);
                        else sconv_item(A, l, it - nseg, tid); }
                }
            }
        }
        if (ph + 1 < ph_hi) { if constexpr (COOP) { if (ph == 0) cg::this_grid().sync(); else xcd_barrier(xbar); } }
    }
}

extern "C" void kernel_launch(void* const* d_in, const int* in_sizes, int n_in, void* d_out, int out_size, void* d_ws, size_t ws_size, hipStream_t stream) {
    static int grid = 0;
    if (grid == 0) {
        if (n_in != 27 || out_size != NBATCH * SEQ * DM || ws_size < WS_END) { fprintf(stderr, "kernel_launch: unexpected shapes (n_in %d out %d ws %zu)\n", n_in, out_size, ws_size); grid = -1; return; }
        int dev = 0, cus = 0, per_cu = 0;
        hipGetDevice(&dev); hipDeviceGetAttribute(&cus, hipDeviceAttributeMultiprocessorCount, dev);
        hipFuncSetAttribute((const void*)fwd_kernel<true>, hipFuncAttributeMaxDynamicSharedMemorySize, LDS_BYTES);
        hipFuncSetAttribute((const void*)fwd_kernel<false>, hipFuncAttributeMaxDynamicSharedMemorySize, LDS_BYTES);
        hipOccupancyMaxActiveBlocksPerMultiprocessor(&per_cu, (const void*)fwd_kernel<true>, 512, LDS_BYTES);
        (void)hipGetLastError();
        if (per_cu < 1) per_cu = 1;
        grid = cus * 1;
        if (grid <= 0) grid = 256;
    }
    if (grid < 0) return;
    hipMemsetAsync((char*)d_ws + WS_CTL, 0, CTL_ZERO_BYTES, stream);
    Args a{};
    for (int i = 0; i < 27; ++i) a.in[i] = (const float*)d_in[i];
    a.out = (float*)d_out; a.ws = (unsigned char*)d_ws;
#if MK_COOP
    a.ph_lo = 0; a.ph_hi = NPHASE;
    void* args[] = {&a};
    hipError_t e = hipLaunchCooperativeKernel((const void*)fwd_kernel<true>, dim3(grid), dim3(512), args, LDS_BYTES, stream);
    if (e != hipSuccess) fprintf(stderr, "cooperative launch failed: %s (grid %d)\n", hipGetErrorString(e), grid);
#else
    for (int ph = 0; ph < NPHASE; ++ph) { a.ph_lo = ph; a.ph_hi = ph + 1; hipLaunchKernelGGL(fwd_kernel<false>, dim3(grid), dim3(512), LDS_BYTES, stream, a); }
#endif
}
```

```cpp
#include <hip/hip_runtime.h>
#include <hip/hip_cooperative_groups.h>
#include <cstdio>
#include <cstdint>
namespace cg = cooperative_groups;

#ifndef MK_COOP
#define MK_COOP 1
#endif
#define PROBE_SUB 7
#define PROBE_K -1

#define LAS __attribute__((address_space(3)))
typedef unsigned short bf16_t;
typedef short bf16x8 __attribute__((ext_vector_type(8)));
typedef float f32x4 __attribute__((ext_vector_type(4)));
typedef float f32x2 __attribute__((ext_vector_type(2)));
typedef unsigned u32x4 __attribute__((ext_vector_type(4)));
typedef unsigned u32x2 __attribute__((ext_vector_type(2)));

constexpr int NBATCH = 32, SEQ = 2048, CTXL = 256, DM = 1024, DEPTH = 2, DLRU = 512, NIN = 6400, DFF = 4096;
constexpr int NB = 16, NCH = 2;
constexpr int RL = NB * SEQ, RC = NB * CTXL, RT = RL + RC;
constexpr int ZN = 6144, YN = 1280;
constexpr int Z_LG = 512, Z_POOL = 1024, Z_SC = 1280, Z_GATE = 2048;
constexpr int Y_F = 512, Y_POOL = 768, Y_SC = 1024;
constexpr int NSC = 36;
constexpr size_t MiB = 1u << 20;
constexpr size_t WS_CTL = 0, CTL_ZERO_BYTES = 65536;
constexpr size_t WS_MOD = 1 * MiB, WS_WG = 3 * MiB, WS_SUMA = 4 * MiB, WS_SUMH = 7 * MiB, WS_DFTC = 10 * MiB, WS_DFT = 12 * MiB;
constexpr size_t WS_WIN = 28 * MiB, WS_WF = 52 * MiB, WS_WBR = 54 * MiB, WS_WOUT = 60 * MiB, WS_W1 = 64 * MiB, WS_W2 = 80 * MiB;
constexpr size_t WS_CTXW = 96 * MiB, WS_U = 128 * MiB, WS_MRG = 200 * MiB, WS_PT = 272 * MiB, WS_PTC = 304 * MiB, WS_Y = 336 * MiB, WS_Z = 432 * MiB;
constexpr size_t WS_HF = WS_Z + (size_t)RT * ZN * 2, WS_HB = WS_HF + (size_t)RT * DLRU * 4;
constexpr size_t WS_END = WS_HB + (size_t)RT * DLRU * 4;
static_assert(WS_END <= 1024 * MiB, "workspace map");
static_assert(WS_Y + (size_t)RT * YN * 2 <= WS_Z && WS_PTC + (size_t)NB * 256 * 4096 * 2 <= WS_Y && WS_MRG + (size_t)RT * DM * 2 <= WS_PT, "workspace map 2");
constexpr int LDS_BYTES = 147456, RING_BYTES = 131072, QSLOT_OFF = LDS_BYTES - 64;
constexpr int PH_PER = 7 + ((PROBE_K >= 1 && PROBE_K <= 8) ? 1 : 0), PH_BASE = (PROBE_K == 9) ? 2 : 1;
constexpr int NPHASE = PH_BASE + 2 + DEPTH * NCH * PH_PER;

__device__ __forceinline__ float bf_lo(unsigned w) { return __uint_as_float(w << 16); }
__device__ __forceinline__ float bf_hi(unsigned w) { return __uint_as_float(w & 0xffff0000u); }
__device__ __forceinline__ unsigned cvt_pk_bf16(float lo, float hi) { unsigned r; asm volatile("v_cvt_pk_bf16_f32 %0, %1, %2" : "=v"(r) : "v"(lo), "v"(hi)); return r; }
__device__ __forceinline__ float sigm(float x) { return __builtin_amdgcn_rcpf(1.0f + __expf(-x)); }
__device__ __forceinline__ float wave_sum(float v) {
#pragma unroll
    for (int o = 1; o < 64; o <<= 1) v += __shfl_xor(v, o);
    return v;
}
#define LDS_WAIT() asm volatile("s_waitcnt lgkmcnt(0)" ::: "memory")
#define DPP_SHR(ident, v, N) __builtin_bit_cast(float, __builtin_amdgcn_update_dpp(__builtin_bit_cast(int, (float)(ident)), __builtin_bit_cast(int, (float)(v)), 0x110 + (N), 0xf, 0xf, false))
#define SCAN_STEP(N) do { const float Ap_ = DPP_SHR(1.0f, Av, N), Bp_ = DPP_SHR(0.0f, Bv, N); Bv = Av * Bp_ + Bv; Av = Av * Ap_; } while (0)

namespace pg8 {
constexpr int BM = 256, BK = 64, HALF = 128, HTB = HALF * BK * 2, STAGE_BYTES = 8 * HTB, NXCD = 8, WGM = 8;
__host__ __device__ __forceinline__ int lds_byte(int r, int c) { const int st = (r >> 4) * 2 + (c >> 5), rr = r & 15, cc = c & 31, ob = rr * 64 + cc * 2; return st * 1024 + (ob ^ (((ob >> 9) & 1) << 5)); }
__host__ __device__ __forceinline__ void stage_rc(int b, int& R, int& C) { const int st = b / 1024, sb = b % 1024, swz = sb ^ (((sb >> 9) & 1) << 5); R = (st >> 1) * 16 + swz / 64; C = (st & 1) * 32 + (swz % 64) / 2; }
__host__ __device__ __forceinline__ int perm32(int rho) { const int n = rho >> 4, i = rho & 15; return 8 * (i >> 2) + 4 * n + (i & 3); }

struct Unit { const char* a; const char* b; char* dst; const char* x0; const char* x1; int nt, seg, ldc; float scale; };
struct Gemm { int lda, ldb; };

__device__ __forceinline__ bool tile_of(long L, int nM, int nN, int& pm, int& pn) {
    const int nwg = nM * nN; if (L >= nwg) return false;
    int wgid = (int)L; { const int q = nwg / NXCD, r = nwg % NXCD, xcd = wgid % NXCD, off = wgid / NXCD; wgid = (xcd < r ? xcd * (q + 1) : r * (q + 1) + (xcd - r) * q) + off; }
    const int nig = WGM * nN, gid = wgid / nig, fm = gid * WGM, gsz = (nM - fm) < WGM ? (nM - fm) : WGM;
    pm = fm + ((wgid % nig) % gsz); pn = (wgid % nig) / gsz; return true;
}

struct EpiBf {
    static constexpr bool PERM = true;
    int act;
    __device__ __forceinline__ bool operator()(f32x4 (&acc)[2][2][4][2], const Unit& u, int wr, int wc, int fr, int fq) const {
        bf16_t* base = (bf16_t*)u.dst + (size_t)(wr * 64 + fr) * u.ldc + wc * 32 + 8 * fq;
        const float sc = u.scale;
#pragma unroll
        for (int ai = 0; ai < 2; ++ai)
#pragma unroll
            for (int m = 0; m < 4; ++m) { bf16_t* rowp = base + (size_t)(ai * HALF + m * 16) * u.ldc;
#pragma unroll
                for (int bj = 0; bj < 2; ++bj) { f32x4 v0 = acc[ai][bj][m][0], v1 = acc[ai][bj][m][1];
                    if (u.seg == 2) {
#pragma unroll
                        for (int e = 0; e < 4; ++e) { v0[e] = 1.0f + __builtin_amdgcn_exp2f(fminf(v0[e] * -1.4426950408889634f, 40.f)); v1[e] = 1.0f + __builtin_amdgcn_exp2f(fminf(v1[e] * -1.4426950408889634f, 40.f)); } }
                    if (act == 1) {
#pragma unroll
                        for (int e = 0; e < 4; ++e) { const float a = fmaxf(v0[e], 0.f), b = fmaxf(v1[e], 0.f); v0[e] = a * a; v1[e] = b * b; } }
                    v0 = v0 * sc; v1 = v1 * sc;
                    u32x4 w; w.x = cvt_pk_bf16(v0[0], v0[1]); w.y = cvt_pk_bf16(v0[2], v0[3]); w.z = cvt_pk_bf16(v1[0], v1[1]); w.w = cvt_pk_bf16(v1[2], v1[3]);
                    *(u32x4*)(rowp + bj * HALF) = w; } }
        return true;
    }
};
struct EpiRes {
    static constexpr bool PERM = false;
    __device__ __forceinline__ bool operator()(f32x4 (&acc)[2][2][4][2], const Unit& u, int wr, int wc, int fr, int fq) const {
        const float* gv = (const float*)u.x1 + wc * 32 + 4 * fq;
        f32x4 g[2][2];
#pragma unroll
        for (int bj = 0; bj < 2; ++bj)
#pragma unroll
            for (int n = 0; n < 2; ++n) g[bj][n] = *(const f32x4*)(gv + bj * HALF + n * 16);
        const size_t o0 = (size_t)(wr * 64 + fr) * DM + wc * 32 + 4 * fq;
        const float* bs = (const float*)u.x0 + o0; float* od = (float*)u.dst + o0;
        f32x4 bc[2][2];
#pragma unroll
        for (int bj = 0; bj < 2; ++bj)
#pragma unroll
            for (int n = 0; n < 2; ++n) bc[bj][n] = *(const f32x4*)(bs + bj * HALF + n * 16);
#pragma unroll
        for (int am = 0; am < 8; ++am) { const int ai = am >> 2, m = am & 3; const size_t off = (size_t)(ai * HALF + m * 16) * DM;
            f32x4 bn[2][2];
            if (am < 7) { const size_t offn = (size_t)(((am + 1) >> 2) * HALF + ((am + 1) & 3) * 16) * DM;
#pragma unroll
                for (int bj = 0; bj < 2; ++bj)
#pragma unroll
                    for (int n = 0; n < 2; ++n) bn[bj][n] = *(const f32x4*)(bs + offn + bj * HALF + n * 16); }
#pragma unroll
            for (int bj = 0; bj < 2; ++bj)
#pragma unroll
                for (int n = 0; n < 2; ++n) *(f32x4*)(od + off + bj * HALF + n * 16) = bc[bj][n] + g[bj][n] * acc[ai][bj][m][n];
            if (am < 7) {
#pragma unroll
                for (int bj = 0; bj < 2; ++bj)
#pragma unroll
                    for (int n = 0; n < 2; ++n) bc[bj][n] = bn[bj][n]; }
        }
        return true;
    }
};
struct EpiMerge {
    static constexpr bool PERM = true;
    __device__ __forceinline__ void apply(const bool LAST, f32x4 (&acc)[2][2][4][2], const Unit& u, int wr, int wc, int fr, int fq) const {
        const bf16_t* g0 = (const bf16_t*)u.x0 + (size_t)(wr * 64 + fr) * ZN + wc * 32 + 8 * fq;
        bf16_t* base = (bf16_t*)u.dst + (size_t)(wr * 64 + fr) * DM + wc * 32 + 8 * fq;
        const int gboff = LAST ? 0 : DM;
        u32x4 ga[2][2][2], gb[2][2][2];
#pragma unroll
        for (int mm = 0; mm < 2; ++mm)
#pragma unroll
            for (int bj = 0; bj < 2; ++bj) { const bf16_t* rp = g0 + (size_t)(mm * 16) * ZN + bj * HALF; ga[0][mm][bj] = *(const u32x4*)rp; gb[0][mm][bj] = *(const u32x4*)(rp + gboff); }
#pragma unroll
        for (int am = 0; am < 4; ++am) { const int ai = am >> 1, m0 = (am & 1) * 2, cb_ = am & 1, nb_ = cb_ ^ 1;
            if (am < 3) { const int ai2 = (am + 1) >> 1, m02 = ((am + 1) & 1) * 2;
#pragma unroll
                for (int mm = 0; mm < 2; ++mm)
#pragma unroll
                    for (int bj = 0; bj < 2; ++bj) { const bf16_t* rp = g0 + (size_t)(ai2 * HALF + (m02 + mm) * 16) * ZN + bj * HALF; ga[nb_][mm][bj] = *(const u32x4*)rp; gb[nb_][mm][bj] = *(const u32x4*)(rp + gboff); } }
            asm volatile("" ::: "memory");
#pragma unroll
            for (int mm = 0; mm < 2; ++mm)
#pragma unroll
                for (int bj = 0; bj < 2; ++bj) { const int m = m0 + mm;
                    f32x4 v0 = acc[ai][bj][m][0], v1 = acc[ai][bj][m][1];
#pragma unroll
                    for (int e = 0; e < 4; ++e) {
                        const unsigned wa = ga[cb_][mm][bj][e], wb = gb[cb_][mm][bj][e];
                        const float f0 = (LAST ? 1.f : bf_lo(wb)) * __builtin_amdgcn_rcpf(bf_lo(wa)), f1 = (LAST ? 1.f : bf_hi(wb)) * __builtin_amdgcn_rcpf(bf_hi(wa));
                        if (e < 2) { v0[2 * e] *= f0; v0[2 * e + 1] *= f1; } else { v1[2 * (e - 2)] *= f0; v1[2 * (e - 2) + 1] *= f1; }
                    }
                    acc[ai][bj][m][0] = v0; acc[ai][bj][m][1] = v1;
                    if (LAST) { u32x4 w; w.x = cvt_pk_bf16(v0[0], v0[1]); w.y = cvt_pk_bf16(v0[2], v0[3]); w.z = cvt_pk_bf16(v1[0], v1[1]); w.w = cvt_pk_bf16(v1[2], v1[3]);
                        *(u32x4*)(base + (size_t)(ai * HALF + m * 16) * DM + bj * HALF) = w; }
                }
        }
    }
    __device__ __forceinline__ bool operator()(f32x4 (&acc)[2][2][4][2], const Unit& u, int wr, int wc, int fr, int fq) const {
        const bool last = (u.seg == 3); apply(last, acc, u, wr, wc, fr, fq); return last;
    }
};

template <class Epi, class Sched>
__device__ __forceinline__ void gemm_phase(LAS unsigned char* lds, const Gemm g, const Sched& S, const Epi& E, const int tid) {
    const int wid = __builtin_amdgcn_readfirstlane(tid >> 6), lane = tid & 63, wr = wid >> 2, wc = wid & 3, fr = lane & 15, fq = lane >> 4;
    unsigned voffA[2], voffB[2];
#pragma unroll
    for (int i = 0; i < 2; ++i) { int R, C; stage_rc(tid * 16 + i * 8192, R, C); const int Rb = Epi::PERM ? ((R & ~31) + perm32(R & 31)) : R;
        voffA[i] = (unsigned)(R * g.lda + C) * 2u; voffB[i] = (unsigned)(Rb * g.ldb + C) * 2u; }
    const size_t kstep = (size_t)(BK * 2);
    const size_t hstepA = (size_t)HALF * g.lda * 2, hstepB = (size_t)HALF * g.ldb * 2;
    const unsigned ldsw = (unsigned)wid * 1024u;
    const int aoff = lds_byte(wr * 64 + fr, fq * 8), boff = lds_byte(wc * 32 + fr, fq * 8);
#define PG8_SA(b, h) (((b) * 2 + (h)) * HTB)
#define PG8_SB(b, h) ((4 + (b) * 2 + (h)) * HTB)
#define PG8_STAGE(bufoff, gbase, voff) do { _Pragma("unroll") for (int _i = 0; _i < 2; ++_i) \
        __builtin_amdgcn_global_load_lds((const unsigned*)((const char*)(gbase) + (voff)[_i]), (LAS unsigned*)(lds + (bufoff) + ldsw + _i * 8192), 16, 0, 0); } while (0)
#define PG8_LDA(dst, b, h) do { _Pragma("unroll") for (int m = 0; m < 4; ++m) _Pragma("unroll") for (int k = 0; k < 2; ++k) dst[m][k] = *(const LAS bf16x8*)(lds + PG8_SA(b, h) + aoff + m * 2048 + k * 1024); } while (0)
#define PG8_LDB(dst, b, h) do { _Pragma("unroll") for (int n = 0; n < 2; ++n) _Pragma("unroll") for (int k = 0; k < 2; ++k) dst[n][k] = *(const LAS bf16x8*)(lds + PG8_SB(b, h) + boff + n * 2048 + k * 1024); } while (0)
#define PG8_MMA(ai, bj, At, Bt) do { __builtin_amdgcn_s_setprio(1); _Pragma("unroll") for (int m = 0; m < 4; ++m) _Pragma("unroll") for (int n = 0; n < 2; ++n) _Pragma("unroll") for (int k = 0; k < 2; ++k) \
        acc[ai][bj][m][n] = __builtin_amdgcn_mfma_f32_16x16x32_bf16(Bt[n][k], At[m][k], acc[ai][bj][m][n], 0, 0, 0); __builtin_amdgcn_s_setprio(0); } while (0)
#define PG8_WAIT_V(n) asm volatile("s_waitcnt vmcnt(" #n ")" ::: "memory")
#define PG8_WAIT_L(n) asm volatile("s_waitcnt lgkmcnt(" #n ")" ::: "memory")
#define PG8_BAR __builtin_amdgcn_s_barrier()
#define PG8_SCHED __builtin_amdgcn_sched_barrier(0)
    Unit cur, nxt; int ui = 0;
    if (!S.next(0, cur)) return;
    f32x4 acc[2][2][4][2];
#pragma unroll
    for (int a = 0; a < 2; ++a)
#pragma unroll
        for (int b = 0; b < 2; ++b)
#pragma unroll
            for (int m = 0; m < 4; ++m)
#pragma unroll
                for (int n = 0; n < 2; ++n) acc[a][b][m][n] = (f32x4){0.f, 0.f, 0.f, 0.f};
    bf16x8 At[4][2], B0[2][2], B1[2][2];
    const char* cA = cur.a; const char* cB = cur.b;
    PG8_STAGE(PG8_SB(0, 0), cB, voffB); PG8_STAGE(PG8_SB(0, 1), cB + hstepB, voffB); PG8_STAGE(PG8_SA(0, 0), cA, voffA); PG8_STAGE(PG8_SA(0, 1), cA + hstepA, voffA);
    if (wr == 1) PG8_BAR;
    PG8_WAIT_V(2); PG8_BAR;
    PG8_STAGE(PG8_SB(1, 0), cB + kstep, voffB); PG8_STAGE(PG8_SA(1, 0), cA + kstep, voffA); PG8_STAGE(PG8_SB(1, 1), cB + hstepB + kstep, voffB);
    PG8_WAIT_V(6); PG8_BAR;
    for (;;) {
        const bool has_next = S.next(ui + 1, nxt);
        const char* nA = has_next ? nxt.a : cA; const char* nB = has_next ? nxt.b : cB;
        const int nt = cur.nt;
        for (int t = 0; t < nt; t += 2) {
            const bool last = (t == nt - 2);
            const char* a1 = cA + (size_t)(t + 1) * kstep;
            const char* a2 = last ? nA : cA + (size_t)(t + 2) * kstep; const char* b2 = last ? nB : cB + (size_t)(t + 2) * kstep;
            const char* a3 = a2 + kstep; const char* b3 = b2 + kstep;
            PG8_LDB(B0, 0, 0); PG8_LDB(B1, 0, 1); PG8_SCHED; PG8_LDA(At, 0, 0); PG8_STAGE(PG8_SA(1, 1), a1 + hstepA, voffA);
            PG8_WAIT_V(8); PG8_WAIT_L(0); PG8_BAR; PG8_MMA(0, 0, At, B0); PG8_MMA(0, 1, At, B1); PG8_BAR; PG8_SCHED;
            PG8_LDA(At, 0, 1); PG8_STAGE(PG8_SB(0, 0), b2, voffB); PG8_STAGE(PG8_SB(0, 1), b2 + hstepB, voffB); PG8_STAGE(PG8_SA(0, 0), a2, voffA);
            PG8_WAIT_V(8); PG8_WAIT_L(0); PG8_BAR; PG8_MMA(1, 0, At, B0); PG8_MMA(1, 1, At, B1); PG8_BAR; PG8_SCHED;
            PG8_LDB(B0, 1, 0); PG8_LDB(B1, 1, 1); PG8_SCHED; PG8_LDA(At, 1, 0); PG8_STAGE(PG8_SA(0, 1), a2 + hstepA, voffA);
            PG8_WAIT_V(8); PG8_WAIT_L(0); PG8_BAR; PG8_MMA(0, 0, At, B0); PG8_MMA(0, 1, At, B1); PG8_BAR; PG8_SCHED;
            PG8_LDA(At, 1, 1); PG8_STAGE(PG8_SB(1, 0), b3, voffB); PG8_STAGE(PG8_SB(1, 1), b3 + hstepB, voffB); PG8_STAGE(PG8_SA(1, 0), a3, voffA);
            PG8_WAIT_V(8); PG8_WAIT_L(0); PG8_BAR; PG8_MMA(1, 0, At, B0); PG8_MMA(1, 1, At, B1); PG8_BAR; PG8_SCHED;
        }
        if (wr == 0) PG8_BAR;
        const bool zero = E(acc, cur, wr, wc, fr, fq);
        if (!has_next) break;
        if (zero) {
#pragma unroll
            for (int a = 0; a < 2; ++a)
#pragma unroll
                for (int b = 0; b < 2; ++b)
#pragma unroll
                    for (int m = 0; m < 4; ++m)
#pragma unroll
                        for (int n = 0; n < 2; ++n) acc[a][b][m][n] = (f32x4){0.f, 0.f, 0.f, 0.f};
        }
        cur = nxt; cA = nA; cB = nB; ++ui;
        if (wr == 1) PG8_BAR;
    }
    PG8_WAIT_V(0);
    PG8_BAR;
#undef PG8_SA
#undef PG8_SB
#undef PG8_STAGE
#undef PG8_LDA
#undef PG8_LDB
#undef PG8_MMA
#undef PG8_WAIT_V
#undef PG8_WAIT_L
#undef PG8_BAR
#undef PG8_SCHED
}
}

struct Args { const float* in[27]; float* out; unsigned char* ws; int ph_lo, ph_hi; };
typedef const __attribute__((address_space(4))) Args* ArgP;
enum { I_X = 0, I_C, I_CTX, I_CCTX, I_WMOD, I_BMOD, I_G1, I_G2, I_WIN, I_CONVW, I_CONVB, I_WA, I_BA, I_WX, I_BX, I_LAM, I_POOLW, I_POOLS, I_SCW,
       I_BRL, I_BRF, I_BRP, I_BRS, I_WOUT, I_FF1, I_FF2, I_GF };

struct Sched {
    int kind, l, ch, G, c;
    ArgP ap;
    __device__ __forceinline__ bool next(int i, pg8::Unit& u) const {
        unsigned char* ws = ap->ws;
        const long L = (long)i * G + c;
        const int nM = (l == 0) ? RT / 256 : RL / 256;
        u.x0 = nullptr; u.x1 = nullptr; u.seg = 0; u.scale = 1.f;
        int pm, pn;
        if (kind == 1) {
            const char* U = (const char*)(ws + WS_U);
            const int nZ = nM * 24;
            long L2 = L - nZ; bool isz = false;
            if (L < nZ) { pg8::tile_of(L, nM, 24, pm, pn); isz = true; }
            else if (l == 1) { if (L2 < 32) { pm = 128 + (int)(L2 >> 1); pn = (int)(L2 & 1); isz = true; } else L2 -= 32; }
            if (isz) {
                u.a = U + (size_t)pm * 256 * DM * 2; u.b = (const char*)(ws + WS_WIN) + ((size_t)l * ZN + (size_t)pn * 256) * DM * 2; u.nt = 16;
                u.dst = (char*)(ws + WS_Z) + ((size_t)pm * 256 * ZN + (size_t)pn * 256) * 2; u.ldc = ZN; u.seg = (pn >= 8) ? 2 : 0; return true;
            }
            if (L2 >= 2 * nM) return false;
            const int seg = (int)(L2 & 1), tt = (int)(L2 >> 1);
            u.a = (const char*)(ws + WS_WF) + ((size_t)l * 512 + (size_t)seg * 256) * DM * 2; u.b = U + (size_t)tt * 256 * DM * 2; u.nt = 16; u.ldc = 4096;
            if (tt < 128) u.dst = (char*)(ws + WS_PT) + ((size_t)(tt >> 3) * 256 * 4096 + (size_t)seg * 2048 + (size_t)(tt & 7) * 256) * 2;
            else u.dst = (char*)(ws + WS_PTC) + ((size_t)(tt - 128) * 256 * 4096 + (size_t)seg * 256) * 2;
            return true;
        }
        if (kind == 7) {
            if (!pg8::tile_of(L, nM, 16, pm, pn)) return false;
            u.a = (const char*)(ws + WS_U) + (size_t)pm * 256 * DM * 2; u.b = (const char*)(ws + WS_W1) + ((size_t)l * DFF + (size_t)pn * 256) * DM * 2; u.nt = 16;
            u.dst = (char*)(ws + WS_Z) + ((size_t)pm * 256 * DFF + (size_t)pn * 256) * 2; u.ldc = DFF; return true;
        }
        if (kind == 2) {
            if (L < 128) { const int b_ = (int)(L >> 3), kt = (int)(L & 7);
                u.a = (const char*)(ws + WS_DFT) + (size_t)kt * 256 * 4096 * 2; u.b = (const char*)(ws + WS_PT) + (size_t)b_ * 256 * 4096 * 2; u.nt = 64;
                u.dst = (char*)(ws + WS_Y) + ((size_t)(b_ * SEQ + kt * 256) * YN + Y_F) * 2; u.ldc = YN; u.scale = 0.001381067932004975f  ; return true; }
            if (l == 0 && L < 144) { const int j = (int)L - 128;
                u.a = (const char*)(ws + WS_DFTC); u.b = (const char*)(ws + WS_PTC) + (size_t)j * 256 * 4096 * 2; u.nt = 8;
                u.dst = (char*)(ws + WS_Y) + ((size_t)(RL + j * 256) * YN + Y_F) * 2; u.ldc = YN; u.scale = 1.f / 256.f; return true; }
            return false;
        }
        if (kind == 4) {
            const int seg = i & 3; const long T = (long)(i >> 2) * G + c;
            if (!pg8::tile_of(T, nM, 4, pm, pn)) return false;
            const int coff = seg == 0 ? 0 : (256 + 256 * seg);
            u.a = (const char*)(ws + WS_Y) + ((size_t)pm * 256 * YN + coff) * 2; u.b = (const char*)(ws + WS_WBR) + (((size_t)l * DM + (size_t)pn * 256) * YN + coff) * 2;
            u.nt = seg == 0 ? 8 : 4; u.seg = seg; u.ldc = DM;
            u.dst = (char*)(ws + WS_MRG) + ((size_t)pm * 256 * DM + (size_t)pn * 256) * 2;
            u.x0 = (const char*)(ws + WS_Z) + ((size_t)pm * 256 * ZN + Z_GATE + seg * DM + pn * 256) * 2;
            return true;
        }
        if (!pg8::tile_of(L, nM, 4, pm, pn)) return false;
        if (kind == 5) { u.a = (const char*)(ws + WS_MRG) + (size_t)pm * 256 * DM * 2; u.b = (const char*)(ws + WS_WOUT) + ((size_t)l * DM + (size_t)pn * 256) * DM * 2; u.nt = 16; }
        else { u.a = (const char*)(ws + WS_Z) + (size_t)pm * 256 * DFF * 2; u.b = (const char*)(ws + WS_W2) + ((size_t)l * DM + (size_t)pn * 256) * DFF * 2; u.nt = 64; }
        int bidx; size_t eoff;
        if (pm < 128) { eoff = ((size_t)(ch * RL + pm * 256) * DM + pn * 256) * 4; bidx = ch * NB + (pm >> 3);
            char* out = (char*)ap->out; u.dst = out + eoff; u.x0 = (kind == 5 && l == 0) ? (const char*)ap->in[I_X] + eoff : (const char*)out + eoff; }
        else { eoff = ((size_t)(ch * RC + (pm - 128) * 256) * DM + pn * 256) * 4; bidx = 32;
            u.dst = (char*)(ws + WS_CTXW) + eoff; u.x0 = (kind == 5) ? (const char*)ap->in[I_CTX] + eoff : (const char*)(ws + WS_CTXW) + eoff; }
        u.x1 = (const char*)(ws + WS_MOD) + ((size_t)((l * 33 + bidx) * 6 + (kind == 5 ? 2 : 5)) * DM + pn * 256) * 4;
        u.ldc = DM;
        return true;
    }
};

__device__ __forceinline__ void tr_item(const float* W, int ldw, int col0, int ncols, bf16_t* WT, int ldt, int koff, LAS float* scr, int item, int lane) {
    const int nblk = ncols / 32, kb = item / nblk, nb = item % nblk, k0 = 64 * kb, n0 = 32 * nb;
#pragma unroll 8
    for (int i = 0; i < 32; ++i) { const int kk = 2 * i + (lane >> 5); scr[kk * 33 + (lane & 31)] = W[(size_t)(k0 + kk) * ldw + col0 + n0 + (lane & 31)]; }
    LDS_WAIT(); asm volatile("" ::: "memory");
    const int c = lane & 7;
#pragma unroll
    for (int j = 0; j < 4; ++j) { const int n = (lane >> 3) + 8 * j; const LAS float* s = scr + (8 * c) * 33 + n;
        u32x4 o; o.x = cvt_pk_bf16(s[0 * 33], s[1 * 33]); o.y = cvt_pk_bf16(s[2 * 33], s[3 * 33]); o.z = cvt_pk_bf16(s[4 * 33], s[5 * 33]); o.w = cvt_pk_bf16(s[6 * 33], s[7 * 33]);
        *(u32x4*)(WT + (size_t)(n0 + n) * ldt + koff + k0 + 8 * c) = o; }
    LDS_WAIT(); asm volatile("" ::: "memory");
}

__device__ __forceinline__ void p0_prologue(ArgP A, LAS unsigned char* lds, int G, const int tid) {
    const int lane = tid & 63, wave = tid >> 6, bx = blockIdx.x;
    unsigned char* ws = A->ws;
    if (bx < 192) {
        const int l = bx / 96, cb = bx % 96, n = cb * 64 + lane;
        LAS float* sl = (LAS float*)lds;
        for (int idx = tid; idx < 33 * 1024; idx += 512) { const int bb = idx >> 10, k = idx & 1023; const float v = bb < 32 ? A->in[I_C][bb * 1024 + k] : A->in[I_CCTX][k]; sl[idx] = v * sigm(v); }
        __syncthreads();
        float acc[33];
#pragma unroll
        for (int bb = 0; bb < 33; ++bb) acc[bb] = 0.f;
        const float* wp = A->in[I_WMOD] + ((size_t)l * 1024 + wave * 128) * 6144 + n;
        for (int k4 = 0; k4 < 32; ++k4) {
            const float w0 = wp[(size_t)(4 * k4 + 0) * 6144], w1 = wp[(size_t)(4 * k4 + 1) * 6144], w2 = wp[(size_t)(4 * k4 + 2) * 6144], w3 = wp[(size_t)(4 * k4 + 3) * 6144];
#pragma unroll
            for (int bb = 0; bb < 33; ++bb) { const f32x4 s = *(const LAS f32x4*)(sl + bb * 1024 + wave * 128 + 4 * k4); acc[bb] += s[0] * w0 + s[1] * w1 + s[2] * w2 + s[3] * w3; }
        }
        __syncthreads();
        LAS float* red = (LAS float*)lds;
#pragma unroll
        for (int bb = 0; bb < 33; ++bb) red[(wave * 33 + bb) * 64 + lane] = acc[bb];
        __syncthreads();
        float* MOD = (float*)(ws + WS_MOD);
        for (int idx = tid; idx < 33 * 64; idx += 512) { const int bb = idx >> 6, ln = idx & 63; float s = A->in[I_BMOD][l * 6144 + cb * 64 + ln];
#pragma unroll
            for (int w = 0; w < 8; ++w) s += red[(w * 33 + bb) * 64 + ln];
            MOD[(size_t)(l * 33 + bb) * 6144 + cb * 64 + ln] = s; }
        __syncthreads();
    } else if (bx < 224) {
        const int it = bx - 192, l = it >> 4, k0 = (it & 15) * 64;
        LAS float* wt = (LAS float*)lds;
        LAS float* tab = (LAS float*)(lds + 65536);
        for (int idx = tid; idx < 64 * 256; idx += 512) { const int kk = idx >> 8, c = idx & 255; wt[idx] = A->in[I_WIN][((size_t)l * 1024 + k0 + kk) * NIN + 1024 + c]; }
        { const int i = tid & 255; tab[tid] = (tid < 256) ? cospif((float)i / 128.f) : sinpif((float)i / 128.f); }
        __syncthreads();
        const int m = tid & 255; const LAS float* tb = tab + (tid >> 8) * 256;
        bf16_t* WF = (bf16_t*)(ws + WS_WF) + ((size_t)l * 512 + tid) * DM + k0;
        for (int kg = 0; kg < 8; ++kg) {
            float a[8];
#pragma unroll
            for (int q = 0; q < 8; ++q) a[q] = 0.f;
            for (int c = 0; c < 256; ++c) { const float tv = tb[(m * c) & 255];
#pragma unroll
                for (int q = 0; q < 8; ++q) a[q] += wt[(kg * 8 + q) * 256 + c] * tv; }
            u32x4 o; o.x = cvt_pk_bf16(a[0], a[1]); o.y = cvt_pk_bf16(a[2], a[3]); o.z = cvt_pk_bf16(a[4], a[5]); o.w = cvt_pk_bf16(a[6], a[7]);
            *(u32x4*)(WF + kg * 8) = o;
        }
        __syncthreads();
    }
    {
        LAS float* scr = (LAS float*)(lds + wave * 16384);
        const int gw = wave * G + bx, NGW = G * 8;
        for (int it = gw; it < 16384; it += NGW) {
            const int l = it >> 13; int r = it & 8191;
            const float* win = A->in[I_WIN] + (size_t)l * 1024 * NIN;
            bf16_t* WIN = (bf16_t*)(ws + WS_WIN) + (size_t)l * ZN * DM;
            bf16_t* WBR = (bf16_t*)(ws + WS_WBR) + (size_t)l * DM * YN;
            if (r < 512) { tr_item(win, NIN, 0, 1024, WIN, DM, 0, scr, r, lane); continue; } r -= 512;
            if (r < 2560) { tr_item(win, NIN, 1280, 5120, WIN + (size_t)1024 * DM, DM, 0, scr, r, lane); continue; } r -= 2560;
            if (r < 256) { tr_item(A->in[I_BRL] + (size_t)l * 512 * DM, DM, 0, DM, WBR, YN, 0, scr, r, lane); continue; } r -= 256;
            if (r < 128) { tr_item(A->in[I_BRF] + (size_t)l * 256 * DM, DM, 0, DM, WBR, YN, Y_F, scr, r, lane); continue; } r -= 128;
            if (r < 128) { tr_item(A->in[I_BRS] + (size_t)l * 256 * DM, DM, 0, DM, WBR, YN, Y_SC, scr, r, lane); continue; } r -= 128;
            if (r < 512) { tr_item(A->in[I_WOUT] + (size_t)l * DM * DM, DM, 0, DM, (bf16_t*)(ws + WS_WOUT) + (size_t)l * DM * DM, DM, 0, scr, r, lane); continue; } r -= 512;
            if (r < 2048) { tr_item(A->in[I_FF1] + (size_t)l * DM * DFF, DFF, 0, DFF, (bf16_t*)(ws + WS_W1) + (size_t)l * DFF * DM, DM, 0, scr, r, lane); continue; } r -= 2048;
            tr_item(A->in[I_FF2] + (size_t)l * DFF * DM, DM, 0, DM, (bf16_t*)(ws + WS_W2) + (size_t)l * DM * DFF, DFF, 0, scr, r, lane);
        }
    }
    const int gt = bx * 512 + tid, NGT = G * 512;
    {
        bf16_t* WG = (bf16_t*)(ws + WS_WG);
        for (int idx = gt; idx < 2 * 8 * 256 * 64; idx += NGT) { const int i = idx & 63, n = (idx >> 6) & 255, h = (idx >> 14) & 7, l = idx >> 17, d = n >> 7, gate = (n >> 6) & 1, j = n & 63;
            const float v = (gate ? A->in[I_WX] : A->in[I_WA])[((size_t)((l * 2 + d) * 8 + h) * 64 + i) * 64 + j];
            WG[idx] = (bf16_t)(cvt_pk_bf16(v, 0.f) & 0xffffu); }
    }
    {
        for (int idx = gt; idx < 2 * 256 * 1024; idx += NGT) { const int n = idx & 1023, i = (idx >> 10) & 255, l = idx >> 18, g = i >> 6, il = i & 63;
            const float* pw = A->in[I_POOLW] + ((size_t)(l * 4 + g) * 64 + il) * 64; const float* ps = A->in[I_POOLS] + l * 256 + g * 64; const float* wb = A->in[I_BRP] + ((size_t)l * 256 + g * 64) * DM + n;
            float s = 0.f;
            for (int j = 0; j < 64; ++j) s += pw[j] * ps[j] * wb[(size_t)j * DM];
            ((bf16_t*)(ws + WS_WBR))[((size_t)l * DM + n) * YN + Y_POOL + i] = (bf16_t)(cvt_pk_bf16(s, 0.f) & 0xffffu); }
    }
    {
        bf16_t* DF = (bf16_t*)(ws + WS_DFT);
        for (int idx = gt; idx < 2048 * 512; idx += NGT) { const int k = idx >> 9, n8 = (idx & 511) * 8; float v[8];
#pragma unroll
            for (int e = 0; e < 8; ++e) { const int np = n8 + e; if (np < 2048) v[e] = cospif((float)((k * np) & 2047) * (1.f / 1024.f)); else v[e] = -sinpif((float)((k * (np - 2048)) & 2047) * (1.f / 1024.f)); }
            u32x4 o; o.x = cvt_pk_bf16(v[0], v[1]); o.y = cvt_pk_bf16(v[2], v[3]); o.z = cvt_pk_bf16(v[4], v[5]); o.w = cvt_pk_bf16(v[6], v[7]);
            *(u32x4*)(DF + (size_t)k * 4096 + n8) = o; }
        bf16_t* DC = (bf16_t*)(ws + WS_DFTC);
        for (int idx = gt; idx < 256 * 64; idx += NGT) { const int k = idx >> 6, n8 = (idx & 63) * 8; float v[8];
#pragma unroll
            for (int e = 0; e < 8; ++e) { const int np = n8 + e; if (np < 256) v[e] = cospif((float)((k * np) & 255) * (1.f / 128.f)); else v[e] = -sinpif((float)((k * (np - 256)) & 255) * (1.f / 128.f)); }
            u32x4 o; o.x = cvt_pk_bf16(v[0], v[1]); o.y = cvt_pk_bf16(v[2], v[3]); o.z = cvt_pk_bf16(v[4], v[5]); o.w = cvt_pk_bf16(v[6], v[7]);
            *(u32x4*)(DC + (size_t)k * 4096 + n8) = o; }
    }
}

__device__ __forceinline__ void norm_phase(ArgP A, int l, int ch, bool second, int r_begin, int r_end, int r_step, const int tid) {
    const int lane = tid & 63, wave = tid >> 6;
    unsigned char* ws = A->ws;
    const int nrows = (second && l == 1) ? RL : RT, rend = r_end < nrows ? r_end : nrows;
    const float* gn = (second ? A->in[I_G2] : A->in[I_G1]) + l * DM;
    const float* MOD = (const float*)(ws + WS_MOD);
    bf16_t* U = (bf16_t*)(ws + WS_U);
    for (int r0 = r_begin + wave; r0 < rend; r0 += 2 * r_step) {
        const float* src[2]; const float* sh[2]; int rr[2]; bool ok[2];
#pragma unroll
        for (int q = 0; q < 2; ++q) { const int rq = r0 + q * r_step; ok[q] = rq < rend; const int r = ok[q] ? rq : r0; rr[q] = r; int bidx;
            if (r < RL) { const size_t grow = (size_t)ch * RL + r; src[q] = ((!second && l == 0) ? A->in[I_X] : (const float*)A->out) + grow * DM; bidx = ch * NB + (r >> 11); }
            else { const size_t grow = (size_t)ch * RC + (r - RL); src[q] = ((!second && l == 0) ? A->in[I_CTX] : (const float*)(ws + WS_CTXW)) + grow * DM; bidx = 32; }
            sh[q] = MOD + (size_t)((l * 33 + bidx) * 6 + (second ? 3 : 0)) * DM; }
        f32x4 v[2][4]; float s[2] = {0.f, 0.f};
#pragma unroll
        for (int q = 0; q < 2; ++q)
#pragma unroll
            for (int j = 0; j < 4; ++j) v[q][j] = *(const f32x4*)(src[q] + 4 * (lane + 64 * j));
#pragma unroll
        for (int q = 0; q < 2; ++q) {
#pragma unroll
            for (int j = 0; j < 4; ++j) s[q] += (v[q][j][0] * v[q][j][0] + v[q][j][1] * v[q][j][1]) + (v[q][j][2] * v[q][j][2] + v[q][j][3] * v[q][j][3]);
            s[q] = 1.0f / sqrtf(wave_sum(s[q]) * (1.f / DM) + 1e-6f); }
#pragma unroll
        for (int q = 0; q < 2; ++q) { if (!ok[q]) continue;
#pragma unroll
            for (int j = 0; j < 4; ++j) { const int col = 4 * (lane + 64 * j);
                const f32x4 gg = *(const f32x4*)(gn + col), s1 = *(const f32x4*)(sh[q] + DM + col), s0 = *(const f32x4*)(sh[q] + col);
                const f32x4 o = (v[q][j] * s[q]) * gg * (s1 + 1.0f) + s0;
                u32x2 w; w.x = cvt_pk_bf16(o[0], o[1]); w.y = cvt_pk_bf16(o[2], o[3]);
                *(u32x2*)(U + (size_t)rr[q] * DM + col) = w; } }
    }
}
__device__ __forceinline__ void final_norm(ArgP A, int G, const int tid) {
    const int lane = tid & 63, wave = tid >> 6;
    const float* gn = A->in[I_GF];
    for (int r0 = blockIdx.x * 8 + wave; r0 < NBATCH * SEQ; r0 += 2 * G * 8) {
        float* p[2]; f32x4 v[2][4]; float s[2] = {0.f, 0.f};
#pragma unroll
        for (int q = 0; q < 2; ++q) { int r = r0 + q * G * 8; if (r >= NBATCH * SEQ) r = r0; p[q] = A->out + (size_t)r * DM;
#pragma unroll
            for (int j = 0; j < 4; ++j) v[q][j] = *(const f32x4*)(p[q] + 4 * (lane + 64 * j)); }
#pragma unroll
        for (int q = 0; q < 2; ++q) {
#pragma unroll
            for (int j = 0; j < 4; ++j) s[q] += (v[q][j][0] * v[q][j][0] + v[q][j][1] * v[q][j][1]) + (v[q][j][2] * v[q][j][2] + v[q][j][3] * v[q][j][3]);
            s[q] = 1.0f / sqrtf(wave_sum(s[q]) * (1.f / DM) + 1e-6f); }
#pragma unroll
        for (int q = 0; q < 2; ++q)
#pragma unroll
            for (int j = 0; j < 4; ++j) { const int col = 4 * (lane + 64 * j); const f32x4 gg = *(const f32x4*)(gn + col); *(f32x4*)(p[q] + col) = (v[q][j] * s[q]) * gg; }
    }
}

__device__ __forceinline__ void unpack8(const u32x4 w, float (&f)[8]) {
#pragma unroll
    for (int e = 0; e < 4; ++e) { f[2 * e] = bf_lo(w[e]); f[2 * e + 1] = bf_hi(w[e]); }
}
__device__ __forceinline__ u32x4 pack8(const float (&f)[8]) { u32x4 o; o.x = cvt_pk_bf16(f[0], f[1]); o.y = cvt_pk_bf16(f[2], f[3]); o.z = cvt_pk_bf16(f[4], f[5]); o.w = cvt_pk_bf16(f[6], f[7]); return o; }

__device__ __forceinline__ void lru_item(ArgP A, int l, int it, bool pass2, LAS unsigned char* lds, const int tid) {
    const int lane = tid & 63, wid = tid >> 6;
    unsigned char* ws = A->ws;
    const int head = it & 7, rest = it >> 3;
    int sc, bl;
    if (!pass2 || l == 0) { sc = rest % NSC; bl = rest / NSC; } else { sc = 4 + (rest & 31); bl = rest >> 5; }
    const bool isctx = sc < 4; const int c = isctx ? sc : sc - 4, Lseq = isctx ? CTXL : SEQ, rowbase = isctx ? RL + bl * CTXL : bl * SEQ, t0 = c * 64;
    const bf16_t* Z = (const bf16_t*)(ws + WS_Z);
    LAS float* xaf = (LAS float*)lds;
    LAS bf16_t* xab = (LAS bf16_t*)(lds + 17408);
    LAS float* hbuf = (LAS float*)(lds + 32768);
    {
        const int t = tid >> 3, i8 = (tid & 7) * 8, tok = t0 + t, Cc = head * 64 + i8;
        float acc[8];
        { const f32x4 b0 = *(const f32x4*)(A->in[I_CONVB] + l * DLRU + Cc), b1 = *(const f32x4*)(A->in[I_CONVB] + l * DLRU + Cc + 4);
#pragma unroll
          for (int e = 0; e < 4; ++e) { acc[e] = b0[e]; acc[4 + e] = b1[e]; } }
#pragma unroll
        for (int k = 0; k < 4; ++k) { const int tt = tok + k - 2;
            if (tt >= 0 && tt < Lseq) { float z[8]; unpack8(*(const u32x4*)(Z + (size_t)(rowbase + tt) * ZN + Cc), z);
                const float* cw = A->in[I_CONVW] + (size_t)(l * 4 + k) * DLRU + Cc; const f32x4 c0 = *(const f32x4*)cw, c1 = *(const f32x4*)(cw + 4);
#pragma unroll
                for (int e = 0; e < 4; ++e) { acc[e] += z[e] * c0[e]; acc[4 + e] += z[4 + e] * c1[e]; } } }
        *(LAS f32x4*)(xaf + t * 68 + i8) = (f32x4){acc[0], acc[1], acc[2], acc[3]}; *(LAS f32x4*)(xaf + t * 68 + i8 + 4) = (f32x4){acc[4], acc[5], acc[6], acc[7]};
        *(LAS u32x4*)(xab + t * 72 + i8) = pack8(acc);
    }
    __syncthreads();
    {
        const int d = wid >> 2, g = wid & 3, fr = lane & 15, fq = lane >> 4;
        const bf16_t* wb = (const bf16_t*)(ws + WS_WG) + ((size_t)((l * 8 + head) * 256 + d * 128 + 16 * g + fr)) * 64 + 8 * fq;
        bf16x8 wR[2], wG[2];
#pragma unroll
        for (int ks = 0; ks < 2; ++ks) { wR[ks] = *(const bf16x8*)(wb + 32 * ks); wG[ks] = *(const bf16x8*)(wb + 64 * 64 + 32 * ks); }
        const int cb = head * 64 + 16 * g + 4 * fq;
        const f32x4 ba = *(const f32x4*)(A->in[I_BA] + (l * 2 + d) * DLRU + cb), bxv = *(const f32x4*)(A->in[I_BX] + (l * 2 + d) * DLRU + cb), lam = *(const f32x4*)(A->in[I_LAM] + (l * 2 + d) * DLRU + cb);
        f32x4 sp8;
#pragma unroll
        for (int e = 0; e < 4; ++e) sp8[e] = 8.0f * log1pf(__expf(-lam[e]));
        const int p = (d == 0) ? sc : (isctx ? 3 - c : 4 + 31 - c);
        float* SA = (float*)(ws + WS_SUMA) + ((size_t)(bl * 2 + d) * NSC) * DLRU + cb; float* SH = (float*)(ws + WS_SUMH) + ((size_t)(bl * 2 + d) * NSC) * DLRU + cb;
        f32x4 hin = (f32x4){0.f, 0.f, 0.f, 0.f}, Atot = (f32x4){1.f, 1.f, 1.f, 1.f}, Htot = (f32x4){0.f, 0.f, 0.f, 0.f};
        if (pass2) for (int pp = 0; pp < p; ++pp) { const f32x4 a4 = *(const f32x4*)(SA + (size_t)pp * DLRU), h4 = *(const f32x4*)(SH + (size_t)pp * DLRU); hin = a4 * hin + h4; }
        const int lastl = (lane & 48) | (d ? 0 : 15);
#pragma unroll
        for (int q = 0; q < 4; ++q) { const int tt = d ? 3 - q : q;
            f32x4 aR = (f32x4){0.f, 0.f, 0.f, 0.f}, aG = (f32x4){0.f, 0.f, 0.f, 0.f};
#pragma unroll
            for (int ks = 0; ks < 2; ++ks) { const bf16x8 bfrag = *(const LAS bf16x8*)(xab + (16 * tt + fr) * 72 + 8 * fq + 32 * ks);
                aR = __builtin_amdgcn_mfma_f32_16x16x32_bf16(wR[ks], bfrag, aR, 0, 0, 0); aG = __builtin_amdgcn_mfma_f32_16x16x32_bf16(wG[ks], bfrag, aG, 0, 0, 0); }
            const f32x4 xv = *(const LAS f32x4*)(xaf + (16 * tt + fr) * 68 + 16 * g + 4 * fq);
            f32x4 hv;
#pragma unroll
            for (int e = 0; e < 4; ++e) {
                const float r = sigm(aR[e] + ba[e]), gi = sigm(aG[e] + bxv[e]);
                const float la = -r * sp8[e], a = __expf(la), x2 = -2.0f * la;
                const float om = x2 < 0.1f ? x2 * (1.0f - x2 * (0.5f - x2 * (0.16666667f - x2 * 0.041666668f))) : 1.0f - a * a;
                float Av = a, Bv = sqrtf(om) * gi * xv[e];
#pragma unroll
                for (int off = 1; off < 16; off <<= 1) { const int src = d ? lane + off : lane - off; const float Ap = __shfl(Av, src), Bp = __shfl(Bv, src);
                    const bool valid = d ? (fr + off < 16) : (fr >= off); if (valid) { Bv = Av * Bp + Bv; Av = Av * Ap; } }
                if (pass2) { const float h = Av * hin[e] + Bv; hv[e] = h; hin[e] = __shfl(h, lastl); }
                else { const float AT = __shfl(Av, lastl), BT = __shfl(Bv, lastl); Htot[e] = AT * Htot[e] + BT; Atot[e] = Atot[e] * AT; }
            }
            if (pass2) *(LAS f32x4*)(hbuf + ((d * 64 + 16 * tt + fr) * 68 + 16 * g + 4 * fq)) = hv;
        }
        if (!pass2 && fr == 0) { *(f32x4*)(SA + (size_t)p * DLRU) = Atot; *(f32x4*)(SH + (size_t)p * DLRU) = Htot; }
    }
    if (pass2) {
        __syncthreads();
        const int t = tid >> 3, i8 = (tid & 7) * 8, tok = t0 + t, Cc = head * 64 + i8;
        float zg[8]; unpack8(*(const u32x4*)(Z + (size_t)(rowbase + tok) * ZN + Z_LG + Cc), zg);
        const f32x4 h00 = *(const LAS f32x4*)(hbuf + t * 68 + i8), h01 = *(const LAS f32x4*)(hbuf + t * 68 + i8 + 4), h10 = *(const LAS f32x4*)(hbuf + (64 + t) * 68 + i8), h11 = *(const LAS f32x4*)(hbuf + (64 + t) * 68 + i8 + 4);
        float y[8];
#pragma unroll
        for (int e = 0; e < 8; ++e) { const float hs = e < 4 ? h00[e & 3] + h10[e & 3] : h01[e & 3] + h11[e & 3]; const float x = zg[e];
            const float u2 = 1.5957691216057308f * (x + 0.044715f * x * x * x);
            y[e] = hs * x * sigm(u2); }
        *(u32x4*)((bf16_t*)(ws + WS_Y) + (size_t)(rowbase + tok) * YN + Cc) = pack8(y);
    }
}

__device__ __forceinline__ void sweep_chunk(int d, int j, int bl, int& rowbase, int& t0, int& Lseq, bool& isctx) {
    isctx = j < 4; const int c = isctx ? (d ? 3 - j : j) : (d ? 35 - j : j - 4);
    Lseq = isctx ? CTXL : SEQ; rowbase = isctx ? RL + bl * CTXL : bl * SEQ; t0 = c * 64;
}
__device__ __forceinline__ void lru_sweep(ArgP A, int l, int item, LAS unsigned char* lds, const int tid) {
    unsigned char* ws = A->ws;
    const int lane = tid & 63, wid = tid >> 6, d = wid >> 2, g = wid & 3, fr = lane & 15, fq = lane >> 4, hl = tid & 255;
    const int head = item & 7, bl = item >> 3;
    const bf16_t* Z = (const bf16_t*)(ws + WS_Z);
    LAS float* cwl = (LAS float*)(lds + 106496);
    __syncthreads();
    if (tid < 256) cwl[tid] = A->in[I_CONVW][(size_t)(l * 4 + (tid >> 6)) * DLRU + head * 64 + (tid & 63)];
    else if (tid < 320) cwl[tid] = A->in[I_CONVB][l * DLRU + head * 64 + (tid - 256)];
    const bf16_t* wb = (const bf16_t*)(ws + WS_WG) + ((size_t)((l * 8 + head) * 256 + d * 128 + 16 * g + fr)) * 64 + 8 * fq;
    bf16x8 wR[2], wG[2];
#pragma unroll
    for (int ks = 0; ks < 2; ++ks) { wR[ks] = *(const bf16x8*)(wb + 32 * ks); wG[ks] = *(const bf16x8*)(wb + 64 * 64 + 32 * ks); }
    const int cb = head * 64 + 16 * g + 4 * fq;
    const f32x4 ba = *(const f32x4*)(A->in[I_BA] + (l * 2 + d) * DLRU + cb), bxv = *(const f32x4*)(A->in[I_BX] + (l * 2 + d) * DLRU + cb), lam = *(const f32x4*)(A->in[I_LAM] + (l * 2 + d) * DLRU + cb);
    const float LOG2E = 1.4426950408889634f;
    f32x4 spl2; const f32x4 nba = ba * (-LOG2E), nbx = bxv * (-LOG2E);
#pragma unroll
    for (int e = 0; e < 4; ++e) { const float sp8 = 8.0f * log1pf(__expf(-lam[e])); spl2[e] = sp8 * LOG2E; }
    float* HX = (float*)(ws + (d ? WS_HB : WS_HF));
    const int lastl = lane | 15;
    const int ct = hl >> 2, ci = (hl & 3) * 16;
    f32x4 hin = (f32x4){0.f, 0.f, 0.f, 0.f};
#define SWEEP_LOAD(zr, jj) do { int rb_, t0_, Ls_; bool ic_; sweep_chunk(d, (jj) < NSC ? (jj) : NSC - 1, bl, rb_, t0_, Ls_, ic_); \
        _Pragma("unroll") for (int k = 0; k < 4; ++k) { const int tt_ = t0_ + ct + k - 2; const bool ok_ = (tt_ >= 0 && tt_ < Ls_); const int tc_ = ok_ ? tt_ : t0_ + ct; \
            const bf16_t* zp_ = Z + (size_t)(rb_ + tc_) * ZN + head * 64 + ci; const u32x4 l0_ = *(const u32x4*)zp_, l1_ = *(const u32x4*)(zp_ + 8); const unsigned mk_ = ok_ ? 0xffffffffu : 0u; \
            zr[k][0] = l0_ & mk_; zr[k][1] = l1_ & mk_; } } while (0)
#define SWEEP_CONV(zr, bufi) do { LAS float* xaf_ = (LAS float*)(lds + d * 53248 + (bufi) * 26624); LAS bf16_t* xab_ = (LAS bf16_t*)(lds + d * 53248 + (bufi) * 26624 + 17408); \
        _Pragma("unroll") for (int hf_ = 0; hf_ < 2; ++hf_) { float acc[8]; \
            { const f32x4 b0_ = *(const LAS f32x4*)(cwl + 256 + ci + 8 * hf_), b1_ = *(const LAS f32x4*)(cwl + 256 + ci + 8 * hf_ + 4); _Pragma("unroll") for (int e = 0; e < 4; ++e) { acc[e] = b0_[e]; acc[4 + e] = b1_[e]; } } \
            _Pragma("unroll") for (int k = 0; k < 4; ++k) { float z[8]; unpack8(zr[k][hf_], z); \
                const f32x4 w0_ = *(const LAS f32x4*)(cwl + k * 64 + ci + 8 * hf_), w1_ = *(const LAS f32x4*)(cwl + k * 64 + ci + 8 * hf_ + 4); \
                _Pragma("unroll") for (int e = 0; e < 4; ++e) { acc[e] += z[e] * w0_[e]; acc[4 + e] += z[4 + e] * w1_[e]; } } \
            *(LAS f32x4*)(xaf_ + ct * 68 + ci + 8 * hf_) = (f32x4){acc[0], acc[1], acc[2], acc[3]}; *(LAS f32x4*)(xaf_ + ct * 68 + ci + 8 * hf_ + 4) = (f32x4){acc[4], acc[5], acc[6], acc[7]}; \
            *(LAS u32x4*)(xab_ + ct * 72 + ci + 8 * hf_) = pack8(acc); } } while (0)
#define SCAN_LVL(N) "v_fmac_f32_dpp %0, %0, %4 row_shr:" #N " row_mask:0xf bank_mask:0xf\n\tv_fmac_f32_dpp %1, %1, %5 row_shr:" #N " row_mask:0xf bank_mask:0xf\n\t" \
                    "v_fmac_f32_dpp %2, %2, %6 row_shr:" #N " row_mask:0xf bank_mask:0xf\n\tv_fmac_f32_dpp %3, %3, %7 row_shr:" #N " row_mask:0xf bank_mask:0xf\n\t" \
                    "v_mul_f32_dpp %4, %4, %4 row_shr:" #N " row_mask:0xf bank_mask:0xf\n\tv_mul_f32_dpp %5, %5, %5 row_shr:" #N " row_mask:0xf bank_mask:0xf\n\t" \
                    "v_mul_f32_dpp %6, %6, %6 row_shr:" #N " row_mask:0xf bank_mask:0xf\n\tv_mul_f32_dpp %7, %7, %7 row_shr:" #N " row_mask:0xf bank_mask:0xf\n\t"
#define SWEEP_SCAN \
        _Pragma("unroll") \
        for (int q = 0; q < 4; ++q) { const int tt = d ? 3 - q : q, trow = 16 * tt + (d ? 15 - fr : fr); \
            f32x4 aR = (f32x4){0.f, 0.f, 0.f, 0.f}, aG = (f32x4){0.f, 0.f, 0.f, 0.f}; \
        _Pragma("unroll") \
            for (int ks = 0; ks < 2; ++ks) { const bf16x8 bfrag = *(const LAS bf16x8*)(xab + trow * 72 + 8 * fq + 32 * ks); \
                aR = __builtin_amdgcn_mfma_f32_16x16x32_bf16(wR[ks], bfrag, aR, 0, 0, 0); aG = __builtin_amdgcn_mfma_f32_16x16x32_bf16(wG[ks], bfrag, aG, 0, 0, 0); } \
            const f32x4 xv = *(const LAS f32x4*)(xaf + trow * 68 + 16 * g + 4 * fq); \
            f32x4 Av, Bv; \
            { \
                const f32x4 tR = aR * (-LOG2E) + nba, tG = aG * (-LOG2E) + nbx; \
                f32x4 eR, eG; \
        _Pragma("unroll") \
                for (int e = 0; e < 4; ++e) { eR[e] = __builtin_amdgcn_exp2f(tR[e]); eG[e] = __builtin_amdgcn_exp2f(tG[e]); } \
                eR = eR + 1.0f; eG = eG + 1.0f; \
                f32x4 r, gi; \
        _Pragma("unroll") \
                for (int e = 0; e < 4; ++e) { r[e] = __builtin_amdgcn_rcpf(eR[e]); gi[e] = __builtin_amdgcn_rcpf(eG[e]); } \
                const f32x4 ta = r * spl2, x2 = ta * 1.3862943611198906f; \
        _Pragma("unroll") \
                for (int e = 0; e < 4; ++e) Av[e] = __builtin_amdgcn_exp2f(-ta[e]); \
                const f32x4 pser = x2 * (x2 * (x2 * 0.16666667f - 0.5f) + 1.0f), om1 = 1.0f - Av * Av; \
                f32x4 sq; \
        _Pragma("unroll") \
                for (int e = 0; e < 4; ++e) sq[e] = __builtin_amdgcn_sqrtf(x2[e] < 0.02f ? pser[e] : om1[e]); \
                Bv = sq * gi * xv; \
            } \
            { \
                float B0 = Bv[0], B1 = Bv[1], B2 = Bv[2], B3 = Bv[3], A0 = Av[0], A1 = Av[1], A2 = Av[2], A3 = Av[3]; \
                asm volatile("s_nop 1\n\t" SCAN_LVL(1) SCAN_LVL(2) SCAN_LVL(4) SCAN_LVL(8) "s_nop 1" \
                    : "+v"(B0), "+v"(B1), "+v"(B2), "+v"(B3), "+v"(A0), "+v"(A1), "+v"(A2), "+v"(A3)); \
                Av = (f32x4){A0, A1, A2, A3}; Bv = (f32x4){B0, B1, B2, B3}; \
            } \
            const f32x4 hq = Av * hin + Bv; *(f32x4*)(HX + (size_t)(rowbase + t0 + trow) * DLRU + cb) = hq; \
        _Pragma("unroll") \
            for (int e = 0; e < 4; ++e) hin[e] = __shfl(hq[e], lastl); \
        }
    __syncthreads();
    u32x4 za[4][2], zb[4][2];
    { SWEEP_LOAD(zb, 0); SWEEP_LOAD(za, 1); SWEEP_CONV(zb, 0); }
    __syncthreads();
#define SWEEP_STEP(jj, ZL, ZC) do { const int j = (jj); \
        int rowbase, t0, Lseq; bool isctx; sweep_chunk(d, j, bl, rowbase, t0, Lseq, isctx); \
        SWEEP_LOAD(ZL, j + 2); \
        const LAS float* xaf = (const LAS float*)(lds + d * 53248 + (j & 1) * 26624); \
        const LAS bf16_t* xab = (const LAS bf16_t*)(lds + d * 53248 + (j & 1) * 26624 + 17408); \
        SWEEP_SCAN \
        if (j + 1 < NSC) SWEEP_CONV(ZC, (j + 1) & 1); \
        __syncthreads(); } while (0)
    for (int j2 = 0; j2 < NSC; j2 += 2) { SWEEP_STEP(j2, zb, za); SWEEP_STEP(j2 + 1, za, zb); }
#undef SWEEP_STEP
#undef SWEEP_SCAN
#undef SCAN_LVL
#undef SWEEP_LOAD
#undef SWEEP_CONV
    asm volatile("s_waitcnt vmcnt(0)" ::: "memory");
    __syncthreads();
    {
        const float* HF = (const float*)(ws + WS_HF); const float* HB = (const float*)(ws + WS_HB);
        const int t = tid >> 3, i8 = (tid & 7) * 8, Cc = head * 64 + i8;
        for (int sc0 = (l == 0 ? 0 : 4); sc0 < NSC; sc0 += 4) {
            u32x4 zgw[4]; f32x4 f0[4], f1[4], b0[4], b1[4]; int rows[4];
#pragma unroll
            for (int u = 0; u < 4; ++u) { const int sc = sc0 + u; const int row = (sc < 4 ? RL + bl * CTXL + sc * 64 : bl * SEQ + (sc - 4) * 64) + t; rows[u] = row;
                zgw[u] = *(const u32x4*)(Z + (size_t)row * ZN + Z_LG + Cc);
                f0[u] = *(const f32x4*)(HF + (size_t)row * DLRU + Cc); f1[u] = *(const f32x4*)(HF + (size_t)row * DLRU + Cc + 4);
                b0[u] = *(const f32x4*)(HB + (size_t)row * DLRU + Cc); b1[u] = *(const f32x4*)(HB + (size_t)row * DLRU + Cc + 4); }
#pragma unroll
            for (int u = 0; u < 4; ++u) { float zg[8]; unpack8(zgw[u], zg); float y[8];
#pragma unroll
                for (int e = 0; e < 8; ++e) { const float hs = e < 4 ? f0[u][e & 3] + b0[u][e & 3] : f1[u][e & 3] + b1[u][e & 3]; const float x = zg[e];
                    const float u2 = 1.5957691216057308f * (x + 0.044715f * x * x * x);
                    y[e] = hs * x * sigm(u2); }
                *(u32x4*)((bf16_t*)(ws + WS_Y) + (size_t)rows[u] * YN + Cc) = pack8(y); }
        }
    }
}

__device__ __forceinline__ void seg_decode(int it, int& rowbase, int& s0, int& lob, int& hib, int& Lseq) {
    if (it < 512) { const int bl = it >> 5, sg = it & 31; rowbase = bl * SEQ; s0 = sg * 64; lob = s0; hib = s0 + 64; Lseq = SEQ; }
    else { const int j = it - 512, bl = j >> 2, q = j & 3; rowbase = RL + bl * CTXL; s0 = q * 64; lob = 0; hib = CTXL; Lseq = CTXL; }
}
__device__ __forceinline__ void pool_item(ArgP A, int it, LAS unsigned char* lds, const int tid) {
    unsigned char* ws = A->ws;
    int rowbase, s0, lob, hib, Lseq; seg_decode(it, rowbase, s0, lob, hib, Lseq);
    const bf16_t* Z = (const bf16_t*)(ws + WS_Z) + Z_POOL;
    const int c8 = (tid & 31) * 8, tq = tid >> 5, w2 = 1 << (c8 >> 6);
    bf16_t* Y = (bf16_t*)(ws + WS_Y) + Y_POOL + c8;
#pragma unroll
    for (int u = 0; u < 4; ++u) { const int tok = s0 + tq * 4 + u; const int lo = max(tok - w2, lob), hi = min(tok + w2, hib);
        float sum[8];
#pragma unroll
        for (int e = 0; e < 8; ++e) sum[e] = 0.f;
        for (int j = lo; j < hi; ++j) { float z[8]; unpack8(*(const u32x4*)(Z + (size_t)(rowbase + j) * ZN + c8), z);
#pragma unroll
            for (int e = 0; e < 8; ++e) sum[e] += z[e]; }
        float zc[8]; unpack8(*(const u32x4*)(Z + (size_t)(rowbase + tok) * ZN + c8), zc);
        const float inv = 1.0f / (float)(hi - lo);
#pragma unroll
        for (int e = 0; e < 8; ++e) sum[e] = sum[e] * inv - zc[e];
        *(u32x4*)(Y + (size_t)(rowbase + tok) * YN) = pack8(sum); }
}
__device__ __forceinline__ void sconv_item(ArgP A, int l, int it, const int tid) {
    unsigned char* ws = A->ws;
    int rowbase, s0, lob, hib, Lseq; seg_decode(it, rowbase, s0, lob, hib, Lseq);
    const bf16_t* Z = (const bf16_t*)(ws + WS_Z);
    const int c8 = (tid & 31) * 8, tr = tid >> 5;
    const float* sw = A->in[I_SCW] + (size_t)l * 3 * 256 + c8;
    f32x4 w0[3], w1[3];
#pragma unroll
    for (int k = 0; k < 3; ++k) { w0[k] = *(const f32x4*)(sw + k * 256); w1[k] = *(const f32x4*)(sw + k * 256 + 4); }
#pragma unroll
    for (int pp = 0; pp < 2; ++pp) {
        u32x4 gcw[2][3], hsw[2][3], gbw[2];
#pragma unroll
        for (int q = 0; q < 2; ++q) { const int tok = s0 + (pp * 2 + q) * 16 + tr;
            gbw[q] = *(const u32x4*)(Z + (size_t)(rowbase + tok) * ZN + Z_SC + c8);
#pragma unroll
            for (int k = 0; k < 3; ++k) { const int tt = tok + k - 1; const bool ok = (tt >= 0 && tt < Lseq); const bf16_t* zr = Z + (size_t)(rowbase + (ok ? tt : tok)) * ZN + Z_SC + c8;
                const u32x4 a = *(const u32x4*)(zr + 256), b = *(const u32x4*)(zr + 512); const unsigned mk = ok ? 0xffffffffu : 0u; gcw[q][k] = a & mk; hsw[q][k] = b; } }
#pragma unroll
        for (int q = 0; q < 2; ++q) { const int tok = s0 + (pp * 2 + q) * 16 + tr; float acc[8];
#pragma unroll
            for (int e = 0; e < 8; ++e) acc[e] = 0.f;
#pragma unroll
            for (int k = 0; k < 3; ++k) { float gc[8], hs[8]; unpack8(gcw[q][k], gc); unpack8(hsw[q][k], hs);
#pragma unroll
                for (int e = 0; e < 4; ++e) { acc[e] += gc[e] * hs[e] * w0[k][e]; acc[4 + e] += gc[4 + e] * hs[4 + e] * w1[k][e]; } }
            float gb[8]; unpack8(gbw[q], gb);
#pragma unroll
            for (int e = 0; e < 8; ++e) acc[e] *= gb[e];
            *(u32x4*)((bf16_t*)(ws + WS_Y) + (size_t)(rowbase + tok) * YN + Y_SC + c8) = pack8(acc); }
    }
}

__device__ __forceinline__ int fetch_item(unsigned* ctr, LAS unsigned char* lds, const int tid) {
    LAS unsigned* slot = (LAS unsigned*)(lds + QSLOT_OFF);
    __syncthreads();
    if (tid == 0) *slot = atomicAdd(ctr, 1u);
    __syncthreads();
    return (int)*slot;
}


#define XB_TMO      128
#define XB_XCNT(j)  (256  + 64 * (j))
#define XB_XSUB(j)  (1280 + 64 * (j))
#define XB_XGEN(j)  (2304 + 64 * (j))
#define XB_TOP      3328
#define XB_TOPGEN   3392
#define XCD_BAR_WORDS 3456
#define XB_SPIN_CAP (1u << 22)
__device__ __forceinline__ unsigned xb_ld(unsigned* p)              { return __hip_atomic_load(p, __ATOMIC_RELAXED, __HIP_MEMORY_SCOPE_AGENT); }
__device__ __forceinline__ unsigned xb_add(unsigned* p, unsigned v) { return __hip_atomic_fetch_add(p, v, __ATOMIC_RELAXED, __HIP_MEMORY_SCOPE_AGENT); }
__device__ __forceinline__ unsigned xb_xcc_id() { return (unsigned)__builtin_amdgcn_s_getreg((3 << 11) | 20) & 0xFu; }
#define XB_SPIN(cond, bar) do { unsigned _sp = 0; while (cond) { __builtin_amdgcn_s_sleep(1); \
    if ((++_sp & 255u) == 0u) { if (xb_ld(&(bar)[XB_TMO])) break; if (_sp > XB_SPIN_CAP) { atomicAdd(&(bar)[XB_TMO], 1u); break; } } } } while (0)
struct XcdBarrier { unsigned* bar; unsigned x; volatile LAS unsigned* st; };
__device__ __forceinline__ XcdBarrier xcd_barrier_post(unsigned* bar, volatile LAS unsigned* st) {
    XcdBarrier b; b.bar = bar; b.x = xb_xcc_id(); b.st = st;
    if (threadIdx.x == 0) (void)xb_add(&bar[XB_XCNT(b.x)], 1u);
    return b;
}
__device__ __forceinline__ void xcd_barrier_complete(unsigned* bar, unsigned x, unsigned& nloc, unsigned& nx) {
    const unsigned G = gridDim.x * gridDim.y * gridDim.z;
    unsigned sum, cnt, mine, sp = 0u;
    for (;;) {
        sum = 0u; cnt = 0u; mine = 0u;
#pragma unroll
        for (unsigned j = 0; j < 16; ++j) { const unsigned c = xb_ld(&bar[XB_XCNT(j)]); sum += c; cnt += (c > 0u) ? 1u : 0u; mine = (j == x) ? c : mine; }
        if (sum == G) break;
        __builtin_amdgcn_s_sleep(1);
        if ((++sp & 255u) == 0u) { if (xb_ld(&bar[XB_TMO])) break; if (sp > XB_SPIN_CAP) { atomicAdd(&bar[XB_TMO], 1u); break; } }
    }
    nloc = mine > 0u ? mine : 1u; nx = cnt > 0u ? cnt : 1u;
}
__device__ __forceinline__ void xcd_barrier(const XcdBarrier& b) {
    asm volatile("s_waitcnt vmcnt(0)" ::: "memory");
    __syncthreads();
    if (threadIdx.x == 0) {
        unsigned* bar = b.bar;
        __builtin_amdgcn_s_waitcnt(0);
        unsigned nloc = b.st[0], nx = b.st[1];
        if (nloc == 0u) { xcd_barrier_complete(bar, b.x, nloc, nx); b.st[0] = nloc; b.st[1] = nx; }
        const unsigned old = xb_add(&bar[XB_XSUB(b.x)], 1u);
        const unsigned gen = old / nloc;
        if (old + 1u == (gen + 1u) * nloc) {
            __builtin_amdgcn_fence(__ATOMIC_RELEASE, "agent");
            asm volatile("s_waitcnt vmcnt(0)" ::: "memory");
            const unsigned og = xb_add(&bar[XB_TOP], 1u);
            const unsigned tg = og / nx;
            if (og + 1u == (tg + 1u) * nx) xb_add(&bar[XB_TOPGEN], 1u);
            else XB_SPIN(xb_ld(&bar[XB_TOPGEN]) == tg, bar);
            __builtin_amdgcn_fence(__ATOMIC_ACQUIRE, "agent");
            xb_add(&bar[XB_XGEN(b.x)], 1u);
            asm volatile("s_waitcnt vmcnt(0)" ::: "memory");
        } else {
            XB_SPIN(xb_ld(&bar[XB_XGEN(b.x)]) == gen, bar);
            __builtin_amdgcn_fence(__ATOMIC_ACQUIRE, "agent");
            asm volatile("s_waitcnt vmcnt(0)" ::: "memory");
        }
    }
    __syncthreads();
}

template <bool COOP>
__global__ void __launch_bounds__(512, 2) fwd_kernel(Args Aparam) {
    extern __shared__ __attribute__((aligned(16))) unsigned char lds_raw[];
    LAS unsigned char* lds = (LAS unsigned char*)lds_raw;
    const int G = gridDim.x;
    ArgP A = (ArgP)__builtin_amdgcn_kernarg_segment_ptr();
    const int ph_lo = A->ph_lo, ph_hi = A->ph_hi;
    XcdBarrier xbar; xbar.bar = nullptr; xbar.x = 0; xbar.st = (volatile LAS unsigned*)(lds + QSLOT_OFF + 16);
    if constexpr (COOP) {
        if (threadIdx.x < 2) xbar.st[threadIdx.x] = 0u;
        __syncthreads();
        xbar = xcd_barrier_post((unsigned*)(A->ws + WS_CTL) + 8192, xbar.st);
    }
    for (int ph = ph_lo; ph < ph_hi; ++ph) {
        asm volatile("" : "+s"(A));
        int tid = threadIdx.x; asm volatile("" : "+v"(tid));
        unsigned* ctl = (unsigned*)(A->ws + WS_CTL);
        if (ph < PH_BASE) p0_prologue(A, lds, G, tid);
        else if (ph == NPHASE - 1) final_norm(A, G, tid);
        else if (ph == PH_BASE) norm_phase(A, 0, 0, false, (int)blockIdx.x * 8, RT, G * 8, tid);
        else {
            const int q = ph - PH_BASE - 1, kj = q % PH_PER, lc = q / PH_PER, l = lc >> 1, ch = lc & 1;
            const int PKJ = PROBE_K < 3 ? PROBE_K - 1 : PROBE_K - 2;
            const int kq = (PROBE_K >= 1 && PROBE_K <= 8 && kj > PKJ) ? kj - 1 : kj;
            const int k = kq < 2 ? kq + 1 : kq + 2;
            const int sub = (PROBE_K >= 1 && PROBE_K <= 8 && kj == PKJ + 1) ? PROBE_SUB : 7;
            if (k == 6) norm_phase(A, l, ch, true, (int)blockIdx.x * 8, RT, G * 8, tid);
            else {
                Sched S; S.kind = k; S.l = l; S.ch = ch; S.G = G; S.c = (int)blockIdx.x; S.ap = A;
                pg8::Gemm g; g.lda = (k == 2 || k == 8) ? 4096 : (k == 4 ? YN : DM); g.ldb = g.lda;
                if (k == 2 && !(sub & 1)) {} else if (k == 1 || k == 2 || k == 7) { pg8::EpiBf E; E.act = (k == 7) ? 1 : 0; pg8::gemm_phase<pg8::EpiBf, Sched>(lds, g, S, E, tid); }
                else if (k == 4) { pg8::EpiMerge E; pg8::gemm_phase<pg8::EpiMerge, Sched>(lds, g, S, E, tid); }
                else { pg8::EpiRes E; pg8::gemm_phase<pg8::EpiRes, Sched>(lds, g, S, E, tid); }
                if (k == 8 && lc + 1 < DEPTH * NCH) {
                    const int l2 = (lc + 1) >> 1, ch2 = (lc + 1) & 1;
                    for (;;) { const int it = fetch_item(ctl + 64 * ph, lds, tid); if (it >= RT / 64) break; norm_phase(A, l2, ch2, false, it * 64, it * 64 + 64, 8, tid); }
                }
                if (k == 2) {
                    if (sub & 2) for (int it = (int)blockIdx.x - (G >> 1); it >= 0 && it < NB * 8; it += G - (G >> 1)) lru_sweep(A, l, it, lds, tid);
                    const int nseg = (l == 0) ? 576 : 512, total = (sub & 4) ? 2 * nseg : 0;
                    for (;;) { const int it = fetch_item(ctl + 64 * ph, lds, tid); if (it >= total) break;
                        if (it < nseg) pool_item(A, it, lds, tid);
                        else sconv_item(A, l, it - nseg, tid); }
                }
            }
        }
        if (ph + 1 < ph_hi) { if constexpr (COOP) { if (ph == 0) cg::this_grid().sync(); else xcd_barrier(xbar); } }
    }
}

extern "C" void kernel_launch(void* const* d_in, const int* in_sizes, int n_in, void* d_out, int out_size, void* d_ws, size_t ws_size, hipStream_t stream) {
    static int grid = 0;
    if (grid == 0) {
        if (n_in != 27 || out_size != NBATCH * SEQ * DM || ws_size < WS_END) { fprintf(stderr, "kernel_launch: unexpected shapes (n_in %d out %d ws %zu)\n", n_in, out_size, ws_size); grid = -1; return; }
        int dev = 0, cus = 0, per_cu = 0;
        hipGetDevice(&dev); hipDeviceGetAttribute(&cus, hipDeviceAttributeMultiprocessorCount, dev);
        hipFuncSetAttribute((const void*)fwd_kernel<true>, hipFuncAttributeMaxDynamicSharedMemorySize, LDS_BYTES);
        hipFuncSetAttribute((const void*)fwd_kernel<false>, hipFuncAttributeMaxDynamicSharedMemorySize, LDS_BYTES);
        hipOccupancyMaxActiveBlocksPerMultiprocessor(&per_cu, (const void*)fwd_kernel<true>, 512, LDS_BYTES);
        (void)hipGetLastError();
        if (per_cu < 1) per_cu = 1;
        grid = cus * 1;
        if (grid <= 0) grid = 256;
    }
    if (grid < 0) return;
    hipMemsetAsync((char*)d_ws + WS_CTL, 0, CTL_ZERO_BYTES, stream);
    Args a{};
    for (int i = 0; i < 27; ++i) a.in[i] = (const float*)d_in[i];
    a.out = (float*)d_out; a.ws = (unsigned char*)d_ws;
#if MK_COOP
    a.ph_lo = 0; a.ph_hi = NPHASE;
    void* args[] = {&a};
    hipError_t e = hipLaunchCooperativeKernel((const void*)fwd_kernel<true>, dim3(grid), dim3(512), args, LDS_BYTES, stream);
    if (e != hipSuccess) fprintf(stderr, "cooperative launch failed: %s (grid %d)\n", hipGetErrorString(e), grid);
#else
    for (int ph = 0; ph < NPHASE; ++ph) { a.ph_lo = ph; a.ph_hi = ph + 1; hipLaunchKernelGGL(fwd_kernel<false>, dim3(grid), dim3(512), LDS_BYTES, stream, a); }
#endif
}
```

```cpp
#include <hip/hip_runtime.h>
#include <hip/hip_cooperative_groups.h>
#include <cstdio>
#include <cstdint>
namespace cg = cooperative_groups;

#ifndef MK_COOP
#define MK_COOP 1
#endif
#define PROBE_SUB 7
#define PROBE_K -1

#define LAS __attribute__((address_space(3)))
typedef unsigned short bf16_t;
typedef short bf16x8 __attribute__((ext_vector_type(8)));
typedef float f32x4 __attribute__((ext_vector_type(4)));
typedef float f32x2 __attribute__((ext_vector_type(2)));
typedef unsigned u32x4 __attribute__((ext_vector_type(4)));
typedef unsigned u32x2 __attribute__((ext_vector_type(2)));

constexpr int NBATCH = 32, SEQ = 2048, CTXL = 256, DM = 1024, DEPTH = 2, DLRU = 512, NIN = 6400, DFF = 4096;
constexpr int NB = 16, NCH = 2;
constexpr int RL = NB * SEQ, RC = NB * CTXL, RT = RL + RC;
constexpr int ZN = 4096  , WN = 6144  , YN = 1280;
constexpr int Z_LG = 512, Z_POOL = 1024, Z_SC = 1280, Z_GATE = 2048;
constexpr int Y_F = 512, Y_POOL = 768, Y_SC = 1024;
constexpr int NSC = 36;
constexpr size_t MiB = 1u << 20;
constexpr size_t WS_CTL = 0, CTL_ZERO_BYTES = 65536;
constexpr size_t WS_MOD = 1 * MiB, WS_WG = 3 * MiB, WS_SUMA = 4 * MiB, WS_SUMH = 7 * MiB, WS_DFTC = 10 * MiB, WS_DFT = 12 * MiB;
constexpr size_t WS_WIN = 28 * MiB, WS_WF = 52 * MiB, WS_WBR = 54 * MiB, WS_WOUT = 60 * MiB, WS_W1 = 64 * MiB, WS_W2 = 80 * MiB;
constexpr size_t WS_CTXW = 96 * MiB, WS_U = 128 * MiB, WS_MRG = 200 * MiB, WS_PT = 272 * MiB, WS_PTC = 304 * MiB, WS_Y = 336 * MiB, WS_Z = 432 * MiB;
constexpr size_t WS_HF = WS_Z + (size_t)RT * ZN * 2, WS_HB = WS_HF + (size_t)RT * DLRU * 4;
constexpr size_t WS_END = WS_HB + (size_t)RT * DLRU * 4;
static_assert(WS_END <= 1024 * MiB, "workspace map");
static_assert(WS_Y + (size_t)RT * YN * 2 <= WS_Z && WS_PTC + (size_t)NB * 256 * 4096 * 2 <= WS_Y && WS_MRG + (size_t)RT * DM * 2 <= WS_PT, "workspace map 2");
constexpr int LDS_BYTES = 147456, RING_BYTES = 131072, QSLOT_OFF = LDS_BYTES - 64;
constexpr int PH_PER = 7 + ((PROBE_K >= 1 && PROBE_K <= 8) ? 1 : 0), PH_BASE = (PROBE_K == 9) ? 2 : 1;
constexpr int NPHASE = PH_BASE + 2 + DEPTH * NCH * PH_PER;

__device__ __forceinline__ float bf_lo(unsigned w) { return __uint_as_float(w << 16); }
__device__ __forceinline__ float bf_hi(unsigned w) { return __uint_as_float(w & 0xffff0000u); }
__device__ __forceinline__ unsigned cvt_pk_bf16(float lo, float hi) { unsigned r; asm volatile("v_cvt_pk_bf16_f32 %0, %1, %2" : "=v"(r) : "v"(lo), "v"(hi)); return r; }
__device__ __forceinline__ float sigm(float x) { return __builtin_amdgcn_rcpf(1.0f + __expf(-x)); }
__device__ __forceinline__ float wave_sum(float v) {
#pragma unroll
    for (int o = 1; o < 64; o <<= 1) v += __shfl_xor(v, o);
    return v;
}
#define LDS_WAIT() asm volatile("s_waitcnt lgkmcnt(0)" ::: "memory")
#define DPP_SHR(ident, v, N) __builtin_bit_cast(float, __builtin_amdgcn_update_dpp(__builtin_bit_cast(int, (float)(ident)), __builtin_bit_cast(int, (float)(v)), 0x110 + (N), 0xf, 0xf, false))
#define SCAN_STEP(N) do { const float Ap_ = DPP_SHR(1.0f, Av, N), Bp_ = DPP_SHR(0.0f, Bv, N); Bv = Av * Bp_ + Bv; Av = Av * Ap_; } while (0)

namespace pg8 {
constexpr int BM = 256, BK = 64, HALF = 128, HTB = HALF * BK * 2, STAGE_BYTES = 8 * HTB, NXCD = 8, WGM = 8;
__host__ __device__ __forceinline__ int lds_byte(int r, int c) { const int st = (r >> 4) * 2 + (c >> 5), rr = r & 15, cc = c & 31, ob = rr * 64 + cc * 2; return st * 1024 + (ob ^ (((ob >> 9) & 1) << 5)); }
__host__ __device__ __forceinline__ void stage_rc(int b, int& R, int& C) { const int st = b / 1024, sb = b % 1024, swz = sb ^ (((sb >> 9) & 1) << 5); R = (st >> 1) * 16 + swz / 64; C = (st & 1) * 32 + (swz % 64) / 2; }
__host__ __device__ __forceinline__ int perm32(int rho) { const int n = rho >> 4, i = rho & 15; return 8 * (i >> 2) + 4 * n + (i & 3); }

struct Unit { const char* a; const char* b; char* dst; const char* x0; const char* x1; int nt, seg; };
struct Gemm { int lda, ldb; };

__device__ __forceinline__ bool tile_of(long L, int nM, int nN, int& pm, int& pn) {
    const int nwg = nM * nN; if (L >= nwg) return false;
    int wgid = (int)L; { const int q = nwg / NXCD, r = nwg % NXCD, xcd = wgid % NXCD, off = wgid / NXCD; wgid = (xcd < r ? xcd * (q + 1) : r * (q + 1) + (xcd - r) * q) + off; }
    const int nig = WGM * nN, gid = wgid / nig, fm = gid * WGM, gsz = (nM - fm) < WGM ? (nM - fm) : WGM;
    pm = fm + ((wgid % nig) % gsz); pn = (wgid % nig) / gsz; return true;
}

struct EpiBf {
    static constexpr bool PERM = true;
    int act;
    __device__ __forceinline__ bool operator()(f32x4 (&acc)[2][2][4][2], const Unit& u, int wr, int wc, int fr, int fq) const {
        const int ldc = (u.seg & 12) ? YN : 4096;
        bf16_t* base = (bf16_t*)u.dst + (size_t)(wr * 64 + fr) * ldc + wc * 32 + 8 * fq;
        const float sc = (u.seg & 4) ? 0.001381067932004975f   : ((u.seg & 8) ? 1.f / 256.f : 1.f);
#pragma unroll
        for (int ai = 0; ai < 2; ++ai)
#pragma unroll
            for (int m = 0; m < 4; ++m) { bf16_t* rowp = base + (size_t)(ai * HALF + m * 16) * ldc;
#pragma unroll
                for (int bj = 0; bj < 2; ++bj) { f32x4 v0 = acc[ai][bj][m][0], v1 = acc[ai][bj][m][1];
                    if (u.seg == 2) {
                        unsigned p0 = 0u, p1 = 0u;
#pragma unroll
                        for (int e = 0; e < 4; ++e) {
                            const float s0 = fmaxf(255.0f * __builtin_amdgcn_rcpf(1.0f + __builtin_amdgcn_exp2f(fminf(v0[e] * -1.4426950408889634f, 40.f))), 1.0f);
                            const float s1 = fmaxf(255.0f * __builtin_amdgcn_rcpf(1.0f + __builtin_amdgcn_exp2f(fminf(v1[e] * -1.4426950408889634f, 40.f))), 1.0f);
                            p0 = __builtin_amdgcn_cvt_pk_u8_f32(s0, e, p0); p1 = __builtin_amdgcn_cvt_pk_u8_f32(s1, e, p1); }
                        u32x2 wg; wg.x = p0; wg.y = p1;
                        *(u32x2*)(u.dst + (size_t)(wr * 64 + fr + ai * HALF + m * 16) * (ZN * 2) + wc * 32 + 8 * fq + bj * HALF) = wg;
                        continue; }
                    if (act == 1) {
#pragma unroll
                        for (int e = 0; e < 4; ++e) { const float a = fmaxf(v0[e], 0.f), b = fmaxf(v1[e], 0.f); v0[e] = a * a; v1[e] = b * b; } }
                    v0 = v0 * sc; v1 = v1 * sc;
                    u32x4 w; w.x = cvt_pk_bf16(v0[0], v0[1]); w.y = cvt_pk_bf16(v0[2], v0[3]); w.z = cvt_pk_bf16(v1[0], v1[1]); w.w = cvt_pk_bf16(v1[2], v1[3]);
                    *(u32x4*)(rowp + bj * HALF) = w; } }
        return true;
    }
};
struct EpiRes {
    static constexpr bool PERM = false;
    __device__ __forceinline__ bool operator()(f32x4 (&acc)[2][2][4][2], const Unit& u, int wr, int wc, int fr, int fq) const {
        const float* gv = (const float*)u.x1 + wc * 32 + 4 * fq;
        f32x4 g[2][2];
#pragma unroll
        for (int bj = 0; bj < 2; ++bj)
#pragma unroll
            for (int n = 0; n < 2; ++n) g[bj][n] = *(const f32x4*)(gv + bj * HALF + n * 16);
        const size_t o0 = (size_t)(wr * 64 + fr) * DM + wc * 32 + 4 * fq;
        const float* bs = (const float*)u.x0 + o0; float* od = (float*)u.dst + o0;
        f32x4 bc[2][2];
#pragma unroll
        for (int bj = 0; bj < 2; ++bj)
#pragma unroll
            for (int n = 0; n < 2; ++n) bc[bj][n] = *(const f32x4*)(bs + bj * HALF + n * 16);
#pragma unroll
        for (int am = 0; am < 8; ++am) { const int ai = am >> 2, m = am & 3; const size_t off = (size_t)(ai * HALF + m * 16) * DM;
            f32x4 bn[2][2];
            if (am < 7) { const size_t offn = (size_t)(((am + 1) >> 2) * HALF + ((am + 1) & 3) * 16) * DM;
#pragma unroll
                for (int bj = 0; bj < 2; ++bj)
#pragma unroll
                    for (int n = 0; n < 2; ++n) bn[bj][n] = *(const f32x4*)(bs + offn + bj * HALF + n * 16); }
#pragma unroll
            for (int bj = 0; bj < 2; ++bj)
#pragma unroll
                for (int n = 0; n < 2; ++n) *(f32x4*)(od + off + bj * HALF + n * 16) = bc[bj][n] + g[bj][n] * acc[ai][bj][m][n];
            if (am < 7) {
#pragma unroll
                for (int bj = 0; bj < 2; ++bj)
#pragma unroll
                    for (int n = 0; n < 2; ++n) bc[bj][n] = bn[bj][n]; }
        }
        return true;
    }
};
struct EpiMerge {
    static constexpr bool PERM = true;
    __device__ __forceinline__ void apply(const bool LAST, f32x4 (&acc)[2][2][4][2], const Unit& u, int wr, int wc, int fr, int fq) const {
        const unsigned char* g0 = (const unsigned char*)u.x0 + (size_t)(wr * 64 + fr) * (ZN * 2) + wc * 32 + 8 * fq;
        bf16_t* base = (bf16_t*)u.dst + (size_t)(wr * 64 + fr) * DM + wc * 32 + 8 * fq;
        const int gboff = LAST ? 0 : DM;
        u32x2 ga[2][2][2], gb[2][2][2];
#pragma unroll
        for (int mm = 0; mm < 2; ++mm)
#pragma unroll
            for (int bj = 0; bj < 2; ++bj) { const unsigned char* rp = g0 + (size_t)(mm * 16) * (ZN * 2) + bj * HALF; ga[0][mm][bj] = *(const u32x2*)rp; gb[0][mm][bj] = *(const u32x2*)(rp + gboff); }
#pragma unroll
        for (int am = 0; am < 4; ++am) { const int ai = am >> 1, m0 = (am & 1) * 2, cb_ = am & 1, nb_ = cb_ ^ 1;
            if (am < 3) { const int ai2 = (am + 1) >> 1, m02 = ((am + 1) & 1) * 2;
#pragma unroll
                for (int mm = 0; mm < 2; ++mm)
#pragma unroll
                    for (int bj = 0; bj < 2; ++bj) { const unsigned char* rp = g0 + (size_t)(ai2 * HALF + (m02 + mm) * 16) * (ZN * 2) + bj * HALF; ga[nb_][mm][bj] = *(const u32x2*)rp; gb[nb_][mm][bj] = *(const u32x2*)(rp + gboff); } }
            asm volatile("" ::: "memory");
#pragma unroll
            for (int mm = 0; mm < 2; ++mm)
#pragma unroll
                for (int bj = 0; bj < 2; ++bj) { const int m = m0 + mm;
                    f32x4 v0 = acc[ai][bj][m][0], v1 = acc[ai][bj][m][1];
#pragma unroll
                    for (int h2 = 0; h2 < 2; ++h2) { const unsigned wa = ga[cb_][mm][bj][h2], wb = gb[cb_][mm][bj][h2];
#pragma unroll
                        for (int e = 0; e < 4; ++e) { const float sa = (float)((wa >> (8 * e)) & 0xffu), sb = (float)((wb >> (8 * e)) & 0xffu);
                            const float f = LAST ? sa * (1.0f / 255.0f) : sa * __builtin_amdgcn_rcpf(sb);
                            if (h2 == 0) v0[e] *= f; else v1[e] *= f; } }
                    acc[ai][bj][m][0] = v0; acc[ai][bj][m][1] = v1;
                    if (LAST) { u32x4 w; w.x = cvt_pk_bf16(v0[0], v0[1]); w.y = cvt_pk_bf16(v0[2], v0[3]); w.z = cvt_pk_bf16(v1[0], v1[1]); w.w = cvt_pk_bf16(v1[2], v1[3]);
                        *(u32x4*)(base + (size_t)(ai * HALF + m * 16) * DM + bj * HALF) = w; }
                }
        }
    }
    __device__ __forceinline__ bool operator()(f32x4 (&acc)[2][2][4][2], const Unit& u, int wr, int wc, int fr, int fq) const {
        const bool last = (u.seg == 3); apply(last, acc, u, wr, wc, fr, fq); return last;
    }
};

template <class Epi, class Sched>
__device__ __forceinline__ void gemm_phase(LAS unsigned char* lds, const Gemm g, const Sched& S, const Epi& E, const int tid) {
    const int wid = __builtin_amdgcn_readfirstlane(tid >> 6), lane = tid & 63, wr = wid >> 2, wc = wid & 3, fr = lane & 15, fq = lane >> 4;
    unsigned voffA[2], voffB[2];
#pragma unroll
    for (int i = 0; i < 2; ++i) { int R, C; stage_rc(tid * 16 + i * 8192, R, C); const int Rb = Epi::PERM ? ((R & ~31) + perm32(R & 31)) : R;
        voffA[i] = (unsigned)(R * g.lda + C) * 2u; voffB[i] = (unsigned)(Rb * g.ldb + C) * 2u; }
    const size_t kstep = (size_t)(BK * 2);
    const size_t hstepA = (size_t)HALF * g.lda * 2, hstepB = (size_t)HALF * g.ldb * 2;
    const unsigned ldsw = (unsigned)wid * 1024u;
    const int aoff = lds_byte(wr * 64 + fr, fq * 8), boff = lds_byte(wc * 32 + fr, fq * 8);
#define PG8_SA(b, h) (((b) * 2 + (h)) * HTB)
#define PG8_SB(b, h) ((4 + (b) * 2 + (h)) * HTB)
#define PG8_STAGE(bufoff, gbase, voff) do { _Pragma("unroll") for (int _i = 0; _i < 2; ++_i) \
        __builtin_amdgcn_global_load_lds((const unsigned*)((const char*)(gbase) + (voff)[_i]), (LAS unsigned*)(lds + (bufoff) + ldsw + _i * 8192), 16, 0, 0); } while (0)
#define PG8_LDA(dst, b, h) do { _Pragma("unroll") for (int m = 0; m < 4; ++m) _Pragma("unroll") for (int k = 0; k < 2; ++k) dst[m][k] = *(const LAS bf16x8*)(lds + PG8_SA(b, h) + aoff + m * 2048 + k * 1024); } while (0)
#define PG8_LDB(dst, b, h) do { _Pragma("unroll") for (int n = 0; n < 2; ++n) _Pragma("unroll") for (int k = 0; k < 2; ++k) dst[n][k] = *(const LAS bf16x8*)(lds + PG8_SB(b, h) + boff + n * 2048 + k * 1024); } while (0)
#define PG8_MMA(ai, bj, At, Bt) do { __builtin_amdgcn_s_setprio(1); _Pragma("unroll") for (int m = 0; m < 4; ++m) _Pragma("unroll") for (int n = 0; n < 2; ++n) _Pragma("unroll") for (int k = 0; k < 2; ++k) \
        acc[ai][bj][m][n] = __builtin_amdgcn_mfma_f32_16x16x32_bf16(Bt[n][k], At[m][k], acc[ai][bj][m][n], 0, 0, 0); __builtin_amdgcn_s_setprio(0); } while (0)
#define PG8_WAIT_V(n) asm volatile("s_waitcnt vmcnt(" #n ")" ::: "memory")
#define PG8_WAIT_L(n) asm volatile("s_waitcnt lgkmcnt(" #n ")" ::: "memory")
#define PG8_BAR __builtin_amdgcn_s_barrier()
#define PG8_SCHED __builtin_amdgcn_sched_barrier(0)
    Unit cur, nxt; int ui = 0;
    if (!S.next(0, cur)) return;
    f32x4 acc[2][2][4][2];
#pragma unroll
    for (int a = 0; a < 2; ++a)
#pragma unroll
        for (int b = 0; b < 2; ++b)
#pragma unroll
            for (int m = 0; m < 4; ++m)
#pragma unroll
                for (int n = 0; n < 2; ++n) acc[a][b][m][n] = (f32x4){0.f, 0.f, 0.f, 0.f};
    bf16x8 At[4][2], B0[2][2], B1[2][2];
    const char* cA = cur.a; const char* cB = cur.b;
    PG8_STAGE(PG8_SB(0, 0), cB, voffB); PG8_STAGE(PG8_SB(0, 1), cB + hstepB, voffB); PG8_STAGE(PG8_SA(0, 0), cA, voffA); PG8_STAGE(PG8_SA(0, 1), cA + hstepA, voffA);
    if (wr == 1) PG8_BAR;
    PG8_WAIT_V(2); PG8_BAR;
    PG8_STAGE(PG8_SB(1, 0), cB + kstep, voffB); PG8_STAGE(PG8_SA(1, 0), cA + kstep, voffA); PG8_STAGE(PG8_SB(1, 1), cB + hstepB + kstep, voffB);
    PG8_WAIT_V(6); PG8_BAR;
    for (;;) {
        const bool has_next = S.next(ui + 1, nxt);
        const char* nA = has_next ? nxt.a : cA; const char* nB = has_next ? nxt.b : cB;
        const int nt = cur.nt;
        for (int t = 0; t < nt; t += 2) {
            const bool last = (t == nt - 2);
            const char* a1 = cA + (size_t)(t + 1) * kstep;
            const char* a2 = last ? nA : cA + (size_t)(t + 2) * kstep; const char* b2 = last ? nB : cB + (size_t)(t + 2) * kstep;
            const char* a3 = a2 + kstep; const char* b3 = b2 + kstep;
            PG8_LDB(B0, 0, 0); PG8_LDB(B1, 0, 1); PG8_SCHED; PG8_LDA(At, 0, 0); PG8_STAGE(PG8_SA(1, 1), a1 + hstepA, voffA);
            PG8_WAIT_V(8); PG8_WAIT_L(0); PG8_BAR; PG8_MMA(0, 0, At, B0); PG8_MMA(0, 1, At, B1); PG8_BAR; PG8_SCHED;
            PG8_LDA(At, 0, 1); PG8_STAGE(PG8_SB(0, 0), b2, voffB); PG8_STAGE(PG8_SB(0, 1), b2 + hstepB, voffB); PG8_STAGE(PG8_SA(0, 0), a2, voffA);
            PG8_WAIT_V(8); PG8_WAIT_L(0); PG8_BAR; PG8_MMA(1, 0, At, B0); PG8_MMA(1, 1, At, B1); PG8_BAR; PG8_SCHED;
            PG8_LDB(B0, 1, 0); PG8_LDB(B1, 1, 1); PG8_SCHED; PG8_LDA(At, 1, 0); PG8_STAGE(PG8_SA(0, 1), a2 + hstepA, voffA);
            PG8_WAIT_V(8); PG8_WAIT_L(0); PG8_BAR; PG8_MMA(0, 0, At, B0); PG8_MMA(0, 1, At, B1); PG8_BAR; PG8_SCHED;
            PG8_LDA(At, 1, 1); PG8_STAGE(PG8_SB(1, 0), b3, voffB); PG8_STAGE(PG8_SB(1, 1), b3 + hstepB, voffB); PG8_STAGE(PG8_SA(1, 0), a3, voffA);
            PG8_WAIT_V(8); PG8_WAIT_L(0); PG8_BAR; PG8_MMA(1, 0, At, B0); PG8_MMA(1, 1, At, B1); PG8_BAR; PG8_SCHED;
        }
        if (wr == 0) PG8_BAR;
        const bool zero = E(acc, cur, wr, wc, fr, fq);
        if (!has_next) break;
        if (zero) {
#pragma unroll
            for (int a = 0; a < 2; ++a)
#pragma unroll
                for (int b = 0; b < 2; ++b)
#pragma unroll
                    for (int m = 0; m < 4; ++m)
#pragma unroll
                        for (int n = 0; n < 2; ++n) acc[a][b][m][n] = (f32x4){0.f, 0.f, 0.f, 0.f};
        }
        cur = nxt; cA = nA; cB = nB; ++ui;
        if (wr == 1) PG8_BAR;
    }
    PG8_WAIT_V(0);
    PG8_BAR;
#undef PG8_SA
#undef PG8_SB
#undef PG8_STAGE
#undef PG8_LDA
#undef PG8_LDB
#undef PG8_MMA
#undef PG8_WAIT_V
#undef PG8_WAIT_L
#undef PG8_BAR
#undef PG8_SCHED
}
}

struct Args { const float* in[27]; float* out; unsigned char* ws; int ph_lo, ph_hi; };
typedef const __attribute__((address_space(4))) Args* ArgP;
enum { I_X = 0, I_C, I_CTX, I_CCTX, I_WMOD, I_BMOD, I_G1, I_G2, I_WIN, I_CONVW, I_CONVB, I_WA, I_BA, I_WX, I_BX, I_LAM, I_POOLW, I_POOLS, I_SCW,
       I_BRL, I_BRF, I_BRP, I_BRS, I_WOUT, I_FF1, I_FF2, I_GF };

struct Sched {
    int kind, l, ch, G, c;
    ArgP ap;
    __device__ __forceinline__ bool next(int i, pg8::Unit& u) const {
        unsigned char* ws = ap->ws;
        const long L = (long)i * G + c;
        const int nM = (l == 0) ? RT / 256 : RL / 256;
        u.x0 = nullptr; u.x1 = nullptr; u.seg = 0;
        int pm, pn;
        if (kind == 1) {
            const char* U = (const char*)(ws + WS_U);
            const int nZ = nM * 24;
            long L2 = L - nZ; bool isz = false;
            if (L < nZ) { pg8::tile_of(L, nM, 24, pm, pn); isz = true; }
            else if (l == 1) { if (L2 < 32) { pm = 128 + (int)(L2 >> 1); pn = (int)(L2 & 1); isz = true; } else L2 -= 32; }
            if (isz) {
                u.a = U + (size_t)pm * 256 * DM * 2; u.b = (const char*)(ws + WS_WIN) + ((size_t)l * WN + (size_t)pn * 256) * DM * 2; u.nt = 16;
                u.dst = (char*)(ws + WS_Z) + (size_t)pm * 256 * ZN * 2 + (pn < 8 ? (size_t)pn * 512 : (size_t)4096 + (size_t)(pn - 8) * 256); u.seg = (pn >= 8) ? 2 : 0; return true;
            }
            if (L2 >= 2 * nM) return false;
            const int seg = (int)(L2 & 1), tt = (int)(L2 >> 1);
            u.a = (const char*)(ws + WS_WF) + ((size_t)l * 512 + (size_t)seg * 256) * DM * 2; u.b = U + (size_t)tt * 256 * DM * 2; u.nt = 16;
            if (tt < 128) u.dst = (char*)(ws + WS_PT) + ((size_t)(tt >> 3) * 256 * 4096 + (size_t)seg * 2048 + (size_t)(tt & 7) * 256) * 2;
            else u.dst = (char*)(ws + WS_PTC) + ((size_t)(tt - 128) * 256 * 4096 + (size_t)seg * 256) * 2;
            return true;
        }
        if (kind == 7) {
            if (!pg8::tile_of(L, nM, 16, pm, pn)) return false;
            u.a = (const char*)(ws + WS_U) + (size_t)pm * 256 * DM * 2; u.b = (const char*)(ws + WS_W1) + ((size_t)l * DFF + (size_t)pn * 256) * DM * 2; u.nt = 16;
            u.dst = (char*)(ws + WS_Z) + ((size_t)pm * 256 * DFF + (size_t)pn * 256) * 2; return true;
        }
        if (kind == 2) {
            if (L < 128) { const int b_ = (int)(L >> 3), kt = (int)(L & 7);
                u.a = (const char*)(ws + WS_DFT) + (size_t)kt * 256 * 4096 * 2; u.b = (const char*)(ws + WS_PT) + (size_t)b_ * 256 * 4096 * 2; u.nt = 64;
                u.dst = (char*)(ws + WS_Y) + ((size_t)(b_ * SEQ + kt * 256) * YN + Y_F) * 2; u.seg = 4; return true; }
            if (l == 0 && L < 144) { const int j = (int)L - 128;
                u.a = (const char*)(ws + WS_DFTC); u.b = (const char*)(ws + WS_PTC) + (size_t)j * 256 * 4096 * 2; u.nt = 8;
                u.dst = (char*)(ws + WS_Y) + ((size_t)(RL + j * 256) * YN + Y_F) * 2; u.seg = 8; return true; }
            return false;
        }
        if (kind == 4) {
            const int seg = i & 3; const long T = (long)(i >> 2) * G + c;
            if (!pg8::tile_of(T, nM, 4, pm, pn)) return false;
            const int coff = seg == 0 ? 0 : (256 + 256 * seg);
            u.a = (const char*)(ws + WS_Y) + ((size_t)pm * 256 * YN + coff) * 2; u.b = (const char*)(ws + WS_WBR) + (((size_t)l * DM + (size_t)pn * 256) * YN + coff) * 2;
            u.nt = seg == 0 ? 8 : 4; u.seg = seg;
            u.dst = (char*)(ws + WS_MRG) + ((size_t)pm * 256 * DM + (size_t)pn * 256) * 2;
            u.x0 = (const char*)(ws + WS_Z) + (size_t)pm * 256 * ZN * 2 + 4096 + seg * DM + pn * 256;
            return true;
        }
        if (!pg8::tile_of(L, nM, 4, pm, pn)) return false;
        if (kind == 5) { u.a = (const char*)(ws + WS_MRG) + (size_t)pm * 256 * DM * 2; u.b = (const char*)(ws + WS_WOUT) + ((size_t)l * DM + (size_t)pn * 256) * DM * 2; u.nt = 16; }
        else { u.a = (const char*)(ws + WS_Z) + (size_t)pm * 256 * DFF * 2; u.b = (const char*)(ws + WS_W2) + ((size_t)l * DM + (size_t)pn * 256) * DFF * 2; u.nt = 64; }
        int bidx; size_t eoff;
        if (pm < 128) { eoff = ((size_t)(ch * RL + pm * 256) * DM + pn * 256) * 4; bidx = ch * NB + (pm >> 3);
            char* out = (char*)ap->out; u.dst = out + eoff; u.x0 = (kind == 5 && l == 0) ? (const char*)ap->in[I_X] + eoff : (const char*)out + eoff; }
        else { eoff = ((size_t)(ch * RC + (pm - 128) * 256) * DM + pn * 256) * 4; bidx = 32;
            u.dst = (char*)(ws + WS_CTXW) + eoff; u.x0 = (kind == 5) ? (const char*)ap->in[I_CTX] + eoff : (const char*)(ws + WS_CTXW) + eoff; }
        u.x1 = (const char*)(ws + WS_MOD) + ((size_t)((l * 33 + bidx) * 6 + (kind == 5 ? 2 : 5)) * DM + pn * 256) * 4;
        return true;
    }
};

__device__ __forceinline__ void tr_item(const float* W, int ldw, int col0, int ncols, bf16_t* WT, int ldt, int koff, LAS float* scr, int item, int lane) {
    const int nblk = ncols / 32, kb = item / nblk, nb = item % nblk, k0 = 64 * kb, n0 = 32 * nb;
#pragma unroll 8
    for (int i = 0; i < 32; ++i) { const int kk = 2 * i + (lane >> 5); scr[kk * 33 + (lane & 31)] = W[(size_t)(k0 + kk) * ldw + col0 + n0 + (lane & 31)]; }
    LDS_WAIT(); asm volatile("" ::: "memory");
    const int c = lane & 7;
#pragma unroll
    for (int j = 0; j < 4; ++j) { const int n = (lane >> 3) + 8 * j; const LAS float* s = scr + (8 * c) * 33 + n;
        u32x4 o; o.x = cvt_pk_bf16(s[0 * 33], s[1 * 33]); o.y = cvt_pk_bf16(s[2 * 33], s[3 * 33]); o.z = cvt_pk_bf16(s[4 * 33], s[5 * 33]); o.w = cvt_pk_bf16(s[6 * 33], s[7 * 33]);
        *(u32x4*)(WT + (size_t)(n0 + n) * ldt + koff + k0 + 8 * c) = o; }
    LDS_WAIT(); asm volatile("" ::: "memory");
}

__device__ __forceinline__ void p0_prologue(ArgP A, LAS unsigned char* lds, int G, const int tid) {
    const int lane = tid & 63, wave = tid >> 6, bx = blockIdx.x;
    unsigned char* ws = A->ws;
    if (bx < 192) {
        const int l = bx / 96, cb = bx % 96, n = cb * 64 + lane;
        LAS float* sl = (LAS float*)lds;
        for (int idx = tid; idx < 33 * 1024; idx += 512) { const int bb = idx >> 10, k = idx & 1023; const float v = bb < 32 ? A->in[I_C][bb * 1024 + k] : A->in[I_CCTX][k]; sl[idx] = v * sigm(v); }
        __syncthreads();
        float acc[33];
#pragma unroll
        for (int bb = 0; bb < 33; ++bb) acc[bb] = 0.f;
        const float* wp = A->in[I_WMOD] + ((size_t)l * 1024 + wave * 128) * 6144 + n;
        for (int k4 = 0; k4 < 32; ++k4) {
            const float w0 = wp[(size_t)(4 * k4 + 0) * 6144], w1 = wp[(size_t)(4 * k4 + 1) * 6144], w2 = wp[(size_t)(4 * k4 + 2) * 6144], w3 = wp[(size_t)(4 * k4 + 3) * 6144];
#pragma unroll
            for (int bb = 0; bb < 33; ++bb) { const f32x4 s = *(const LAS f32x4*)(sl + bb * 1024 + wave * 128 + 4 * k4); acc[bb] += s[0] * w0 + s[1] * w1 + s[2] * w2 + s[3] * w3; }
        }
        __syncthreads();
        LAS float* red = (LAS float*)lds;
#pragma unroll
        for (int bb = 0; bb < 33; ++bb) red[(wave * 33 + bb) * 64 + lane] = acc[bb];
        __syncthreads();
        float* MOD = (float*)(ws + WS_MOD);
        for (int idx = tid; idx < 33 * 64; idx += 512) { const int bb = idx >> 6, ln = idx & 63; float s = A->in[I_BMOD][l * 6144 + cb * 64 + ln];
#pragma unroll
            for (int w = 0; w < 8; ++w) s += red[(w * 33 + bb) * 64 + ln];
            MOD[(size_t)(l * 33 + bb) * 6144 + cb * 64 + ln] = s; }
        __syncthreads();
    } else if (bx < 224) {
        const int it = bx - 192, l = it >> 4, k0 = (it & 15) * 64;
        LAS float* wt = (LAS float*)lds;
        LAS float* tab = (LAS float*)(lds + 65536);
        for (int idx = tid; idx < 64 * 256; idx += 512) { const int kk = idx >> 8, c = idx & 255; wt[idx] = A->in[I_WIN][((size_t)l * 1024 + k0 + kk) * NIN + 1024 + c]; }
        { const int i = tid & 255; tab[tid] = (tid < 256) ? cospif((float)i / 128.f) : sinpif((float)i / 128.f); }
        __syncthreads();
        const int m = tid & 255; const LAS float* tb = tab + (tid >> 8) * 256;
        bf16_t* WF = (bf16_t*)(ws + WS_WF) + ((size_t)l * 512 + tid) * DM + k0;
        for (int kg = 0; kg < 8; ++kg) {
            float a[8];
#pragma unroll
            for (int q = 0; q < 8; ++q) a[q] = 0.f;
            for (int c = 0; c < 256; ++c) { const float tv = tb[(m * c) & 255];
#pragma unroll
                for (int q = 0; q < 8; ++q) a[q] += wt[(kg * 8 + q) * 256 + c] * tv; }
            u32x4 o; o.x = cvt_pk_bf16(a[0], a[1]); o.y = cvt_pk_bf16(a[2], a[3]); o.z = cvt_pk_bf16(a[4], a[5]); o.w = cvt_pk_bf16(a[6], a[7]);
            *(u32x4*)(WF + kg * 8) = o;
        }
        __syncthreads();
    }
    {
        LAS float* scr = (LAS float*)(lds + wave * 16384);
        const int gw = wave * G + bx, NGW = G * 8;
        for (int it = gw; it < 16384; it += NGW) {
            const int l = it >> 13; int r = it & 8191;
            const float* win = A->in[I_WIN] + (size_t)l * 1024 * NIN;
            bf16_t* WIN = (bf16_t*)(ws + WS_WIN) + (size_t)l * WN * DM;
            bf16_t* WBR = (bf16_t*)(ws + WS_WBR) + (size_t)l * DM * YN;
            if (r < 512) { tr_item(win, NIN, 0, 1024, WIN, DM, 0, scr, r, lane); continue; } r -= 512;
            if (r < 2560) { tr_item(win, NIN, 1280, 5120, WIN + (size_t)1024 * DM, DM, 0, scr, r, lane); continue; } r -= 2560;
            if (r < 256) { tr_item(A->in[I_BRL] + (size_t)l * 512 * DM, DM, 0, DM, WBR, YN, 0, scr, r, lane); continue; } r -= 256;
            if (r < 128) { tr_item(A->in[I_BRF] + (size_t)l * 256 * DM, DM, 0, DM, WBR, YN, Y_F, scr, r, lane); continue; } r -= 128;
            if (r < 128) { tr_item(A->in[I_BRS] + (size_t)l * 256 * DM, DM, 0, DM, WBR, YN, Y_SC, scr, r, lane); continue; } r -= 128;
            if (r < 512) { tr_item(A->in[I_WOUT] + (size_t)l * DM * DM, DM, 0, DM, (bf16_t*)(ws + WS_WOUT) + (size_t)l * DM * DM, DM, 0, scr, r, lane); continue; } r -= 512;
            if (r < 2048) { tr_item(A->in[I_FF1] + (size_t)l * DM * DFF, DFF, 0, DFF, (bf16_t*)(ws + WS_W1) + (size_t)l * DFF * DM, DM, 0, scr, r, lane); continue; } r -= 2048;
            tr_item(A->in[I_FF2] + (size_t)l * DFF * DM, DM, 0, DM, (bf16_t*)(ws + WS_W2) + (size_t)l * DM * DFF, DFF, 0, scr, r, lane);
        }
    }
    const int gt = bx * 512 + tid, NGT = G * 512;
    {
        bf16_t* WG = (bf16_t*)(ws + WS_WG);
        for (int idx = gt; idx < 2 * 8 * 256 * 64; idx += NGT) { const int i = idx & 63, n = (idx >> 6) & 255, h = (idx >> 14) & 7, l = idx >> 17, d = n >> 7, gate = (n >> 6) & 1, j = n & 63;
            const float v = (gate ? A->in[I_WX] : A->in[I_WA])[((size_t)((l * 2 + d) * 8 + h) * 64 + i) * 64 + j];
            WG[idx] = (bf16_t)(cvt_pk_bf16(v, 0.f) & 0xffffu); }
    }
    {
        for (int idx = gt; idx < 2 * 256 * 1024; idx += NGT) { const int n = idx & 1023, i = (idx >> 10) & 255, l = idx >> 18, g = i >> 6, il = i & 63;
            const float* pw = A->in[I_POOLW] + ((size_t)(l * 4 + g) * 64 + il) * 64; const float* ps = A->in[I_POOLS] + l * 256 + g * 64; const float* wb = A->in[I_BRP] + ((size_t)l * 256 + g * 64) * DM + n;
            float s = 0.f;
            for (int j = 0; j < 64; ++j) s += pw[j] * ps[j] * wb[(size_t)j * DM];
            ((bf16_t*)(ws + WS_WBR))[((size_t)l * DM + n) * YN + Y_POOL + i] = (bf16_t)(cvt_pk_bf16(s, 0.f) & 0xffffu); }
    }
    {
        bf16_t* DF = (bf16_t*)(ws + WS_DFT);
        for (int idx = gt; idx < 2048 * 512; idx += NGT) { const int k = idx >> 9, n8 = (idx & 511) * 8; float v[8];
#pragma unroll
            for (int e = 0; e < 8; ++e) { const int np = n8 + e; if (np < 2048) v[e] = cospif((float)((k * np) & 2047) * (1.f / 1024.f)); else v[e] = -sinpif((float)((k * (np - 2048)) & 2047) * (1.f / 1024.f)); }
            u32x4 o; o.x = cvt_pk_bf16(v[0], v[1]); o.y = cvt_pk_bf16(v[2], v[3]); o.z = cvt_pk_bf16(v[4], v[5]); o.w = cvt_pk_bf16(v[6], v[7]);
            *(u32x4*)(DF + (size_t)k * 4096 + n8) = o; }
        bf16_t* DC = (bf16_t*)(ws + WS_DFTC);
        for (int idx = gt; idx < 256 * 64; idx += NGT) { const int k = idx >> 6, n8 = (idx & 63) * 8; float v[8];
#pragma unroll
            for (int e = 0; e < 8; ++e) { const int np = n8 + e; if (np < 256) v[e] = cospif((float)((k * np) & 255) * (1.f / 128.f)); else v[e] = -sinpif((float)((k * (np - 256)) & 255) * (1.f / 128.f)); }
            u32x4 o; o.x = cvt_pk_bf16(v[0], v[1]); o.y = cvt_pk_bf16(v[2], v[3]); o.z = cvt_pk_bf16(v[4], v[5]); o.w = cvt_pk_bf16(v[6], v[7]);
            *(u32x4*)(DC + (size_t)k * 4096 + n8) = o; }
    }
}

__device__ __forceinline__ void norm_phase(ArgP A, int l, int ch, bool second, int r_begin, int r_end, int r_step, const int tid) {
    const int lane = tid & 63, wave = tid >> 6;
    unsigned char* ws = A->ws;
    const int nrows = (second && l == 1) ? RL : RT, rend = r_end < nrows ? r_end : nrows;
    const float* gn = (second ? A->in[I_G2] : A->in[I_G1]) + l * DM;
    const float* MOD = (const float*)(ws + WS_MOD);
    bf16_t* U = (bf16_t*)(ws + WS_U);
    for (int r0 = r_begin + wave; r0 < rend; r0 += 2 * r_step) {
        const float* src[2]; const float* sh[2]; int rr[2]; bool ok[2];
#pragma unroll
        for (int q = 0; q < 2; ++q) { const int rq = r0 + q * r_step; ok[q] = rq < rend; const int r = ok[q] ? rq : r0; rr[q] = r; int bidx;
            if (r < RL) { const size_t grow = (size_t)ch * RL + r; src[q] = ((!second && l == 0) ? A->in[I_X] : (const float*)A->out) + grow * DM; bidx = ch * NB + (r >> 11); }
            else { const size_t grow = (size_t)ch * RC + (r - RL); src[q] = ((!second && l == 0) ? A->in[I_CTX] : (const float*)(ws + WS_CTXW)) + grow * DM; bidx = 32; }
            sh[q] = MOD + (size_t)((l * 33 + bidx) * 6 + (second ? 3 : 0)) * DM; }
        f32x4 v[2][4]; float s[2] = {0.f, 0.f};
#pragma unroll
        for (int q = 0; q < 2; ++q)
#pragma unroll
            for (int j = 0; j < 4; ++j) v[q][j] = *(const f32x4*)(src[q] + 4 * (lane + 64 * j));
#pragma unroll
        for (int q = 0; q < 2; ++q) {
#pragma unroll
            for (int j = 0; j < 4; ++j) s[q] += (v[q][j][0] * v[q][j][0] + v[q][j][1] * v[q][j][1]) + (v[q][j][2] * v[q][j][2] + v[q][j][3] * v[q][j][3]);
            s[q] = 1.0f / sqrtf(wave_sum(s[q]) * (1.f / DM) + 1e-6f); }
#pragma unroll
        for (int q = 0; q < 2; ++q) { if (!ok[q]) continue;
#pragma unroll
            for (int j = 0; j < 4; ++j) { const int col = 4 * (lane + 64 * j);
                const f32x4 gg = *(const f32x4*)(gn + col), s1 = *(const f32x4*)(sh[q] + DM + col), s0 = *(const f32x4*)(sh[q] + col);
                const f32x4 o = (v[q][j] * s[q]) * gg * (s1 + 1.0f) + s0;
                u32x2 w; w.x = cvt_pk_bf16(o[0], o[1]); w.y = cvt_pk_bf16(o[2], o[3]);
                *(u32x2*)(U + (size_t)rr[q] * DM + col) = w; } }
    }
}
__device__ __forceinline__ void final_norm(ArgP A, int G, const int tid) {
    const int lane = tid & 63, wave = tid >> 6;
    const float* gn = A->in[I_GF];
    for (int r0 = blockIdx.x * 8 + wave; r0 < NBATCH * SEQ; r0 += 2 * G * 8) {
        float* p[2]; f32x4 v[2][4]; float s[2] = {0.f, 0.f};
#pragma unroll
        for (int q = 0; q < 2; ++q) { int r = r0 + q * G * 8; if (r >= NBATCH * SEQ) r = r0; p[q] = A->out + (size_t)r * DM;
#pragma unroll
            for (int j = 0; j < 4; ++j) v[q][j] = *(const f32x4*)(p[q] + 4 * (lane + 64 * j)); }
#pragma unroll
        for (int q = 0; q < 2; ++q) {
#pragma unroll
            for (int j = 0; j < 4; ++j) s[q] += (v[q][j][0] * v[q][j][0] + v[q][j][1] * v[q][j][1]) + (v[q][j][2] * v[q][j][2] + v[q][j][3] * v[q][j][3]);
            s[q] = 1.0f / sqrtf(wave_sum(s[q]) * (1.f / DM) + 1e-6f); }
#pragma unroll
        for (int q = 0; q < 2; ++q)
#pragma unroll
            for (int j = 0; j < 4; ++j) { const int col = 4 * (lane + 64 * j); const f32x4 gg = *(const f32x4*)(gn + col); *(f32x4*)(p[q] + col) = (v[q][j] * s[q]) * gg; }
    }
}

__device__ __forceinline__ void unpack8(const u32x4 w, float (&f)[8]) {
#pragma unroll
    for (int e = 0; e < 4; ++e) { f[2 * e] = bf_lo(w[e]); f[2 * e + 1] = bf_hi(w[e]); }
}
__device__ __forceinline__ u32x4 pack8(const float (&f)[8]) { u32x4 o; o.x = cvt_pk_bf16(f[0], f[1]); o.y = cvt_pk_bf16(f[2], f[3]); o.z = cvt_pk_bf16(f[4], f[5]); o.w = cvt_pk_bf16(f[6], f[7]); return o; }

__device__ __forceinline__ void lru_item(ArgP A, int l, int it, bool pass2, LAS unsigned char* lds, const int tid) {
    const int lane = tid & 63, wid = tid >> 6;
    unsigned char* ws = A->ws;
    const int head = it & 7, rest = it >> 3;
    int sc, bl;
    if (!pass2 || l == 0) { sc = rest % NSC; bl = rest / NSC; } else { sc = 4 + (rest & 31); bl = rest >> 5; }
    const bool isctx = sc < 4; const int c = isctx ? sc : sc - 4, Lseq = isctx ? CTXL : SEQ, rowbase = isctx ? RL + bl * CTXL : bl * SEQ, t0 = c * 64;
    const bf16_t* Z = (const bf16_t*)(ws + WS_Z);
    LAS float* xaf = (LAS float*)lds;
    LAS bf16_t* xab = (LAS bf16_t*)(lds + 17408);
    LAS float* hbuf = (LAS float*)(lds + 32768);
    {
        const int t = tid >> 3, i8 = (tid & 7) * 8, tok = t0 + t, Cc = head * 64 + i8;
        float acc[8];
        { const f32x4 b0 = *(const f32x4*)(A->in[I_CONVB] + l * DLRU + Cc), b1 = *(const f32x4*)(A->in[I_CONVB] + l * DLRU + Cc + 4);
#pragma unroll
          for (int e = 0; e < 4; ++e) { acc[e] = b0[e]; acc[4 + e] = b1[e]; } }
#pragma unroll
        for (int k = 0; k < 4; ++k) { const int tt = tok + k - 2;
            if (tt >= 0 && tt < Lseq) { float z[8]; unpack8(*(const u32x4*)(Z + (size_t)(rowbase + tt) * ZN + Cc), z);
                const float* cw = A->in[I_CONVW] + (size_t)(l * 4 + k) * DLRU + Cc; const f32x4 c0 = *(const f32x4*)cw, c1 = *(const f32x4*)(cw + 4);
#pragma unroll
                for (int e = 0; e < 4; ++e) { acc[e] += z[e] * c0[e]; acc[4 + e] += z[4 + e] * c1[e]; } } }
        *(LAS f32x4*)(xaf + t * 68 + i8) = (f32x4){acc[0], acc[1], acc[2], acc[3]}; *(LAS f32x4*)(xaf + t * 68 + i8 + 4) = (f32x4){acc[4], acc[5], acc[6], acc[7]};
        *(LAS u32x4*)(xab + t * 72 + i8) = pack8(acc);
    }
    __syncthreads();
    {
        const int d = wid >> 2, g = wid & 3, fr = lane & 15, fq = lane >> 4;
        const bf16_t* wb = (const bf16_t*)(ws + WS_WG) + ((size_t)((l * 8 + head) * 256 + d * 128 + 16 * g + fr)) * 64 + 8 * fq;
        bf16x8 wR[2], wG[2];
#pragma unroll
        for (int ks = 0; ks < 2; ++ks) { wR[ks] = *(const bf16x8*)(wb + 32 * ks); wG[ks] = *(const bf16x8*)(wb + 64 * 64 + 32 * ks); }
        const int cb = head * 64 + 16 * g + 4 * fq;
        const f32x4 ba = *(const f32x4*)(A->in[I_BA] + (l * 2 + d) * DLRU + cb), bxv = *(const f32x4*)(A->in[I_BX] + (l * 2 + d) * DLRU + cb), lam = *(const f32x4*)(A->in[I_LAM] + (l * 2 + d) * DLRU + cb);
        f32x4 sp8;
#pragma unroll
        for (int e = 0; e < 4; ++e) sp8[e] = 8.0f * log1pf(__expf(-lam[e]));
        const int p = (d == 0) ? sc : (isctx ? 3 - c : 4 + 31 - c);
        float* SA = (float*)(ws + WS_SUMA) + ((size_t)(bl * 2 + d) * NSC) * DLRU + cb; float* SH = (float*)(ws + WS_SUMH) + ((size_t)(bl * 2 + d) * NSC) * DLRU + cb;
        f32x4 hin = (f32x4){0.f, 0.f, 0.f, 0.f}, Atot = (f32x4){1.f, 1.f, 1.f, 1.f}, Htot = (f32x4){0.f, 0.f, 0.f, 0.f};
        if (pass2) for (int pp = 0; pp < p; ++pp) { const f32x4 a4 = *(const f32x4*)(SA + (size_t)pp * DLRU), h4 = *(const f32x4*)(SH + (size_t)pp * DLRU); hin = a4 * hin + h4; }
        const int lastl = (lane & 48) | (d ? 0 : 15);
#pragma unroll
        for (int q = 0; q < 4; ++q) { const int tt = d ? 3 - q : q;
            f32x4 aR = (f32x4){0.f, 0.f, 0.f, 0.f}, aG = (f32x4){0.f, 0.f, 0.f, 0.f};
#pragma unroll
            for (int ks = 0; ks < 2; ++ks) { const bf16x8 bfrag = *(const LAS bf16x8*)(xab + (16 * tt + fr) * 72 + 8 * fq + 32 * ks);
                aR = __builtin_amdgcn_mfma_f32_16x16x32_bf16(wR[ks], bfrag, aR, 0, 0, 0); aG = __builtin_amdgcn_mfma_f32_16x16x32_bf16(wG[ks], bfrag, aG, 0, 0, 0); }
            const f32x4 xv = *(const LAS f32x4*)(xaf + (16 * tt + fr) * 68 + 16 * g + 4 * fq);
            f32x4 hv;
#pragma unroll
            for (int e = 0; e < 4; ++e) {
                const float r = sigm(aR[e] + ba[e]), gi = sigm(aG[e] + bxv[e]);
                const float la = -r * sp8[e], a = __expf(la), x2 = -2.0f * la;
                const float om = x2 < 0.1f ? x2 * (1.0f - x2 * (0.5f - x2 * (0.16666667f - x2 * 0.041666668f))) : 1.0f - a * a;
                float Av = a, Bv = sqrtf(om) * gi * xv[e];
#pragma unroll
                for (int off = 1; off < 16; off <<= 1) { const int src = d ? lane + off : lane - off; const float Ap = __shfl(Av, src), Bp = __shfl(Bv, src);
                    const bool valid = d ? (fr + off < 16) : (fr >= off); if (valid) { Bv = Av * Bp + Bv; Av = Av * Ap; } }
                if (pass2) { const float h = Av * hin[e] + Bv; hv[e] = h; hin[e] = __shfl(h, lastl); }
                else { const float AT = __shfl(Av, lastl), BT = __shfl(Bv, lastl); Htot[e] = AT * Htot[e] + BT; Atot[e] = Atot[e] * AT; }
            }
            if (pass2) *(LAS f32x4*)(hbuf + ((d * 64 + 16 * tt + fr) * 68 + 16 * g + 4 * fq)) = hv;
        }
        if (!pass2 && fr == 0) { *(f32x4*)(SA + (size_t)p * DLRU) = Atot; *(f32x4*)(SH + (size_t)p * DLRU) = Htot; }
    }
    if (pass2) {
        __syncthreads();
        const int t = tid >> 3, i8 = (tid & 7) * 8, tok = t0 + t, Cc = head * 64 + i8;
        float zg[8]; unpack8(*(const u32x4*)(Z + (size_t)(rowbase + tok) * ZN + Z_LG + Cc), zg);
        const f32x4 h00 = *(const LAS f32x4*)(hbuf + t * 68 + i8), h01 = *(const LAS f32x4*)(hbuf + t * 68 + i8 + 4), h10 = *(const LAS f32x4*)(hbuf + (64 + t) * 68 + i8), h11 = *(const LAS f32x4*)(hbuf + (64 + t) * 68 + i8 + 4);
        float y[8];
#pragma unroll
        for (int e = 0; e < 8; ++e) { const float hs = e < 4 ? h00[e & 3] + h10[e & 3] : h01[e & 3] + h11[e & 3]; const float x = zg[e];
            const float u2 = 1.5957691216057308f * (x + 0.044715f * x * x * x);
            y[e] = hs * x * sigm(u2); }
        *(u32x4*)((bf16_t*)(ws + WS_Y) + (size_t)(rowbase + tok) * YN + Cc) = pack8(y);
    }
}

__device__ __forceinline__ void sweep_chunk(int d, int j, int bl, int& rowbase, int& t0, int& Lseq, bool& isctx) {
    isctx = j < 4; const int c = isctx ? (d ? 3 - j : j) : (d ? 35 - j : j - 4);
    Lseq = isctx ? CTXL : SEQ; rowbase = isctx ? RL + bl * CTXL : bl * SEQ; t0 = c * 64;
}
__device__ __forceinline__ void lru_sweep(ArgP A, int l, int item, LAS unsigned char* lds, const int tid) {
    unsigned char* ws = A->ws;
    const int lane = tid & 63, wid = tid >> 6, d = wid >> 2, g = wid & 3, fr = lane & 15, fq = lane >> 4, hl = tid & 255;
    const int head = item & 7, bl = item >> 3;
    const bf16_t* Z = (const bf16_t*)(ws + WS_Z);
    LAS float* cwl = (LAS float*)(lds + 106496);
    __syncthreads();
    if (tid < 256) cwl[tid] = A->in[I_CONVW][(size_t)(l * 4 + (tid >> 6)) * DLRU + head * 64 + (tid & 63)];
    else if (tid < 320) cwl[tid] = A->in[I_CONVB][l * DLRU + head * 64 + (tid - 256)];
    const bf16_t* wb = (const bf16_t*)(ws + WS_WG) + ((size_t)((l * 8 + head) * 256 + d * 128 + 16 * g + fr)) * 64 + 8 * fq;
    bf16x8 wR[2], wG[2];
#pragma unroll
    for (int ks = 0; ks < 2; ++ks) { wR[ks] = *(const bf16x8*)(wb + 32 * ks); wG[ks] = *(const bf16x8*)(wb + 64 * 64 + 32 * ks); }
    const int cb = head * 64 + 16 * g + 4 * fq;
    const f32x4 ba = *(const f32x4*)(A->in[I_BA] + (l * 2 + d) * DLRU + cb), bxv = *(const f32x4*)(A->in[I_BX] + (l * 2 + d) * DLRU + cb), lam = *(const f32x4*)(A->in[I_LAM] + (l * 2 + d) * DLRU + cb);
    const float LOG2E = 1.4426950408889634f;
    f32x4 spl2; const f32x4 nba = ba * (-LOG2E), nbx = bxv * (-LOG2E);
#pragma unroll
    for (int e = 0; e < 4; ++e) { const float sp8 = 8.0f * log1pf(__expf(-lam[e])); spl2[e] = sp8 * LOG2E; }
    float* HX = (float*)(ws + (d ? WS_HB : WS_HF));
    const int lastl = lane | 15;
    const int ct = hl >> 2, ci = (hl & 3) * 16;
    f32x4 hin = (f32x4){0.f, 0.f, 0.f, 0.f};
#define SWEEP_LOAD(zr, jj) do { int rb_, t0_, Ls_; bool ic_; sweep_chunk(d, (jj) < NSC ? (jj) : NSC - 1, bl, rb_, t0_, Ls_, ic_); \
        _Pragma("unroll") for (int k = 0; k < 4; ++k) { const int tt_ = t0_ + ct + k - 2; const bool ok_ = (tt_ >= 0 && tt_ < Ls_); const int tc_ = ok_ ? tt_ : t0_ + ct; \
            const bf16_t* zp_ = Z + (size_t)(rb_ + tc_) * ZN + head * 64 + ci; const u32x4 l0_ = *(const u32x4*)zp_, l1_ = *(const u32x4*)(zp_ + 8); const unsigned mk_ = ok_ ? 0xffffffffu : 0u; \
            zr[k][0] = l0_ & mk_; zr[k][1] = l1_ & mk_; } } while (0)
#define SWEEP_CONV(zr, bufi) do { LAS float* xaf_ = (LAS float*)(lds + d * 53248 + (bufi) * 26624); LAS bf16_t* xab_ = (LAS bf16_t*)(lds + d * 53248 + (bufi) * 26624 + 17408); \
        _Pragma("unroll") for (int hf_ = 0; hf_ < 2; ++hf_) { float acc[8]; \
            { const f32x4 b0_ = *(const LAS f32x4*)(cwl + 256 + ci + 8 * hf_), b1_ = *(const LAS f32x4*)(cwl + 256 + ci + 8 * hf_ + 4); _Pragma("unroll") for (int e = 0; e < 4; ++e) { acc[e] = b0_[e]; acc[4 + e] = b1_[e]; } } \
            _Pragma("unroll") for (int k = 0; k < 4; ++k) { float z[8]; unpack8(zr[k][hf_], z); \
                const f32x4 w0_ = *(const LAS f32x4*)(cwl + k * 64 + ci + 8 * hf_), w1_ = *(const LAS f32x4*)(cwl + k * 64 + ci + 8 * hf_ + 4); \
                _Pragma("unroll") for (int e = 0; e < 4; ++e) { acc[e] += z[e] * w0_[e]; acc[4 + e] += z[4 + e] * w1_[e]; } } \
            *(LAS f32x4*)(xaf_ + ct * 68 + ci + 8 * hf_) = (f32x4){acc[0], acc[1], acc[2], acc[3]}; *(LAS f32x4*)(xaf_ + ct * 68 + ci + 8 * hf_ + 4) = (f32x4){acc[4], acc[5], acc[6], acc[7]}; \
            *(LAS u32x4*)(xab_ + ct * 72 + ci + 8 * hf_) = pack8(acc); } } while (0)
#define SCAN_LVL(N) "v_fmac_f32_dpp %0, %0, %4 row_shr:" #N " row_mask:0xf bank_mask:0xf\n\tv_fmac_f32_dpp %1, %1, %5 row_shr:" #N " row_mask:0xf bank_mask:0xf\n\t" \
                    "v_fmac_f32_dpp %2, %2, %6 row_shr:" #N " row_mask:0xf bank_mask:0xf\n\tv_fmac_f32_dpp %3, %3, %7 row_shr:" #N " row_mask:0xf bank_mask:0xf\n\t" \
                    "v_mul_f32_dpp %4, %4, %4 row_shr:" #N " row_mask:0xf bank_mask:0xf\n\tv_mul_f32_dpp %5, %5, %5 row_shr:" #N " row_mask:0xf bank_mask:0xf\n\t" \
                    "v_mul_f32_dpp %6, %6, %6 row_shr:" #N " row_mask:0xf bank_mask:0xf\n\tv_mul_f32_dpp %7, %7, %7 row_shr:" #N " row_mask:0xf bank_mask:0xf\n\t"
#define SWEEP_SCAN \
        _Pragma("unroll") \
        for (int q = 0; q < 4; ++q) { const int tt = d ? 3 - q : q, trow = 16 * tt + (d ? 15 - fr : fr); \
            f32x4 aR = (f32x4){0.f, 0.f, 0.f, 0.f}, aG = (f32x4){0.f, 0.f, 0.f, 0.f}; \
        _Pragma("unroll") \
            for (int ks = 0; ks < 2; ++ks) { const bf16x8 bfrag = *(const LAS bf16x8*)(xab + trow * 72 + 8 * fq + 32 * ks); \
                aR = __builtin_amdgcn_mfma_f32_16x16x32_bf16(wR[ks], bfrag, aR, 0, 0, 0); aG = __builtin_amdgcn_mfma_f32_16x16x32_bf16(wG[ks], bfrag, aG, 0, 0, 0); } \
            const f32x4 xv = *(const LAS f32x4*)(xaf + trow * 68 + 16 * g + 4 * fq); \
            f32x4 Av, Bv; \
            { \
                const f32x4 tR = aR * (-LOG2E) + nba, tG = aG * (-LOG2E) + nbx; \
                f32x4 eR, eG; \
        _Pragma("unroll") \
                for (int e = 0; e < 4; ++e) { eR[e] = __builtin_amdgcn_exp2f(tR[e]); eG[e] = __builtin_amdgcn_exp2f(tG[e]); } \
                eR = eR + 1.0f; eG = eG + 1.0f; \
                f32x4 r, gi; \
        _Pragma("unroll") \
                for (int e = 0; e < 4; ++e) { r[e] = __builtin_amdgcn_rcpf(eR[e]); gi[e] = __builtin_amdgcn_rcpf(eG[e]); } \
                const f32x4 ta = r * spl2, x2 = ta * 1.3862943611198906f; \
        _Pragma("unroll") \
                for (int e = 0; e < 4; ++e) Av[e] = __builtin_amdgcn_exp2f(-ta[e]); \
                const f32x4 pser = x2 * (x2 * (x2 * 0.16666667f - 0.5f) + 1.0f), om1 = 1.0f - Av * Av; \
                f32x4 sq; \
        _Pragma("unroll") \
                for (int e = 0; e < 4; ++e) sq[e] = __builtin_amdgcn_sqrtf(x2[e] < 0.02f ? pser[e] : om1[e]); \
                Bv = sq * gi * xv; \
            } \
            { \
                float B0 = Bv[0], B1 = Bv[1], B2 = Bv[2], B3 = Bv[3], A0 = Av[0], A1 = Av[1], A2 = Av[2], A3 = Av[3]; \
                asm volatile("s_nop 1\n\t" SCAN_LVL(1) SCAN_LVL(2) SCAN_LVL(4) SCAN_LVL(8) "s_nop 1" \
                    : "+v"(B0), "+v"(B1), "+v"(B2), "+v"(B3), "+v"(A0), "+v"(A1), "+v"(A2), "+v"(A3)); \
                Av = (f32x4){A0, A1, A2, A3}; Bv = (f32x4){B0, B1, B2, B3}; \
            } \
            const f32x4 hq = Av * hin + Bv; *(f32x4*)(HX + (size_t)(rowbase + t0 + trow) * DLRU + cb) = hq; \
        _Pragma("unroll") \
            for (int e = 0; e < 4; ++e) hin[e] = __shfl(hq[e], lastl); \
        }
    __syncthreads();
    u32x4 za[4][2], zb[4][2];
    { SWEEP_LOAD(zb, 0); SWEEP_LOAD(za, 1); SWEEP_CONV(zb, 0); }
    __syncthreads();
#define SWEEP_STEP(jj, ZL, ZC) do { const int j = (jj); \
        int rowbase, t0, Lseq; bool isctx; sweep_chunk(d, j, bl, rowbase, t0, Lseq, isctx); \
        SWEEP_LOAD(ZL, j + 2); \
        const LAS float* xaf = (const LAS float*)(lds + d * 53248 + (j & 1) * 26624); \
        const LAS bf16_t* xab = (const LAS bf16_t*)(lds + d * 53248 + (j & 1) * 26624 + 17408); \
        SWEEP_SCAN \
        if (j + 1 < NSC) SWEEP_CONV(ZC, (j + 1) & 1); \
        __syncthreads(); } while (0)
    for (int j2 = 0; j2 < NSC; j2 += 2) { SWEEP_STEP(j2, zb, za); SWEEP_STEP(j2 + 1, za, zb); }
#undef SWEEP_STEP
#undef SWEEP_SCAN
#undef SCAN_LVL
#undef SWEEP_LOAD
#undef SWEEP_CONV
    asm volatile("s_waitcnt vmcnt(0)" ::: "memory");
    __syncthreads();
    {
        const float* HF = (const float*)(ws + WS_HF); const float* HB = (const float*)(ws + WS_HB);
        const int t = tid >> 3, i8 = (tid & 7) * 8, Cc = head * 64 + i8;
        for (int sc0 = (l == 0 ? 0 : 4); sc0 < NSC; sc0 += 4) {
            u32x4 zgw[4]; f32x4 f0[4], f1[4], b0[4], b1[4]; int rows[4];
#pragma unroll
            for (int u = 0; u < 4; ++u) { const int sc = sc0 + u; const int row = (sc < 4 ? RL + bl * CTXL + sc * 64 : bl * SEQ + (sc - 4) * 64) + t; rows[u] = row;
                zgw[u] = *(const u32x4*)(Z + (size_t)row * ZN + Z_LG + Cc);
                f0[u] = *(const f32x4*)(HF + (size_t)row * DLRU + Cc); f1[u] = *(const f32x4*)(HF + (size_t)row * DLRU + Cc + 4);
                b0[u] = *(const f32x4*)(HB + (size_t)row * DLRU + Cc); b1[u] = *(const f32x4*)(HB + (size_t)row * DLRU + Cc + 4); }
#pragma unroll
            for (int u = 0; u < 4; ++u) { float zg[8]; unpack8(zgw[u], zg); float y[8];
#pragma unroll
                for (int e = 0; e < 8; ++e) { const float hs = e < 4 ? f0[u][e & 3] + b0[u][e & 3] : f1[u][e & 3] + b1[u][e & 3]; const float x = zg[e];
                    const float u2 = 1.5957691216057308f * (x + 0.044715f * x * x * x);
                    y[e] = hs * x * sigm(u2); }
                *(u32x4*)((bf16_t*)(ws + WS_Y) + (size_t)rows[u] * YN + Cc) = pack8(y); }
        }
    }
}

__device__ __forceinline__ void seg_decode(int it, int& rowbase, int& s0, int& lob, int& hib, int& Lseq) {
    if (it < 512) { const int bl = it >> 5, sg = it & 31; rowbase = bl * SEQ; s0 = sg * 64; lob = s0; hib = s0 + 64; Lseq = SEQ; }
    else { const int j = it - 512, bl = j >> 2, q = j & 3; rowbase = RL + bl * CTXL; s0 = q * 64; lob = 0; hib = CTXL; Lseq = CTXL; }
}
__device__ __forceinline__ void pool_item(ArgP A, int it, LAS unsigned char* lds, const int tid) {
    unsigned char* ws = A->ws;
    int rowbase, s0, lob, hib, Lseq; seg_decode(it, rowbase, s0, lob, hib, Lseq);
    const bf16_t* Z = (const bf16_t*)(ws + WS_Z) + Z_POOL;
    const int c8 = (tid & 31) * 8, tq = tid >> 5, w2 = 1 << (c8 >> 6);
    bf16_t* Y = (bf16_t*)(ws + WS_Y) + Y_POOL + c8;
#pragma unroll
    for (int u = 0; u < 4; ++u) { const int tok = s0 + tq * 4 + u; const int lo = max(tok - w2, lob), hi = min(tok + w2, hib);
        float sum[8];
#pragma unroll
        for (int e = 0; e < 8; ++e) sum[e] = 0.f;
        for (int j = lo; j < hi; ++j) { float z[8]; unpack8(*(const u32x4*)(Z + (size_t)(rowbase + j) * ZN + c8), z);
#pragma unroll
            for (int e = 0; e < 8; ++e) sum[e] += z[e]; }
        float zc[8]; unpack8(*(const u32x4*)(Z + (size_t)(rowbase + tok) * ZN + c8), zc);
        const float inv = 1.0f / (float)(hi - lo);
#pragma unroll
        for (int e = 0; e < 8; ++e) sum[e] = sum[e] * inv - zc[e];
        *(u32x4*)(Y + (size_t)(rowbase + tok) * YN) = pack8(sum); }
}
__device__ __forceinline__ void sconv_item(ArgP A, int l, int it, const int tid) {
    unsigned char* ws = A->ws;
    int rowbase, s0, lob, hib, Lseq; seg_decode(it, rowbase, s0, lob, hib, Lseq);
    const bf16_t* Z = (const bf16_t*)(ws + WS_Z);
    const int c8 = (tid & 31) * 8, tr = tid >> 5;
    const float* sw = A->in[I_SCW] + (size_t)l * 3 * 256 + c8;
    f32x4 w0[3], w1[3];
#pragma unroll
    for (int k = 0; k < 3; ++k) { w0[k] = *(const f32x4*)(sw + k * 256); w1[k] = *(const f32x4*)(sw + k * 256 + 4); }
#pragma unroll
    for (int pp = 0; pp < 2; ++pp) {
        u32x4 gcw[2][3], hsw[2][3], gbw[2];
#pragma unroll
        for (int q = 0; q < 2; ++q) { const int tok = s0 + (pp * 2 + q) * 16 + tr;
            gbw[q] = *(const u32x4*)(Z + (size_t)(rowbase + tok) * ZN + Z_SC + c8);
#pragma unroll
            for (int k = 0; k < 3; ++k) { const int tt = tok + k - 1; const bool ok = (tt >= 0 && tt < Lseq); const bf16_t* zr = Z + (size_t)(rowbase + (ok ? tt : tok)) * ZN + Z_SC + c8;
                const u32x4 a = *(const u32x4*)(zr + 256), b = *(const u32x4*)(zr + 512); const unsigned mk = ok ? 0xffffffffu : 0u; gcw[q][k] = a & mk; hsw[q][k] = b; } }
#pragma unroll
        for (int q = 0; q < 2; ++q) { const int tok = s0 + (pp * 2 + q) * 16 + tr; float acc[8];
#pragma unroll
            for (int e = 0; e < 8; ++e) acc[e] = 0.f;
#pragma unroll
            for (int k = 0; k < 3; ++k) { float gc[8], hs[8]; unpack8(gcw[q][k], gc); unpack8(hsw[q][k], hs);
#pragma unroll
                for (int e = 0; e < 4; ++e) { acc[e] += gc[e] * hs[e] * w0[k][e]; acc[4 + e] += gc[4 + e] * hs[4 + e] * w1[k][e]; } }
            float gb[8]; unpack8(gbw[q], gb);
#pragma unroll
            for (int e = 0; e < 8; ++e) acc[e] *= gb[e];
            *(u32x4*)((bf16_t*)(ws + WS_Y) + (size_t)(rowbase + tok) * YN + Y_SC + c8) = pack8(acc); }
    }
}

__device__ __forceinline__ int fetch_item(unsigned* ctr, LAS unsigned char* lds, const int tid) {
    LAS unsigned* slot = (LAS unsigned*)(lds + QSLOT_OFF);
    __syncthreads();
    if (tid == 0) *slot = atomicAdd(ctr, 1u);
    __syncthreads();
    return (int)*slot;
}


#define XB_TMO      128
#define XB_XCNT(j)  (256  + 64 * (j))
#define XB_XSUB(j)  (1280 + 64 * (j))
#define XB_XGEN(j)  (2304 + 64 * (j))
#define XB_TOP      3328
#define XB_TOPGEN   3392
#define XCD_BAR_WORDS 3456
#define XB_SPIN_CAP (1u << 22)
__device__ __forceinline__ unsigned xb_ld(unsigned* p)              { return __hip_atomic_load(p, __ATOMIC_RELAXED, __HIP_MEMORY_SCOPE_AGENT); }
__device__ __forceinline__ unsigned xb_add(unsigned* p, unsigned v) { return __hip_atomic_fetch_add(p, v, __ATOMIC_RELAXED, __HIP_MEMORY_SCOPE_AGENT); }
__device__ __forceinline__ unsigned xb_xcc_id() { return (unsigned)__builtin_amdgcn_s_getreg((3 << 11) | 20) & 0xFu; }
#define XB_SPIN(cond, bar) do { unsigned _sp = 0; while (cond) { __builtin_amdgcn_s_sleep(1); \
    if ((++_sp & 255u) == 0u) { if (xb_ld(&(bar)[XB_TMO])) break; if (_sp > XB_SPIN_CAP) { atomicAdd(&(bar)[XB_TMO], 1u); break; } } } } while (0)
struct XcdBarrier { unsigned* bar; unsigned x; volatile LAS unsigned* st; };
__device__ __forceinline__ XcdBarrier xcd_barrier_post(unsigned* bar, volatile LAS unsigned* st) {
    XcdBarrier b; b.bar = bar; b.x = xb_xcc_id(); b.st = st;
    if (threadIdx.x == 0) (void)xb_add(&bar[XB_XCNT(b.x)], 1u);
    return b;
}
__device__ __forceinline__ void xcd_barrier_complete(unsigned* bar, unsigned x, unsigned& nloc, unsigned& nx) {
    const unsigned G = gridDim.x * gridDim.y * gridDim.z;
    unsigned sum, cnt, mine, sp = 0u;
    for (;;) {
        sum = 0u; cnt = 0u; mine = 0u;
#pragma unroll
        for (unsigned j = 0; j < 16; ++j) { const unsigned c = xb_ld(&bar[XB_XCNT(j)]); sum += c; cnt += (c > 0u) ? 1u : 0u; }
        mine = xb_ld(&bar[XB_XCNT(x)]);
        if (sum == G) break;
        __builtin_amdgcn_s_sleep(1);
        if ((++sp & 255u) == 0u) { if (xb_ld(&bar[XB_TMO])) break; if (sp > XB_SPIN_CAP) { atomicAdd(&bar[XB_TMO], 1u); break; } }
    }
    nloc = mine > 0u ? mine : 1u; nx = cnt > 0u ? cnt : 1u;
}
__device__ __forceinline__ void xcd_barrier(const XcdBarrier& b, const int tid) {
    asm volatile("s_waitcnt vmcnt(0)" ::: "memory");
    __syncthreads();
    if (tid == 0) {
        unsigned* bar = b.bar;
        __builtin_amdgcn_s_waitcnt(0);
        unsigned nloc = b.st[0], nx = b.st[1];
        if (nloc == 0u) { xcd_barrier_complete(bar, b.x, nloc, nx); b.st[0] = nloc; b.st[1] = nx; }
        const unsigned old = xb_add(&bar[XB_XSUB(b.x)], 1u);
        const unsigned gen = old / nloc;
        if (old + 1u == (gen + 1u) * nloc) {
            __builtin_amdgcn_fence(__ATOMIC_RELEASE, "agent");
            asm volatile("s_waitcnt vmcnt(0)" ::: "memory");
            const unsigned og = xb_add(&bar[XB_TOP], 1u);
            const unsigned tg = og / nx;
            if (og + 1u == (tg + 1u) * nx) xb_add(&bar[XB_TOPGEN], 1u);
            else XB_SPIN(xb_ld(&bar[XB_TOPGEN]) == tg, bar);
            __builtin_amdgcn_fence(__ATOMIC_ACQUIRE, "agent");
            xb_add(&bar[XB_XGEN(b.x)], 1u);
            asm volatile("s_waitcnt vmcnt(0)" ::: "memory");
        } else {
            XB_SPIN(xb_ld(&bar[XB_XGEN(b.x)]) == gen, bar);
            __builtin_amdgcn_fence(__ATOMIC_ACQUIRE, "agent");
            asm volatile("s_waitcnt vmcnt(0)" ::: "memory");
        }
    }
    __syncthreads();
}

template <bool COOP>
__global__ void __launch_bounds__(512, 2) fwd_kernel(Args Aparam) {
    extern __shared__ __attribute__((aligned(16))) unsigned char lds_raw[];
    LAS unsigned char* lds = (LAS unsigned char*)lds_raw;
    const int G = gridDim.x;
    ArgP A = (ArgP)__builtin_amdgcn_kernarg_segment_ptr();
    const int ph_lo = A->ph_lo, ph_hi = A->ph_hi;
    XcdBarrier xbar; xbar.bar = nullptr; xbar.x = 0; xbar.st = (volatile LAS unsigned*)(lds + QSLOT_OFF + 16);
    if constexpr (COOP) {
        if (threadIdx.x < 2) xbar.st[threadIdx.x] = 0u;
        __syncthreads();
        xbar = xcd_barrier_post((unsigned*)(A->ws + WS_CTL) + 8192, xbar.st);
    }
    int tid0 = threadIdx.x;
    for (int ph = ph_lo; ph < ph_hi; ++ph) {
        asm volatile("" : "+s"(A));
        asm volatile("" : "+v"(tid0)); const int tid = tid0;
        unsigned* ctl = (unsigned*)(A->ws + WS_CTL);
        if (ph < PH_BASE) p0_prologue(A, lds, G, tid);
        else if (ph == NPHASE - 1) final_norm(A, G, tid);
        else if (ph == PH_BASE) norm_phase(A, 0, 0, false, (int)blockIdx.x * 8, RT, G * 8, tid);
        else {
            const int q = ph - PH_BASE - 1, kj = q % PH_PER, lc = q / PH_PER, l = lc >> 1, ch = lc & 1;
            const int PKJ = PROBE_K < 3 ? PROBE_K - 1 : PROBE_K - 2;
            const int kq = (PROBE_K >= 1 && PROBE_K <= 8 && kj > PKJ) ? kj - 1 : kj;
            const int k = kq < 2 ? kq + 1 : kq + 2;
            const int sub = (PROBE_K >= 1 && PROBE_K <= 8 && kj == PKJ + 1) ? PROBE_SUB : 7;
            if (k == 6) norm_phase(A, l, ch, true, (int)blockIdx.x * 8, RT, G * 8, tid);
            else {
                Sched S; S.kind = k; S.l = l; S.ch = ch; S.G = G; S.c = (int)blockIdx.x; S.ap = A;
                pg8::Gemm g; g.lda = (k == 2 || k == 8) ? 4096 : (k == 4 ? YN : DM); g.ldb = g.lda;
                if (k == 2 && !(sub & 1)) {} else if (k == 1 || k == 2 || k == 7) { pg8::EpiBf E; E.act = (k == 7) ? 1 : 0; pg8::gemm_phase<pg8::EpiBf, Sched>(lds, g, S, E, tid); }
                else if (k == 4) { pg8::EpiMerge E; pg8::gemm_phase<pg8::EpiMerge, Sched>(lds, g, S, E, tid); }
                else { pg8::EpiRes E; pg8::gemm_phase<pg8::EpiRes, Sched>(lds, g, S, E, tid); }
                if (k == 8 && lc + 1 < DEPTH * NCH) {
                    const int l2 = (lc + 1) >> 1, ch2 = (lc + 1) & 1;
                    for (;;) { const int it = fetch_item(ctl + 64 * ph, lds, tid); if (it >= RT / 64) break; norm_phase(A, l2, ch2, false, it * 64, it * 64 + 64, 8, tid); }
                }
                if (k == 2) {
                    if (sub & 2) for (int it = (int)blockIdx.x - (G >> 1); it >= 0 && it < NB * 8; it += G - (G >> 1)) lru_sweep(A, l, it, lds, tid);
                    const int nseg = (l == 0) ? 576 : 512, total = (sub & 4) ? 2 * nseg : 0;
                    for (;;) { const int it = fetch_item(ctl + 64 * ph, lds, tid); if (it >= total) break;
                        if (it < nseg) pool_item(A, it, lds, tid);
                        else sconv_item(A, l, it - nseg, tid); }
                }
            }
        }
        if (ph + 1 < ph_hi) { if constexpr (COOP) { if (ph == 0) cg::this_grid().sync(); else xcd_barrier(xbar, tid); } }
    }
}

extern "C" void kernel_launch(void* const* d_in, const int* in_sizes, int n_in, void* d_out, int out_size, void* d_ws, size_t ws_size, hipStream_t stream) {
    static int grid = 0;
    if (grid == 0) {
        if (n_in != 27 || out_size != NBATCH * SEQ * DM || ws_size < WS_END) { fprintf(stderr, "kernel_launch: unexpected shapes (n_in %d out %d ws %zu)\n", n_in, out_size, ws_size); grid = -1; return; }
        int dev = 0, cus = 0, per_cu = 0;
        hipGetDevice(&dev); hipDeviceGetAttribute(&cus, hipDeviceAttributeMultiprocessorCount, dev);
        hipFuncSetAttribute((const void*)fwd_kernel<true>, hipFuncAttributeMaxDynamicSharedMemorySize, LDS_BYTES);
        hipFuncSetAttribute((const void*)fwd_kernel<false>, hipFuncAttributeMaxDynamicSharedMemorySize, LDS_BYTES);
        hipOccupancyMaxActiveBlocksPerMultiprocessor(&per_cu, (const void*)fwd_kernel<true>, 512, LDS_BYTES);
        (void)hipGetLastError();
        if (per_cu < 1) per_cu = 1;
        grid = cus * 1;
        if (grid <= 0) grid = 256;
    }
    if (grid < 0) return;
    hipMemsetAsync((char*)d_ws + WS_CTL, 0, CTL_ZERO_BYTES, stream);
    Args a{};
    for (int i = 0; i < 27; ++i) a.in[i] = (const float*)d_in[i];
    a.out = (float*)d_out; a.ws = (unsigned char*)d_ws;
#if MK_COOP
    a.ph_lo = 0; a.ph_hi = NPHASE;
    void* args[] = {&a};
    hipError_t e = hipLaunchCooperativeKernel((const void*)fwd_kernel<true>, dim3(grid), dim3(512), args, LDS_BYTES, stream);
    if (e != hipSuccess) fprintf(stderr, "cooperative launch failed: %s (grid %d)\n", hipGetErrorString(e), grid);
#else
    for (int ph = 0; ph < NPHASE; ++ph) { a.ph_lo = ph; a.ph_hi = ph + 1; hipLaunchKernelGGL(fwd_kernel<false>, dim3(grid), dim3(512), LDS_BYTES, stream, a); }
#endif
}
```

```cpp
#include <hip/hip_runtime.h>
#include <hip/hip_cooperative_groups.h>
#include <cstdio>
#include <cstdint>
namespace cg = cooperative_groups;

#ifndef MK_COOP
#define MK_COOP 1
#endif
#define PROBE_SUB 7
#define PROBE_K -1

#define LAS __attribute__((address_space(3)))
typedef unsigned short bf16_t;
typedef short bf16x8 __attribute__((ext_vector_type(8)));
typedef float f32x4 __attribute__((ext_vector_type(4)));
typedef float f32x2 __attribute__((ext_vector_type(2)));
typedef unsigned u32x4 __attribute__((ext_vector_type(4)));
typedef unsigned u32x2 __attribute__((ext_vector_type(2)));

constexpr int NBATCH = 32, SEQ = 2048, CTXL = 256, DM = 1024, DEPTH = 2, DLRU = 512, NIN = 6400, DFF = 4096;
constexpr int NB = 16, NCH = 2;
constexpr int RL = NB * SEQ, RC = NB * CTXL, RT = RL + RC;
constexpr int ZN = 4096  , WN = 6144  , YN = 1280;
constexpr int Z_LG = 512, Z_POOL = 1024, Z_SC = 1280, Z_GATE = 2048;
constexpr int Y_F = 512, Y_POOL = 768, Y_SC = 1024;
constexpr int NSC = 36;
constexpr size_t MiB = 1u << 20;
constexpr size_t WS_CTL = 0, CTL_ZERO_BYTES = 65536;
constexpr size_t WS_MOD = 1 * MiB, WS_WG = 3 * MiB, WS_SUMA = 4 * MiB, WS_SUMH = 7 * MiB, WS_DFTC = 10 * MiB, WS_DFT = 12 * MiB;
constexpr size_t WS_WIN = 28 * MiB, WS_WF = 52 * MiB, WS_WBR = 54 * MiB, WS_WOUT = 60 * MiB, WS_W1 = 64 * MiB, WS_W2 = 80 * MiB;
constexpr size_t WS_CTXW = 96 * MiB, WS_U = 128 * MiB, WS_MRG = 200 * MiB, WS_PT = 272 * MiB, WS_PTC = 304 * MiB, WS_Y = 336 * MiB, WS_Z = 432 * MiB;
constexpr size_t WS_HF = WS_Z + (size_t)RT * ZN * 2, WS_HB = WS_HF + (size_t)RT * DLRU * 4;
constexpr size_t WS_END = WS_HB + (size_t)RT * DLRU * 4;
static_assert(WS_END <= 1024 * MiB, "workspace map");
static_assert(WS_Y + (size_t)RT * YN * 2 <= WS_Z && WS_PTC + (size_t)NB * 256 * 4096 * 2 <= WS_Y && WS_MRG + (size_t)RT * DM * 2 <= WS_PT, "workspace map 2");
constexpr int LDS_BYTES = 147456, RING_BYTES = 131072, QSLOT_OFF = LDS_BYTES - 64;
constexpr int PH_PER = 7 + ((PROBE_K >= 1 && PROBE_K <= 8) ? 1 : 0), PH_BASE = (PROBE_K == 9) ? 2 : 1;
constexpr int NPHASE = PH_BASE + 2 + DEPTH * NCH * PH_PER;

__device__ __forceinline__ float bf_lo(unsigned w) { return __uint_as_float(w << 16); }
__device__ __forceinline__ float bf_hi(unsigned w) { return __uint_as_float(w & 0xffff0000u); }
__device__ __forceinline__ unsigned cvt_pk_bf16(float lo, float hi) { unsigned r; asm volatile("v_cvt_pk_bf16_f32 %0, %1, %2" : "=v"(r) : "v"(lo), "v"(hi)); return r; }
__device__ __forceinline__ float sigm(float x) { return __builtin_amdgcn_rcpf(1.0f + __expf(-x)); }
__device__ __forceinline__ float wave_sum(float v) {
#pragma unroll
    for (int o = 1; o < 64; o <<= 1) v += __shfl_xor(v, o);
    return v;
}
#define LDS_WAIT() asm volatile("s_waitcnt lgkmcnt(0)" ::: "memory")
#define DPP_SHR(ident, v, N) __builtin_bit_cast(float, __builtin_amdgcn_update_dpp(__builtin_bit_cast(int, (float)(ident)), __builtin_bit_cast(int, (float)(v)), 0x110 + (N), 0xf, 0xf, false))
#define SCAN_STEP(N) do { const float Ap_ = DPP_SHR(1.0f, Av, N), Bp_ = DPP_SHR(0.0f, Bv, N); Bv = Av * Bp_ + Bv; Av = Av * Ap_; } while (0)

namespace pg8 {
constexpr int BM = 256, BK = 64, HALF = 128, HTB = HALF * BK * 2, STAGE_BYTES = 8 * HTB, NXCD = 8, WGM = 8;
__host__ __device__ __forceinline__ int lds_byte(int r, int c) { const int st = (r >> 4) * 2 + (c >> 5), rr = r & 15, cc = c & 31, ob = rr * 64 + cc * 2; return st * 1024 + (ob ^ (((ob >> 9) & 1) << 5)); }
__host__ __device__ __forceinline__ void stage_rc(int b, int& R, int& C) { const int st = b / 1024, sb = b % 1024, swz = sb ^ (((sb >> 9) & 1) << 5); R = (st >> 1) * 16 + swz / 64; C = (st & 1) * 32 + (swz % 64) / 2; }
__host__ __device__ __forceinline__ int perm32(int rho) { const int n = rho >> 4, i = rho & 15; return 8 * (i >> 2) + 4 * n + (i & 3); }

struct Unit { const char* a; const char* b; char* dst; const char* x0; const char* x1; int nt, seg; };
struct Gemm { int lda, ldb; };

__device__ __forceinline__ bool tile_of(long L, int nM, int nN, int& pm, int& pn) {
    const int nwg = nM * nN; if (L >= nwg) return false;
    int wgid = (int)L; { const int q = nwg / NXCD, r = nwg % NXCD, xcd = wgid % NXCD, off = wgid / NXCD; wgid = (xcd < r ? xcd * (q + 1) : r * (q + 1) + (xcd - r) * q) + off; }
    const int nig = WGM * nN, gid = wgid / nig, fm = gid * WGM, gsz = (nM - fm) < WGM ? (nM - fm) : WGM;
    pm = fm + ((wgid % nig) % gsz); pn = (wgid % nig) / gsz; return true;
}

struct EpiBf {
    static constexpr bool PERM = true;
    int act;
    __device__ __forceinline__ bool operator()(f32x4 (&acc)[2][2][4][2], const Unit& u, int wr, int wc, int fr, int fq) const {
        const int ldc = (u.seg & 12) ? YN : 4096;
        bf16_t* base = (bf16_t*)u.dst + (size_t)(wr * 64 + fr) * ldc + wc * 32 + 8 * fq;
        const float sc = (u.seg & 4) ? 0.001381067932004975f   : ((u.seg & 8) ? 1.f / 256.f : 1.f);
#pragma unroll
        for (int ai = 0; ai < 2; ++ai)
#pragma unroll
            for (int m = 0; m < 4; ++m) { bf16_t* rowp = base + (size_t)(ai * HALF + m * 16) * ldc;
#pragma unroll
                for (int bj = 0; bj < 2; ++bj) { f32x4 v0 = acc[ai][bj][m][0], v1 = acc[ai][bj][m][1];
                    if (u.seg == 2) {
                        unsigned p0 = 0u, p1 = 0u;
#pragma unroll
                        for (int e = 0; e < 4; ++e) {
                            const float s0 = fmaxf(__builtin_amdgcn_rcpf(__builtin_amdgcn_exp2f(v0[e] * -1.4426950408889634f) * (1.0f / 255.0f) + (1.0f / 255.0f)), 1.0f);
                            const float s1 = fmaxf(__builtin_amdgcn_rcpf(__builtin_amdgcn_exp2f(v1[e] * -1.4426950408889634f) * (1.0f / 255.0f) + (1.0f / 255.0f)), 1.0f);
                            p0 = __builtin_amdgcn_cvt_pk_u8_f32(s0, e, p0); p1 = __builtin_amdgcn_cvt_pk_u8_f32(s1, e, p1); }
                        u32x2 wg; wg.x = p0; wg.y = p1;
                        *(u32x2*)(u.dst + (size_t)(wr * 64 + fr + ai * HALF + m * 16) * (ZN * 2) + wc * 32 + 8 * fq + bj * HALF) = wg;
                        continue; }
                    if (act == 1) {
#pragma unroll
                        for (int e = 0; e < 4; ++e) { const float a = fmaxf(v0[e], 0.f), b = fmaxf(v1[e], 0.f); v0[e] = a * a; v1[e] = b * b; } }
                    v0 = v0 * sc; v1 = v1 * sc;
                    u32x4 w; w.x = cvt_pk_bf16(v0[0], v0[1]); w.y = cvt_pk_bf16(v0[2], v0[3]); w.z = cvt_pk_bf16(v1[0], v1[1]); w.w = cvt_pk_bf16(v1[2], v1[3]);
                    *(u32x4*)(rowp + bj * HALF) = w; } }
        return true;
    }
};
struct EpiRes {
    static constexpr bool PERM = false;
    __device__ __forceinline__ bool operator()(f32x4 (&acc)[2][2][4][2], const Unit& u, int wr, int wc, int fr, int fq) const {
        const float* gv = (const float*)u.x1 + wc * 32 + 4 * fq;
        f32x4 g[2][2];
#pragma unroll
        for (int bj = 0; bj < 2; ++bj)
#pragma unroll
            for (int n = 0; n < 2; ++n) g[bj][n] = *(const f32x4*)(gv + bj * HALF + n * 16);
        const size_t o0 = (size_t)(wr * 64 + fr) * DM + wc * 32 + 4 * fq;
        const float* bs = (const float*)u.x0 + o0; float* od = (float*)u.dst + o0;
        f32x4 bc[2][2];
#pragma unroll
        for (int bj = 0; bj < 2; ++bj)
#pragma unroll
            for (int n = 0; n < 2; ++n) bc[bj][n] = *(const f32x4*)(bs + bj * HALF + n * 16);
#pragma unroll
        for (int am = 0; am < 8; ++am) { const int ai = am >> 2, m = am & 3; const size_t off = (size_t)(ai * HALF + m * 16) * DM;
            f32x4 bn[2][2];
            if (am < 7) { const size_t offn = (size_t)(((am + 1) >> 2) * HALF + ((am + 1) & 3) * 16) * DM;
#pragma unroll
                for (int bj = 0; bj < 2; ++bj)
#pragma unroll
                    for (int n = 0; n < 2; ++n) bn[bj][n] = *(const f32x4*)(bs + offn + bj * HALF + n * 16); }
#pragma unroll
            for (int bj = 0; bj < 2; ++bj)
#pragma unroll
                for (int n = 0; n < 2; ++n) *(f32x4*)(od + off + bj * HALF + n * 16) = bc[bj][n] + g[bj][n] * acc[ai][bj][m][n];
            if (am < 7) {
#pragma unroll
                for (int bj = 0; bj < 2; ++bj)
#pragma unroll
                    for (int n = 0; n < 2; ++n) bc[bj][n] = bn[bj][n]; }
        }
        return true;
    }
};
struct EpiMerge {
    static constexpr bool PERM = true;
    __device__ __forceinline__ void apply(const bool LAST, f32x4 (&acc)[2][2][4][2], const Unit& u, int wr, int wc, int fr, int fq) const {
        const unsigned char* g0 = (const unsigned char*)u.x0 + (size_t)(wr * 64 + fr) * (ZN * 2) + wc * 32 + 8 * fq;
        bf16_t* base = (bf16_t*)u.dst + (size_t)(wr * 64 + fr) * DM + wc * 32 + 8 * fq;
        const int gboff = LAST ? 0 : DM;
        u32x2 ga[2][2][2], gb[2][2][2];
#pragma unroll
        for (int mm = 0; mm < 2; ++mm)
#pragma unroll
            for (int bj = 0; bj < 2; ++bj) { const unsigned char* rp = g0 + (size_t)(mm * 16) * (ZN * 2) + bj * HALF; ga[0][mm][bj] = *(const u32x2*)rp; gb[0][mm][bj] = *(const u32x2*)(rp + gboff); }
#pragma unroll
        for (int am = 0; am < 4; ++am) { const int ai = am >> 1, m0 = (am & 1) * 2, cb_ = am & 1, nb_ = cb_ ^ 1;
            if (am < 3) { const int ai2 = (am + 1) >> 1, m02 = ((am + 1) & 1) * 2;
#pragma unroll
                for (int mm = 0; mm < 2; ++mm)
#pragma unroll
                    for (int bj = 0; bj < 2; ++bj) { const unsigned char* rp = g0 + (size_t)(ai2 * HALF + (m02 + mm) * 16) * (ZN * 2) + bj * HALF; ga[nb_][mm][bj] = *(const u32x2*)rp; gb[nb_][mm][bj] = *(const u32x2*)(rp + gboff); } }
            asm volatile("" ::: "memory");
#pragma unroll
            for (int mm = 0; mm < 2; ++mm)
#pragma unroll
                for (int bj = 0; bj < 2; ++bj) { const int m = m0 + mm;
                    f32x4 v0 = acc[ai][bj][m][0], v1 = acc[ai][bj][m][1];
#pragma unroll
                    for (int h2 = 0; h2 < 2; ++h2) { const unsigned wa = ga[cb_][mm][bj][h2], wb = gb[cb_][mm][bj][h2];
#pragma unroll
                        for (int e = 0; e < 4; ++e) { const float sa = (float)((wa >> (8 * e)) & 0xffu), sb = (float)((wb >> (8 * e)) & 0xffu);
                            const float f = LAST ? sa * (1.0f / 255.0f) : sa * __builtin_amdgcn_rcpf(sb);
                            if (h2 == 0) v0[e] *= f; else v1[e] *= f; } }
                    acc[ai][bj][m][0] = v0; acc[ai][bj][m][1] = v1;
                    if (LAST) { u32x4 w; w.x = cvt_pk_bf16(v0[0], v0[1]); w.y = cvt_pk_bf16(v0[2], v0[3]); w.z = cvt_pk_bf16(v1[0], v1[1]); w.w = cvt_pk_bf16(v1[2], v1[3]);
                        *(u32x4*)(base + (size_t)(ai * HALF + m * 16) * DM + bj * HALF) = w; }
                }
        }
    }
    __device__ __forceinline__ bool operator()(f32x4 (&acc)[2][2][4][2], const Unit& u, int wr, int wc, int fr, int fq) const {
        const bool last = (u.seg == 3); apply(last, acc, u, wr, wc, fr, fq); return last;
    }
};

template <class Epi, class Sched>
__device__ __forceinline__ void gemm_phase(LAS unsigned char* lds, const Gemm g, const Sched& S, const Epi& E, const int tid) {
    const int wid = __builtin_amdgcn_readfirstlane(tid >> 6), lane = tid & 63, wr = wid >> 2, wc = wid & 3, fr = lane & 15, fq = lane >> 4;
    unsigned voffA[2], voffB[2];
#pragma unroll
    for (int i = 0; i < 2; ++i) { int R, C; stage_rc(tid * 16 + i * 8192, R, C); const int Rb = Epi::PERM ? ((R & ~31) + perm32(R & 31)) : R;
        voffA[i] = (unsigned)(R * g.lda + C) * 2u; voffB[i] = (unsigned)(Rb * g.ldb + C) * 2u; }
    const size_t kstep = (size_t)(BK * 2);
    const size_t hstepA = (size_t)HALF * g.lda * 2, hstepB = (size_t)HALF * g.ldb * 2;
    const unsigned ldsw = (unsigned)wid * 1024u;
    const int aoff = lds_byte(wr * 64 + fr, fq * 8), boff = lds_byte(wc * 32 + fr, fq * 8);
#define PG8_SA(b, h) (((b) * 2 + (h)) * HTB)
#define PG8_SB(b, h) ((4 + (b) * 2 + (h)) * HTB)
#define PG8_STAGE(bufoff, gbase, voff) do { _Pragma("unroll") for (int _i = 0; _i < 2; ++_i) \
        __builtin_amdgcn_global_load_lds((const unsigned*)((const char*)(gbase) + (voff)[_i]), (LAS unsigned*)(lds + (bufoff) + ldsw + _i * 8192), 16, 0, 0); } while (0)
#define PG8_LDA(dst, b, h) do { _Pragma("unroll") for (int m = 0; m < 4; ++m) _Pragma("unroll") for (int k = 0; k < 2; ++k) dst[m][k] = *(const LAS bf16x8*)(lds + PG8_SA(b, h) + aoff + m * 2048 + k * 1024); } while (0)
#define PG8_LDB(dst, b, h) do { _Pragma("unroll") for (int n = 0; n < 2; ++n) _Pragma("unroll") for (int k = 0; k < 2; ++k) dst[n][k] = *(const LAS bf16x8*)(lds + PG8_SB(b, h) + boff + n * 2048 + k * 1024); } while (0)
#define PG8_MMA(ai, bj, At, Bt) do { __builtin_amdgcn_s_setprio(1); _Pragma("unroll") for (int m = 0; m < 4; ++m) _Pragma("unroll") for (int n = 0; n < 2; ++n) _Pragma("unroll") for (int k = 0; k < 2; ++k) \
        acc[ai][bj][m][n] = __builtin_amdgcn_mfma_f32_16x16x32_bf16(Bt[n][k], At[m][k], acc[ai][bj][m][n], 0, 0, 0); __builtin_amdgcn_s_setprio(0); } while (0)
#define PG8_WAIT_V(n) asm volatile("s_waitcnt vmcnt(" #n ")" ::: "memory")
#define PG8_WAIT_L(n) asm volatile("s_waitcnt lgkmcnt(" #n ")" ::: "memory")
#define PG8_BAR __builtin_amdgcn_s_barrier()
#define PG8_SCHED __builtin_amdgcn_sched_barrier(0)
    Unit cur, nxt; int ui = 0;
    if (!S.next(0, cur)) return;
    f32x4 acc[2][2][4][2];
#pragma unroll
    for (int a = 0; a < 2; ++a)
#pragma unroll
        for (int b = 0; b < 2; ++b)
#pragma unroll
            for (int m = 0; m < 4; ++m)
#pragma unroll
                for (int n = 0; n < 2; ++n) acc[a][b][m][n] = (f32x4){0.f, 0.f, 0.f, 0.f};
    bf16x8 At[4][2], B0[2][2], B1[2][2];
    const char* cA = cur.a; const char* cB = cur.b;
    PG8_STAGE(PG8_SB(0, 0), cB, voffB); PG8_STAGE(PG8_SB(0, 1), cB + hstepB, voffB); PG8_STAGE(PG8_SA(0, 0), cA, voffA); PG8_STAGE(PG8_SA(0, 1), cA + hstepA, voffA);
    if (wr == 1) PG8_BAR;
    PG8_WAIT_V(2); PG8_BAR;
    PG8_STAGE(PG8_SB(1, 0), cB + kstep, voffB); PG8_STAGE(PG8_SA(1, 0), cA + kstep, voffA); PG8_STAGE(PG8_SB(1, 1), cB + hstepB + kstep, voffB);
    PG8_WAIT_V(6); PG8_BAR;
    for (;;) {
        const bool has_next = S.next(ui + 1, nxt);
        const char* nA = has_next ? nxt.a : cA; const char* nB = has_next ? nxt.b : cB;
        const int nt = cur.nt;
        for (int t = 0; t < nt; t += 2) {
            const bool last = (t == nt - 2);
            const char* a1 = cA + (size_t)(t + 1) * kstep;
            const char* a2 = last ? nA : cA + (size_t)(t + 2) * kstep; const char* b2 = last ? nB : cB + (size_t)(t + 2) * kstep;
            const char* a3 = a2 + kstep; const char* b3 = b2 + kstep;
            PG8_LDB(B0, 0, 0); PG8_LDB(B1, 0, 1); PG8_SCHED; PG8_LDA(At, 0, 0); PG8_STAGE(PG8_SA(1, 1), a1 + hstepA, voffA);
            PG8_WAIT_V(8); PG8_WAIT_L(0); PG8_BAR; PG8_MMA(0, 0, At, B0); PG8_MMA(0, 1, At, B1); PG8_BAR; PG8_SCHED;
            PG8_LDA(At, 0, 1); PG8_STAGE(PG8_SB(0, 0), b2, voffB); PG8_STAGE(PG8_SB(0, 1), b2 + hstepB, voffB); PG8_STAGE(PG8_SA(0, 0), a2, voffA);
            PG8_WAIT_V(8); PG8_WAIT_L(0); PG8_BAR; PG8_MMA(1, 0, At, B0); PG8_MMA(1, 1, At, B1); PG8_BAR; PG8_SCHED;
            PG8_LDB(B0, 1, 0); PG8_LDB(B1, 1, 1); PG8_SCHED; PG8_LDA(At, 1, 0); PG8_STAGE(PG8_SA(0, 1), a2 + hstepA, voffA);
            PG8_WAIT_V(8); PG8_WAIT_L(0); PG8_BAR; PG8_MMA(0, 0, At, B0); PG8_MMA(0, 1, At, B1); PG8_BAR; PG8_SCHED;
            PG8_LDA(At, 1, 1); PG8_STAGE(PG8_SB(1, 0), b3, voffB); PG8_STAGE(PG8_SB(1, 1), b3 + hstepB, voffB); PG8_STAGE(PG8_SA(1, 0), a3, voffA);
            PG8_WAIT_V(8); PG8_WAIT_L(0); PG8_BAR; PG8_MMA(1, 0, At, B0); PG8_MMA(1, 1, At, B1); PG8_BAR; PG8_SCHED;
        }
        if (wr == 0) PG8_BAR;
        const bool zero = E(acc, cur, wr, wc, fr, fq);
        if (!has_next) break;
        if (zero) {
#pragma unroll
            for (int a = 0; a < 2; ++a)
#pragma unroll
                for (int b = 0; b < 2; ++b)
#pragma unroll
                    for (int m = 0; m < 4; ++m)
#pragma unroll
                        for (int n = 0; n < 2; ++n) acc[a][b][m][n] = (f32x4){0.f, 0.f, 0.f, 0.f};
        }
        cur = nxt; cA = nA; cB = nB; ++ui;
        if (wr == 1) PG8_BAR;
    }
    PG8_WAIT_V(0);
    PG8_BAR;
#undef PG8_SA
#undef PG8_SB
#undef PG8_STAGE
#undef PG8_LDA
#undef PG8_LDB
#undef PG8_MMA
#undef PG8_WAIT_V
#undef PG8_WAIT_L
#undef PG8_BAR
#undef PG8_SCHED
}
}

struct Args { const float* in[27]; float* out; unsigned char* ws; int ph_lo, ph_hi; };
typedef const __attribute__((address_space(4))) Args* ArgP;
enum { I_X = 0, I_C, I_CTX, I_CCTX, I_WMOD, I_BMOD, I_G1, I_G2, I_WIN, I_CONVW, I_CONVB, I_WA, I_BA, I_WX, I_BX, I_LAM, I_POOLW, I_POOLS, I_SCW,
       I_BRL, I_BRF, I_BRP, I_BRS, I_WOUT, I_FF1, I_FF2, I_GF };

struct Sched {
    int kind, l, ch, G, c;
    ArgP ap;
    __device__ __forceinline__ bool next(int i, pg8::Unit& u) const {
        unsigned char* ws = ap->ws;
        const long L = (long)i * G + c;
        const int nM = (l == 0) ? RT / 256 : RL / 256;
        u.x0 = nullptr; u.x1 = nullptr; u.seg = 0;
        int pm, pn;
        if (kind == 1) {
            const char* U = (const char*)(ws + WS_U);
            const int nZ = nM * 24;
            long L2 = L - nZ; bool isz = false;
            if (L < nZ) { pg8::tile_of(L, nM, 24, pm, pn); isz = true; }
            else if (l == 1) { if (L2 < 32) { pm = 128 + (int)(L2 >> 1); pn = (int)(L2 & 1); isz = true; } else L2 -= 32; }
            if (isz) {
                u.a = U + (size_t)pm * 256 * DM * 2; u.b = (const char*)(ws + WS_WIN) + ((size_t)l * WN + (size_t)pn * 256) * DM * 2; u.nt = 16;
                u.dst = (char*)(ws + WS_Z) + (size_t)pm * 256 * ZN * 2 + (pn < 8 ? (size_t)pn * 512 : (size_t)4096 + (size_t)(pn - 8) * 256); u.seg = (pn >= 8) ? 2 : 0; return true;
            }
            if (L2 >= 2 * nM) return false;
            const int seg = (int)(L2 & 1), tt = (int)(L2 >> 1);
            u.a = (const char*)(ws + WS_WF) + ((size_t)l * 512 + (size_t)seg * 256) * DM * 2; u.b = U + (size_t)tt * 256 * DM * 2; u.nt = 16;
            if (tt < 128) u.dst = (char*)(ws + WS_PT) + ((size_t)(tt >> 3) * 256 * 4096 + (size_t)seg * 2048 + (size_t)(tt & 7) * 256) * 2;
            else u.dst = (char*)(ws + WS_PTC) + ((size_t)(tt - 128) * 256 * 4096 + (size_t)seg * 256) * 2;
            return true;
        }
        if (kind == 7) {
            if (!pg8::tile_of(L, nM, 16, pm, pn)) return false;
            u.a = (const char*)(ws + WS_U) + (size_t)pm * 256 * DM * 2; u.b = (const char*)(ws + WS_W1) + ((size_t)l * DFF + (size_t)pn * 256) * DM * 2; u.nt = 16;
            u.dst = (char*)(ws + WS_Z) + ((size_t)pm * 256 * DFF + (size_t)pn * 256) * 2; return true;
        }
        if (kind == 2) {
            if (L < 128) { const int b_ = (int)(L >> 3), kt = (int)(L & 7);
                u.a = (const char*)(ws + WS_DFT) + (size_t)kt * 256 * 4096 * 2; u.b = (const char*)(ws + WS_PT) + (size_t)b_ * 256 * 4096 * 2; u.nt = 64;
                u.dst = (char*)(ws + WS_Y) + ((size_t)(b_ * SEQ + kt * 256) * YN + Y_F) * 2; u.seg = 4; return true; }
            if (l == 0 && L < 144) { const int j = (int)L - 128;
                u.a = (const char*)(ws + WS_DFTC); u.b = (const char*)(ws + WS_PTC) + (size_t)j * 256 * 4096 * 2; u.nt = 8;
                u.dst = (char*)(ws + WS_Y) + ((size_t)(RL + j * 256) * YN + Y_F) * 2; u.seg = 8; return true; }
            return false;
        }
        if (kind == 4) {
            const int seg = i & 3; const long T = (long)(i >> 2) * G + c;
            if (!pg8::tile_of(T, nM, 4, pm, pn)) return false;
            const int coff = seg == 0 ? 0 : (256 + 256 * seg);
            u.a = (const char*)(ws + WS_Y) + ((size_t)pm * 256 * YN + coff) * 2; u.b = (const char*)(ws + WS_WBR) + (((size_t)l * DM + (size_t)pn * 256) * YN + coff) * 2;
            u.nt = seg == 0 ? 8 : 4; u.seg = seg;
            u.dst = (char*)(ws + WS_MRG) + ((size_t)pm * 256 * DM + (size_t)pn * 256) * 2;
            u.x0 = (const char*)(ws + WS_Z) + (size_t)pm * 256 * ZN * 2 + 4096 + seg * DM + pn * 256;
            return true;
        }
        if (!pg8::tile_of(L, nM, 4, pm, pn)) return false;
        if (kind == 5) { u.a = (const char*)(ws + WS_MRG) + (size_t)pm * 256 * DM * 2; u.b = (const char*)(ws + WS_WOUT) + ((size_t)l * DM + (size_t)pn * 256) * DM * 2; u.nt = 16; }
        else { u.a = (const char*)(ws + WS_Z) + (size_t)pm * 256 * DFF * 2; u.b = (const char*)(ws + WS_W2) + ((size_t)l * DM + (size_t)pn * 256) * DFF * 2; u.nt = 64; }
        int bidx; size_t eoff;
        if (pm < 128) { eoff = ((size_t)(ch * RL + pm * 256) * DM + pn * 256) * 4; bidx = ch * NB + (pm >> 3);
            char* out = (char*)ap->out; u.dst = out + eoff; u.x0 = (kind == 5 && l == 0) ? (const char*)ap->in[I_X] + eoff : (const char*)out + eoff; }
        else { eoff = ((size_t)(ch * RC + (pm - 128) * 256) * DM + pn * 256) * 4; bidx = 32;
            u.dst = (char*)(ws + WS_CTXW) + eoff; u.x0 = (kind == 5) ? (const char*)ap->in[I_CTX] + eoff : (const char*)(ws + WS_CTXW) + eoff; }
        u.x1 = (const char*)(ws + WS_MOD) + ((size_t)((l * 33 + bidx) * 6 + (kind == 5 ? 2 : 5)) * DM + pn * 256) * 4;
        return true;
    }
};

__device__ __forceinline__ void tr_item(const float* W, int ldw, int col0, int ncols, bf16_t* WT, int ldt, int koff, LAS float* scr, int item, int lane) {
    const int nblk = ncols / 32, kb = item / nblk, nb = item % nblk, k0 = 64 * kb, n0 = 32 * nb;
#pragma unroll 8
    for (int i = 0; i < 32; ++i) { const int kk = 2 * i + (lane >> 5); scr[kk * 33 + (lane & 31)] = W[(size_t)(k0 + kk) * ldw + col0 + n0 + (lane & 31)]; }
    LDS_WAIT(); asm volatile("" ::: "memory");
    const int c = lane & 7;
#pragma unroll
    for (int j = 0; j < 4; ++j) { const int n = (lane >> 3) + 8 * j; const LAS float* s = scr + (8 * c) * 33 + n;
        u32x4 o; o.x = cvt_pk_bf16(s[0 * 33], s[1 * 33]); o.y = cvt_pk_bf16(s[2 * 33], s[3 * 33]); o.z = cvt_pk_bf16(s[4 * 33], s[5 * 33]); o.w = cvt_pk_bf16(s[6 * 33], s[7 * 33]);
        *(u32x4*)(WT + (size_t)(n0 + n) * ldt + koff + k0 + 8 * c) = o; }
    LDS_WAIT(); asm volatile("" ::: "memory");
}

__device__ __forceinline__ void p0_prologue(ArgP A, LAS unsigned char* lds, int G, const int tid) {
    const int lane = tid & 63, wave = tid >> 6, bx = blockIdx.x;
    unsigned char* ws = A->ws;
    if (bx < 192) {
        const int l = bx / 96, cb = bx % 96, n = cb * 64 + lane;
        LAS float* sl = (LAS float*)lds;
        for (int idx = tid; idx < 33 * 1024; idx += 512) { const int bb = idx >> 10, k = idx & 1023; const float v = bb < 32 ? A->in[I_C][bb * 1024 + k] : A->in[I_CCTX][k]; sl[idx] = v * sigm(v); }
        __syncthreads();
        float acc[33];
#pragma unroll
        for (int bb = 0; bb < 33; ++bb) acc[bb] = 0.f;
        const float* wp = A->in[I_WMOD] + ((size_t)l * 1024 + wave * 128) * 6144 + n;
        for (int k4 = 0; k4 < 32; ++k4) {
            const float w0 = wp[(size_t)(4 * k4 + 0) * 6144], w1 = wp[(size_t)(4 * k4 + 1) * 6144], w2 = wp[(size_t)(4 * k4 + 2) * 6144], w3 = wp[(size_t)(4 * k4 + 3) * 6144];
#pragma unroll
            for (int bb = 0; bb < 33; ++bb) { const f32x4 s = *(const LAS f32x4*)(sl + bb * 1024 + wave * 128 + 4 * k4); acc[bb] += s[0] * w0 + s[1] * w1 + s[2] * w2 + s[3] * w3; }
        }
        __syncthreads();
        LAS float* red = (LAS float*)lds;
#pragma unroll
        for (int bb = 0; bb < 33; ++bb) red[(wave * 33 + bb) * 64 + lane] = acc[bb];
        __syncthreads();
        float* MOD = (float*)(ws + WS_MOD);
        for (int idx = tid; idx < 33 * 64; idx += 512) { const int bb = idx >> 6, ln = idx & 63; float s = A->in[I_BMOD][l * 6144 + cb * 64 + ln];
#pragma unroll
            for (int w = 0; w < 8; ++w) s += red[(w * 33 + bb) * 64 + ln];
            MOD[(size_t)(l * 33 + bb) * 6144 + cb * 64 + ln] = s; }
        __syncthreads();
    } else if (bx < 224) {
        const int it = bx - 192, l = it >> 4, k0 = (it & 15) * 64;
        LAS float* wt = (LAS float*)lds;
        LAS float* tab = (LAS float*)(lds + 65536);
        for (int idx = tid; idx < 64 * 256; idx += 512) { const int kk = idx >> 8, c = idx & 255; wt[idx] = A->in[I_WIN][((size_t)l * 1024 + k0 + kk) * NIN + 1024 + c]; }
        { const int i = tid & 255; tab[tid] = (tid < 256) ? cospif((float)i / 128.f) : sinpif((float)i / 128.f); }
        __syncthreads();
        const int m = tid & 255; const LAS float* tb = tab + (tid >> 8) * 256;
        bf16_t* WF = (bf16_t*)(ws + WS_WF) + ((size_t)l * 512 + tid) * DM + k0;
        for (int kg = 0; kg < 8; ++kg) {
            float a[8];
#pragma unroll
            for (int q = 0; q < 8; ++q) a[q] = 0.f;
            for (int c = 0; c < 256; ++c) { const float tv = tb[(m * c) & 255];
#pragma unroll
                for (int q = 0; q < 8; ++q) a[q] += wt[(kg * 8 + q) * 256 + c] * tv; }
            u32x4 o; o.x = cvt_pk_bf16(a[0], a[1]); o.y = cvt_pk_bf16(a[2], a[3]); o.z = cvt_pk_bf16(a[4], a[5]); o.w = cvt_pk_bf16(a[6], a[7]);
            *(u32x4*)(WF + kg * 8) = o;
        }
        __syncthreads();
    }
    {
        LAS float* scr = (LAS float*)(lds + wave * 16384);
        const int gw = wave * G + bx, NGW = G * 8;
        for (int it = gw; it < 16384; it += NGW) {
            const int l = it >> 13; int r = it & 8191;
            const float* win = A->in[I_WIN] + (size_t)l * 1024 * NIN;
            bf16_t* WIN = (bf16_t*)(ws + WS_WIN) + (size_t)l * WN * DM;
            bf16_t* WBR = (bf16_t*)(ws + WS_WBR) + (size_t)l * DM * YN;
            if (r < 512) { tr_item(win, NIN, 0, 1024, WIN, DM, 0, scr, r, lane); continue; } r -= 512;
            if (r < 2560) { tr_item(win, NIN, 1280, 5120, WIN + (size_t)1024 * DM, DM, 0, scr, r, lane); continue; } r -= 2560;
            if (r < 256) { tr_item(A->in[I_BRL] + (size_t)l * 512 * DM, DM, 0, DM, WBR, YN, 0, scr, r, lane); continue; } r -= 256;
            if (r < 128) { tr_item(A->in[I_BRF] + (size_t)l * 256 * DM, DM, 0, DM, WBR, YN, Y_F, scr, r, lane); continue; } r -= 128;
            if (r < 128) { tr_item(A->in[I_BRS] + (size_t)l * 256 * DM, DM, 0, DM, WBR, YN, Y_SC, scr, r, lane); continue; } r -= 128;
            if (r < 512) { tr_item(A->in[I_WOUT] + (size_t)l * DM * DM, DM, 0, DM, (bf16_t*)(ws + WS_WOUT) + (size_t)l * DM * DM, DM, 0, scr, r, lane); continue; } r -= 512;
            if (r < 2048) { tr_item(A->in[I_FF1] + (size_t)l * DM * DFF, DFF, 0, DFF, (bf16_t*)(ws + WS_W1) + (size_t)l * DFF * DM, DM, 0, scr, r, lane); continue; } r -= 2048;
            tr_item(A->in[I_FF2] + (size_t)l * DFF * DM, DM, 0, DM, (bf16_t*)(ws + WS_W2) + (size_t)l * DM * DFF, DFF, 0, scr, r, lane);
        }
    }
    const int gt = bx * 512 + tid, NGT = G * 512;
    {
        bf16_t* WG = (bf16_t*)(ws + WS_WG);
        for (int idx = gt; idx < 2 * 8 * 256 * 64; idx += NGT) { const int i = idx & 63, n = (idx >> 6) & 255, h = (idx >> 14) & 7, l = idx >> 17, d = n >> 7, gate = (n >> 6) & 1, j = n & 63;
            const float v = (gate ? A->in[I_WX] : A->in[I_WA])[((size_t)((l * 2 + d) * 8 + h) * 64 + i) * 64 + j];
            WG[idx] = (bf16_t)(cvt_pk_bf16(v, 0.f) & 0xffffu); }
    }
    {
        for (int idx = gt; idx < 2 * 256 * 1024; idx += NGT) { const int n = idx & 1023, i = (idx >> 10) & 255, l = idx >> 18, g = i >> 6, il = i & 63;
            const float* pw = A->in[I_POOLW] + ((size_t)(l * 4 + g) * 64 + il) * 64; const float* ps = A->in[I_POOLS] + l * 256 + g * 64; const float* wb = A->in[I_BRP] + ((size_t)l * 256 + g * 64) * DM + n;
            float s = 0.f;
            for (int j = 0; j < 64; ++j) s += pw[j] * ps[j] * wb[(size_t)j * DM];
            ((bf16_t*)(ws + WS_WBR))[((size_t)l * DM + n) * YN + Y_POOL + i] = (bf16_t)(cvt_pk_bf16(s, 0.f) & 0xffffu); }
    }
    {
        bf16_t* DF = (bf16_t*)(ws + WS_DFT);
        for (int idx = gt; idx < 2048 * 512; idx += NGT) { const int k = idx >> 9, n8 = (idx & 511) * 8; float v[8];
#pragma unroll
            for (int e = 0; e < 8; ++e) { const int np = n8 + e; if (np < 2048) v[e] = cospif((float)((k * np) & 2047) * (1.f / 1024.f)); else v[e] = -sinpif((float)((k * (np - 2048)) & 2047) * (1.f / 1024.f)); }
            u32x4 o; o.x = cvt_pk_bf16(v[0], v[1]); o.y = cvt_pk_bf16(v[2], v[3]); o.z = cvt_pk_bf16(v[4], v[5]); o.w = cvt_pk_bf16(v[6], v[7]);
            *(u32x4*)(DF + (size_t)k * 4096 + n8) = o; }
        bf16_t* DC = (bf16_t*)(ws + WS_DFTC);
        for (int idx = gt; idx < 256 * 64; idx += NGT) { const int k = idx >> 6, n8 = (idx & 63) * 8; float v[8];
#pragma unroll
            for (int e = 0; e < 8; ++e) { const int np = n8 + e; if (np < 256) v[e] = cospif((float)((k * np) & 255) * (1.f / 128.f)); else v[e] = -sinpif((float)((k * (np - 256)) & 255) * (1.f / 128.f)); }
            u32x4 o; o.x = cvt_pk_bf16(v[0], v[1]); o.y = cvt_pk_bf16(v[2], v[3]); o.z = cvt_pk_bf16(v[4], v[5]); o.w = cvt_pk_bf16(v[6], v[7]);
            *(u32x4*)(DC + (size_t)k * 4096 + n8) = o; }
    }
}

__device__ __forceinline__ void norm_phase(ArgP A, int l, int ch, bool second, int r_begin, int r_end, int r_step, const int tid) {
    const int lane = tid & 63, wave = tid >> 6;
    unsigned char* ws = A->ws;
    const int nrows = (second && l == 1) ? RL : RT, rend = r_end < nrows ? r_end : nrows;
    const float* gn = (second ? A->in[I_G2] : A->in[I_G1]) + l * DM;
    const float* MOD = (const float*)(ws + WS_MOD);
    bf16_t* U = (bf16_t*)(ws + WS_U);
    for (int r0 = r_begin + wave; r0 < rend; r0 += 2 * r_step) {
        const float* src[2]; const float* sh[2]; int rr[2]; bool ok[2];
#pragma unroll
        for (int q = 0; q < 2; ++q) { const int rq = r0 + q * r_step; ok[q] = rq < rend; const int r = ok[q] ? rq : r0; rr[q] = r; int bidx;
            if (r < RL) { const size_t grow = (size_t)ch * RL + r; src[q] = ((!second && l == 0) ? A->in[I_X] : (const float*)A->out) + grow * DM; bidx = ch * NB + (r >> 11); }
            else { const size_t grow = (size_t)ch * RC + (r - RL); src[q] = ((!second && l == 0) ? A->in[I_CTX] : (const float*)(ws + WS_CTXW)) + grow * DM; bidx = 32; }
            sh[q] = MOD + (size_t)((l * 33 + bidx) * 6 + (second ? 3 : 0)) * DM; }
        f32x4 v[2][4]; float s[2] = {0.f, 0.f};
#pragma unroll
        for (int q = 0; q < 2; ++q)
#pragma unroll
            for (int j = 0; j < 4; ++j) v[q][j] = *(const f32x4*)(src[q] + 4 * (lane + 64 * j));
#pragma unroll
        for (int q = 0; q < 2; ++q) {
#pragma unroll
            for (int j = 0; j < 4; ++j) s[q] += (v[q][j][0] * v[q][j][0] + v[q][j][1] * v[q][j][1]) + (v[q][j][2] * v[q][j][2] + v[q][j][3] * v[q][j][3]);
            s[q] = 1.0f / sqrtf(wave_sum(s[q]) * (1.f / DM) + 1e-6f); }
#pragma unroll
        for (int q = 0; q < 2; ++q) { if (!ok[q]) continue;
#pragma unroll
            for (int j = 0; j < 4; ++j) { const int col = 4 * (lane + 64 * j);
                const f32x4 gg = *(const f32x4*)(gn + col), s1 = *(const f32x4*)(sh[q] + DM + col), s0 = *(const f32x4*)(sh[q] + col);
                const f32x4 o = (v[q][j] * s[q]) * gg * (s1 + 1.0f) + s0;
                u32x2 w; w.x = cvt_pk_bf16(o[0], o[1]); w.y = cvt_pk_bf16(o[2], o[3]);
                *(u32x2*)(U + (size_t)rr[q] * DM + col) = w; } }
    }
}
__device__ __forceinline__ void final_norm(ArgP A, int G, const int tid) {
    const int lane = tid & 63, wave = tid >> 6;
    const float* gn = A->in[I_GF];
    for (int r0 = blockIdx.x * 8 + wave; r0 < NBATCH * SEQ; r0 += 2 * G * 8) {
        float* p[2]; f32x4 v[2][4]; float s[2] = {0.f, 0.f};
#pragma unroll
        for (int q = 0; q < 2; ++q) { int r = r0 + q * G * 8; if (r >= NBATCH * SEQ) r = r0; p[q] = A->out + (size_t)r * DM;
#pragma unroll
            for (int j = 0; j < 4; ++j) v[q][j] = *(const f32x4*)(p[q] + 4 * (lane + 64 * j)); }
#pragma unroll
        for (int q = 0; q < 2; ++q) {
#pragma unroll
            for (int j = 0; j < 4; ++j) s[q] += (v[q][j][0] * v[q][j][0] + v[q][j][1] * v[q][j][1]) + (v[q][j][2] * v[q][j][2] + v[q][j][3] * v[q][j][3]);
            s[q] = 1.0f / sqrtf(wave_sum(s[q]) * (1.f / DM) + 1e-6f); }
#pragma unroll
        for (int q = 0; q < 2; ++q)
#pragma unroll
            for (int j = 0; j < 4; ++j) { const int col = 4 * (lane + 64 * j); const f32x4 gg = *(const f32x4*)(gn + col); *(f32x4*)(p[q] + col) = (v[q][j] * s[q]) * gg; }
    }
}

__device__ __forceinline__ void unpack8(const u32x4 w, float (&f)[8]) {
#pragma unroll
    for (int e = 0; e < 4; ++e) { f[2 * e] = bf_lo(w[e]); f[2 * e + 1] = bf_hi(w[e]); }
}
__device__ __forceinline__ u32x4 pack8(const float (&f)[8]) { u32x4 o; o.x = cvt_pk_bf16(f[0], f[1]); o.y = cvt_pk_bf16(f[2], f[3]); o.z = cvt_pk_bf16(f[4], f[5]); o.w = cvt_pk_bf16(f[6], f[7]); return o; }

__device__ __forceinline__ void lru_item(ArgP A, int l, int it, bool pass2, LAS unsigned char* lds, const int tid) {
    const int lane = tid & 63, wid = tid >> 6;
    unsigned char* ws = A->ws;
    const int head = it & 7, rest = it >> 3;
    int sc, bl;
    if (!pass2 || l == 0) { sc = rest % NSC; bl = rest / NSC; } else { sc = 4 + (rest & 31); bl = rest >> 5; }
    const bool isctx = sc < 4; const int c = isctx ? sc : sc - 4, Lseq = isctx ? CTXL : SEQ, rowbase = isctx ? RL + bl * CTXL : bl * SEQ, t0 = c * 64;
    const bf16_t* Z = (const bf16_t*)(ws + WS_Z);
    LAS float* xaf = (LAS float*)lds;
    LAS bf16_t* xab = (LAS bf16_t*)(lds + 17408);
    LAS float* hbuf = (LAS float*)(lds + 32768);
    {
        const int t = tid >> 3, i8 = (tid & 7) * 8, tok = t0 + t, Cc = head * 64 + i8;
        float acc[8];
        { const f32x4 b0 = *(const f32x4*)(A->in[I_CONVB] + l * DLRU + Cc), b1 = *(const f32x4*)(A->in[I_CONVB] + l * DLRU + Cc + 4);
#pragma unroll
          for (int e = 0; e < 4; ++e) { acc[e] = b0[e]; acc[4 + e] = b1[e]; } }
#pragma unroll
        for (int k = 0; k < 4; ++k) { const int tt = tok + k - 2;
            if (tt >= 0 && tt < Lseq) { float z[8]; unpack8(*(const u32x4*)(Z + (size_t)(rowbase + tt) * ZN + Cc), z);
                const float* cw = A->in[I_CONVW] + (size_t)(l * 4 + k) * DLRU + Cc; const f32x4 c0 = *(const f32x4*)cw, c1 = *(const f32x4*)(cw + 4);
#pragma unroll
                for (int e = 0; e < 4; ++e) { acc[e] += z[e] * c0[e]; acc[4 + e] += z[4 + e] * c1[e]; } } }
        *(LAS f32x4*)(xaf + t * 68 + i8) = (f32x4){acc[0], acc[1], acc[2], acc[3]}; *(LAS f32x4*)(xaf + t * 68 + i8 + 4) = (f32x4){acc[4], acc[5], acc[6], acc[7]};
        *(LAS u32x4*)(xab + t * 72 + i8) = pack8(acc);
    }
    __syncthreads();
    {
        const int d = wid >> 2, g = wid & 3, fr = lane & 15, fq = lane >> 4;
        const bf16_t* wb = (const bf16_t*)(ws + WS_WG) + ((size_t)((l * 8 + head) * 256 + d * 128 + 16 * g + fr)) * 64 + 8 * fq;
        bf16x8 wR[2], wG[2];
#pragma unroll
        for (int ks = 0; ks < 2; ++ks) { wR[ks] = *(const bf16x8*)(wb + 32 * ks); wG[ks] = *(const bf16x8*)(wb + 64 * 64 + 32 * ks); }
        const int cb = head * 64 + 16 * g + 4 * fq;
        const f32x4 ba = *(const f32x4*)(A->in[I_BA] + (l * 2 + d) * DLRU + cb), bxv = *(const f32x4*)(A->in[I_BX] + (l * 2 + d) * DLRU + cb), lam = *(const f32x4*)(A->in[I_LAM] + (l * 2 + d) * DLRU + cb);
        f32x4 sp8;
#pragma unroll
        for (int e = 0; e < 4; ++e) sp8[e] = 8.0f * log1pf(__expf(-lam[e]));
        const int p = (d == 0) ? sc : (isctx ? 3 - c : 4 + 31 - c);
        float* SA = (float*)(ws + WS_SUMA) + ((size_t)(bl * 2 + d) * NSC) * DLRU + cb; float* SH = (float*)(ws + WS_SUMH) + ((size_t)(bl * 2 + d) * NSC) * DLRU + cb;
        f32x4 hin = (f32x4){0.f, 0.f, 0.f, 0.f}, Atot = (f32x4){1.f, 1.f, 1.f, 1.f}, Htot = (f32x4){0.f, 0.f, 0.f, 0.f};
        if (pass2) for (int pp = 0; pp < p; ++pp) { const f32x4 a4 = *(const f32x4*)(SA + (size_t)pp * DLRU), h4 = *(const f32x4*)(SH + (size_t)pp * DLRU); hin = a4 * hin + h4; }
        const int lastl = (lane & 48) | (d ? 0 : 15);
#pragma unroll
        for (int q = 0; q < 4; ++q) { const int tt = d ? 3 - q : q;
            f32x4 aR = (f32x4){0.f, 0.f, 0.f, 0.f}, aG = (f32x4){0.f, 0.f, 0.f, 0.f};
#pragma unroll
            for (int ks = 0; ks < 2; ++ks) { const bf16x8 bfrag = *(const LAS bf16x8*)(xab + (16 * tt + fr) * 72 + 8 * fq + 32 * ks);
                aR = __builtin_amdgcn_mfma_f32_16x16x32_bf16(wR[ks], bfrag, aR, 0, 0, 0); aG = __builtin_amdgcn_mfma_f32_16x16x32_bf16(wG[ks], bfrag, aG, 0, 0, 0); }
            const f32x4 xv = *(const LAS f32x4*)(xaf + (16 * tt + fr) * 68 + 16 * g + 4 * fq);
            f32x4 hv;
#pragma unroll
            for (int e = 0; e < 4; ++e) {
                const float r = sigm(aR[e] + ba[e]), gi = sigm(aG[e] + bxv[e]);
                const float la = -r * sp8[e], a = __expf(la), x2 = -2.0f * la;
                const float om = x2 < 0.1f ? x2 * (1.0f - x2 * (0.5f - x2 * (0.16666667f - x2 * 0.041666668f))) : 1.0f - a * a;
                float Av = a, Bv = sqrtf(om) * gi * xv[e];
#pragma unroll
                for (int off = 1; off < 16; off <<= 1) { const int src = d ? lane + off : lane - off; const float Ap = __shfl(Av, src), Bp = __shfl(Bv, src);
                    const bool valid = d ? (fr + off < 16) : (fr >= off); if (valid) { Bv = Av * Bp + Bv; Av = Av * Ap; } }
                if (pass2) { const float h = Av * hin[e] + Bv; hv[e] = h; hin[e] = __shfl(h, lastl); }
                else { const float AT = __shfl(Av, lastl), BT = __shfl(Bv, lastl); Htot[e] = AT * Htot[e] + BT; Atot[e] = Atot[e] * AT; }
            }
            if (pass2) *(LAS f32x4*)(hbuf + ((d * 64 + 16 * tt + fr) * 68 + 16 * g + 4 * fq)) = hv;
        }
        if (!pass2 && fr == 0) { *(f32x4*)(SA + (size_t)p * DLRU) = Atot; *(f32x4*)(SH + (size_t)p * DLRU) = Htot; }
    }
    if (pass2) {
        __syncthreads();
        const int t = tid >> 3, i8 = (tid & 7) * 8, tok = t0 + t, Cc = head * 64 + i8;
        float zg[8]; unpack8(*(const u32x4*)(Z + (size_t)(rowbase + tok) * ZN + Z_LG + Cc), zg);
        const f32x4 h00 = *(const LAS f32x4*)(hbuf + t * 68 + i8), h01 = *(const LAS f32x4*)(hbuf + t * 68 + i8 + 4), h10 = *(const LAS f32x4*)(hbuf + (64 + t) * 68 + i8), h11 = *(const LAS f32x4*)(hbuf + (64 + t) * 68 + i8 + 4);
        float y[8];
#pragma unroll
        for (int e = 0; e < 8; ++e) { const float hs = e < 4 ? h00[e & 3] + h10[e & 3] : h01[e & 3] + h11[e & 3]; const float x = zg[e];
            const float u2 = 1.5957691216057308f * (x + 0.044715f * x * x * x);
            y[e] = hs * x * sigm(u2); }
        *(u32x4*)((bf16_t*)(ws + WS_Y) + (size_t)(rowbase + tok) * YN + Cc) = pack8(y);
    }
}

__device__ __forceinline__ void sweep_chunk(int d, int j, int bl, int& rowbase, int& t0, int& Lseq, bool& isctx) {
    isctx = j < 4; const int c = isctx ? (d ? 3 - j : j) : (d ? 35 - j : j - 4);
    Lseq = isctx ? CTXL : SEQ; rowbase = isctx ? RL + bl * CTXL : bl * SEQ; t0 = c * 64;
}
__device__ __forceinline__ void lru_sweep(ArgP A, int l, int item, LAS unsigned char* lds, const int tid) {
    unsigned char* ws = A->ws;
    const int lane = tid & 63, wid = tid >> 6, d = wid >> 2, g = wid & 3, fr = lane & 15, fq = lane >> 4, hl = tid & 255;
    const int head = item & 7, bl = item >> 3;
    const bf16_t* Z = (const bf16_t*)(ws + WS_Z);
    LAS float* cwl = (LAS float*)(lds + 106496);
    __syncthreads();
    if (tid < 256) cwl[tid] = A->in[I_CONVW][(size_t)(l * 4 + (tid >> 6)) * DLRU + head * 64 + (tid & 63)];
    else if (tid < 320) cwl[tid] = A->in[I_CONVB][l * DLRU + head * 64 + (tid - 256)];
    const bf16_t* wb = (const bf16_t*)(ws + WS_WG) + ((size_t)((l * 8 + head) * 256 + d * 128 + 16 * g + fr)) * 64 + 8 * fq;
    bf16x8 wR[2], wG[2];
#pragma unroll
    for (int ks = 0; ks < 2; ++ks) { wR[ks] = *(const bf16x8*)(wb + 32 * ks); wG[ks] = *(const bf16x8*)(wb + 64 * 64 + 32 * ks); }
    const int cb = head * 64 + 16 * g + 4 * fq;
    const f32x4 ba = *(const f32x4*)(A->in[I_BA] + (l * 2 + d) * DLRU + cb), bxv = *(const f32x4*)(A->in[I_BX] + (l * 2 + d) * DLRU + cb), lam = *(const f32x4*)(A->in[I_LAM] + (l * 2 + d) * DLRU + cb);
    const float LOG2E = 1.4426950408889634f;
    f32x4 spl2; const f32x4 nba = ba * (-LOG2E), nbx = bxv * (-LOG2E);
#pragma unroll
    for (int e = 0; e < 4; ++e) { const float sp8 = 8.0f * log1pf(__expf(-lam[e])); spl2[e] = sp8 * LOG2E; }
    float* HX = (float*)(ws + (d ? WS_HB : WS_HF));
    const int lastl = lane | 15;
    const int ct = hl >> 2, ci = (hl & 3) * 16;
    f32x4 hin = (f32x4){0.f, 0.f, 0.f, 0.f};
#define SWEEP_LOAD(zr, jj) do { int rb_, t0_, Ls_; bool ic_; sweep_chunk(d, (jj) < NSC ? (jj) : NSC - 1, bl, rb_, t0_, Ls_, ic_); \
        _Pragma("unroll") for (int k = 0; k < 4; ++k) { const int tt_ = t0_ + ct + k - 2; const bool ok_ = (tt_ >= 0 && tt_ < Ls_); const int tc_ = ok_ ? tt_ : t0_ + ct; \
            const bf16_t* zp_ = Z + (size_t)(rb_ + tc_) * ZN + head * 64 + ci; const u32x4 l0_ = *(const u32x4*)zp_, l1_ = *(const u32x4*)(zp_ + 8); const unsigned mk_ = ok_ ? 0xffffffffu : 0u; \
            zr[k][0] = l0_ & mk_; zr[k][1] = l1_ & mk_; } } while (0)
#define SWEEP_CONV(zr, bufi) do { LAS float* xaf_ = (LAS float*)(lds + d * 53248 + (bufi) * 26624); LAS bf16_t* xab_ = (LAS bf16_t*)(lds + d * 53248 + (bufi) * 26624 + 17408); \
        _Pragma("unroll") for (int hf_ = 0; hf_ < 2; ++hf_) { float acc[8]; \
            { const f32x4 b0_ = *(const LAS f32x4*)(cwl + 256 + ci + 8 * hf_), b1_ = *(const LAS f32x4*)(cwl + 256 + ci + 8 * hf_ + 4); _Pragma("unroll") for (int e = 0; e < 4; ++e) { acc[e] = b0_[e]; acc[4 + e] = b1_[e]; } } \
            _Pragma("unroll") for (int k = 0; k < 4; ++k) { float z[8]; unpack8(zr[k][hf_], z); \
                const f32x4 w0_ = *(const LAS f32x4*)(cwl + k * 64 + ci + 8 * hf_), w1_ = *(const LAS f32x4*)(cwl + k * 64 + ci + 8 * hf_ + 4); \
                _Pragma("unroll") for (int e = 0; e < 4; ++e) { acc[e] += z[e] * w0_[e]; acc[4 + e] += z[4 + e] * w1_[e]; } } \
            *(LAS f32x4*)(xaf_ + ct * 68 + ci + 8 * hf_) = (f32x4){acc[0], acc[1], acc[2], acc[3]}; *(LAS f32x4*)(xaf_ + ct * 68 + ci + 8 * hf_ + 4) = (f32x4){acc[4], acc[5], acc[6], acc[7]}; \
            *(LAS u32x4*)(xab_ + ct * 72 + ci + 8 * hf_) = pack8(acc); } } while (0)
#define SCAN_LVL(N) "v_fmac_f32_dpp %0, %0, %4 row_shr:" #N " row_mask:0xf bank_mask:0xf\n\tv_fmac_f32_dpp %1, %1, %5 row_shr:" #N " row_mask:0xf bank_mask:0xf\n\t" \
                    "v_fmac_f32_dpp %2, %2, %6 row_shr:" #N " row_mask:0xf bank_mask:0xf\n\tv_fmac_f32_dpp %3, %3, %7 row_shr:" #N " row_mask:0xf bank_mask:0xf\n\t" \
                    "v_mul_f32_dpp %4, %4, %4 row_shr:" #N " row_mask:0xf bank_mask:0xf\n\tv_mul_f32_dpp %5, %5, %5 row_shr:" #N " row_mask:0xf bank_mask:0xf\n\t" \
                    "v_mul_f32_dpp %6, %6, %6 row_shr:" #N " row_mask:0xf bank_mask:0xf\n\tv_mul_f32_dpp %7, %7, %7 row_shr:" #N " row_mask:0xf bank_mask:0xf\n\t"
#define SWEEP_SCAN \
        _Pragma("unroll") \
        for (int q = 0; q < 4; ++q) { const int tt = d ? 3 - q : q, trow = 16 * tt + (d ? 15 - fr : fr); \
            f32x4 aR = (f32x4){0.f, 0.f, 0.f, 0.f}, aG = (f32x4){0.f, 0.f, 0.f, 0.f}; \
        _Pragma("unroll") \
            for (int ks = 0; ks < 2; ++ks) { const bf16x8 bfrag = *(const LAS bf16x8*)(xab + trow * 72 + 8 * fq + 32 * ks); \
                aR = __builtin_amdgcn_mfma_f32_16x16x32_bf16(wR[ks], bfrag, aR, 0, 0, 0); aG = __builtin_amdgcn_mfma_f32_16x16x32_bf16(wG[ks], bfrag, aG, 0, 0, 0); } \
            const f32x4 xv = *(const LAS f32x4*)(xaf + trow * 68 + 16 * g + 4 * fq); \
            f32x4 Av, Bv; \
            { \
                const f32x4 tR = aR * (-LOG2E) + nba, tG = aG * (-LOG2E) + nbx; \
                f32x4 eR, eG; \
        _Pragma("unroll") \
                for (int e = 0; e < 4; ++e) { eR[e] = __builtin_amdgcn_exp2f(tR[e]); eG[e] = __builtin_amdgcn_exp2f(tG[e]); } \
                eR = eR + 1.0f; eG = eG + 1.0f; \
                f32x4 r, gi; \
        _Pragma("unroll") \
                for (int e = 0; e < 4; ++e) { r[e] = __builtin_amdgcn_rcpf(eR[e]); gi[e] = __builtin_amdgcn_rcpf(eG[e]); } \
                const f32x4 ta = r * spl2, x2 = ta * 1.3862943611198906f; \
        _Pragma("unroll") \
                for (int e = 0; e < 4; ++e) Av[e] = __builtin_amdgcn_exp2f(-ta[e]); \
                const f32x4 pser = x2 * (x2 * (x2 * 0.16666667f - 0.5f) + 1.0f), om1 = 1.0f - Av * Av; \
                f32x4 sq; \
        _Pragma("unroll") \
                for (int e = 0; e < 4; ++e) sq[e] = __builtin_amdgcn_sqrtf(x2[e] < 0.02f ? pser[e] : om1[e]); \
                Bv = sq * gi * xv; \
            } \
            { \
                float B0 = Bv[0], B1 = Bv[1], B2 = Bv[2], B3 = Bv[3], A0 = Av[0], A1 = Av[1], A2 = Av[2], A3 = Av[3]; \
                asm volatile("s_nop 1\n\t" SCAN_LVL(1) SCAN_LVL(2) SCAN_LVL(4) SCAN_LVL(8) "s_nop 1" \
                    : "+v"(B0), "+v"(B1), "+v"(B2), "+v"(B3), "+v"(A0), "+v"(A1), "+v"(A2), "+v"(A3)); \
                Av = (f32x4){A0, A1, A2, A3}; Bv = (f32x4){B0, B1, B2, B3}; \
            } \
            const f32x4 hq = Av * hin + Bv; *(f32x4*)(HX + (size_t)(rowbase + t0 + trow) * DLRU + cb) = hq; \
        _Pragma("unroll") \
            for (int e = 0; e < 4; ++e) hin[e] = __shfl(hq[e], lastl); \
        }
    __syncthreads();
    u32x4 za[4][2], zb[4][2];
    { SWEEP_LOAD(zb, 0); SWEEP_LOAD(za, 1); SWEEP_CONV(zb, 0); }
    __syncthreads();
#define SWEEP_STEP(jj, ZL, ZC) do { const int j = (jj); \
        int rowbase, t0, Lseq; bool isctx; sweep_chunk(d, j, bl, rowbase, t0, Lseq, isctx); \
        SWEEP_LOAD(ZL, j + 2); \
        const LAS float* xaf = (const LAS float*)(lds + d * 53248 + (j & 1) * 26624); \
        const LAS bf16_t* xab = (const LAS bf16_t*)(lds + d * 53248 + (j & 1) * 26624 + 17408); \
        SWEEP_SCAN \
        if (j + 1 < NSC) SWEEP_CONV(ZC, (j + 1) & 1); \
        __syncthreads(); } while (0)
    for (int j2 = 0; j2 < NSC; j2 += 2) { SWEEP_STEP(j2, zb, za); SWEEP_STEP(j2 + 1, za, zb); }
#undef SWEEP_STEP
#undef SWEEP_SCAN
#undef SCAN_LVL
#undef SWEEP_LOAD
#undef SWEEP_CONV
    asm volatile("s_waitcnt vmcnt(0)" ::: "memory");
    __syncthreads();
    {
        const float* HF = (const float*)(ws + WS_HF); const float* HB = (const float*)(ws + WS_HB);
        const int t = tid >> 3, i8 = (tid & 7) * 8, Cc = head * 64 + i8;
        for (int sc0 = (l == 0 ? 0 : 4); sc0 < NSC; sc0 += 4) {
            u32x4 zgw[4]; f32x4 f0[4], f1[4], b0[4], b1[4]; int rows[4];
#pragma unroll
            for (int u = 0; u < 4; ++u) { const int sc = sc0 + u; const int row = (sc < 4 ? RL + bl * CTXL + sc * 64 : bl * SEQ + (sc - 4) * 64) + t; rows[u] = row;
                zgw[u] = *(const u32x4*)(Z + (size_t)row * ZN + Z_LG + Cc);
                f0[u] = *(const f32x4*)(HF + (size_t)row * DLRU + Cc); f1[u] = *(const f32x4*)(HF + (size_t)row * DLRU + Cc + 4);
                b0[u] = *(const f32x4*)(HB + (size_t)row * DLRU + Cc); b1[u] = *(const f32x4*)(HB + (size_t)row * DLRU + Cc + 4); }
#pragma unroll
            for (int u = 0; u < 4; ++u) { float zg[8]; unpack8(zgw[u], zg); float y[8];
#pragma unroll
                for (int e = 0; e < 8; ++e) { const float hs = e < 4 ? f0[u][e & 3] + b0[u][e & 3] : f1[u][e & 3] + b1[u][e & 3]; const float x = zg[e];
                    const float u2 = 1.5957691216057308f * (x + 0.044715f * x * x * x);
                    y[e] = hs * x * sigm(u2); }
                *(u32x4*)((bf16_t*)(ws + WS_Y) + (size_t)rows[u] * YN + Cc) = pack8(y); }
        }
    }
}

__device__ __forceinline__ void seg_decode(int it, int& rowbase, int& s0, int& lob, int& hib, int& Lseq) {
    if (it < 512) { const int bl = it >> 5, sg = it & 31; rowbase = bl * SEQ; s0 = sg * 64; lob = s0; hib = s0 + 64; Lseq = SEQ; }
    else { const int j = it - 512, bl = j >> 2, q = j & 3; rowbase = RL + bl * CTXL; s0 = q * 64; lob = 0; hib = CTXL; Lseq = CTXL; }
}
__device__ __forceinline__ void pool_item(ArgP A, int it, LAS unsigned char* lds, const int tid) {
    unsigned char* ws = A->ws;
    int rowbase, s0, lob, hib, Lseq; seg_decode(it, rowbase, s0, lob, hib, Lseq);
    const bf16_t* Z = (const bf16_t*)(ws + WS_Z) + Z_POOL;
    const int c8 = (tid & 31) * 8, tq = tid >> 5, w2 = 1 << (c8 >> 6);
    bf16_t* Y = (bf16_t*)(ws + WS_Y) + Y_POOL + c8;
#pragma unroll
    for (int u = 0; u < 4; ++u) { const int tok = s0 + tq * 4 + u; const int lo = max(tok - w2, lob), hi = min(tok + w2, hib);
        float sum[8];
#pragma unroll
        for (int e = 0; e < 8; ++e) sum[e] = 0.f;
        for (int j = lo; j < hi; ++j) { float z[8]; unpack8(*(const u32x4*)(Z + (size_t)(rowbase + j) * ZN + c8), z);
#pragma unroll
            for (int e = 0; e < 8; ++e) sum[e] += z[e]; }
        float zc[8]; unpack8(*(const u32x4*)(Z + (size_t)(rowbase + tok) * ZN + c8), zc);
        const float inv = 1.0f / (float)(hi - lo);
#pragma unroll
        for (int e = 0; e < 8; ++e) sum[e] = sum[e] * inv - zc[e];
        *(u32x4*)(Y + (size_t)(rowbase + tok) * YN) = pack8(sum); }
}
__device__ __forceinline__ void sconv_item(ArgP A, int l, int it, const int tid) {
    unsigned char* ws = A->ws;
    int rowbase, s0, lob, hib, Lseq; seg_decode(it, rowbase, s0, lob, hib, Lseq);
    const bf16_t* Z = (const bf16_t*)(ws + WS_Z);
    const int c8 = (tid & 31) * 8, tr = tid >> 5;
    const float* sw = A->in[I_SCW] + (size_t)l * 3 * 256 + c8;
    f32x4 w0[3], w1[3];
#pragma unroll
    for (int k = 0; k < 3; ++k) { w0[k] = *(const f32x4*)(sw + k * 256); w1[k] = *(const f32x4*)(sw + k * 256 + 4); }
#pragma unroll
    for (int pp = 0; pp < 2; ++pp) {
        u32x4 gcw[2][3], hsw[2][3], gbw[2];
#pragma unroll
        for (int q = 0; q < 2; ++q) { const int tok = s0 + (pp * 2 + q) * 16 + tr;
            gbw[q] = *(const u32x4*)(Z + (size_t)(rowbase + tok) * ZN + Z_SC + c8);
#pragma unroll
            for (int k = 0; k < 3; ++k) { const int tt = tok + k - 1; const bool ok = (tt >= 0 && tt < Lseq); const bf16_t* zr = Z + (size_t)(rowbase + (ok ? tt : tok)) * ZN + Z_SC + c8;
                const u32x4 a = *(const u32x4*)(zr + 256), b = *(const u32x4*)(zr + 512); const unsigned mk = ok ? 0xffffffffu : 0u; gcw[q][k] = a & mk; hsw[q][k] = b; } }
#pragma unroll
        for (int q = 0; q < 2; ++q) { const int tok = s0 + (pp * 2 + q) * 16 + tr; float acc[8];
#pragma unroll
            for (int e = 0; e < 8; ++e) acc[e] = 0.f;
#pragma unroll
            for (int k = 0; k < 3; ++k) { float gc[8], hs[8]; unpack8(gcw[q][k], gc); unpack8(hsw[q][k], hs);
#pragma unroll
                for (int e = 0; e < 4; ++e) { acc[e] += gc[e] * hs[e] * w0[k][e]; acc[4 + e] += gc[4 + e] * hs[4 + e] * w1[k][e]; } }
            float gb[8]; unpack8(gbw[q], gb);
#pragma unroll
            for (int e = 0; e < 8; ++e) acc[e] *= gb[e];
            *(u32x4*)((bf16_t*)(ws + WS_Y) + (size_t)(rowbase + tok) * YN + Y_SC + c8) = pack8(acc); }
    }
}

__device__ __forceinline__ int fetch_item(unsigned* ctr, LAS unsigned char* lds, const int tid) {
    LAS unsigned* slot = (LAS unsigned*)(lds + QSLOT_OFF);
    __syncthreads();
    if (tid == 0) *slot = atomicAdd(ctr, 1u);
    __syncthreads();
    return (int)*slot;
}


#define XB_TMO      128
#define XB_XCNT(j)  (256  + 64 * (j))
#define XB_XSUB(j)  (1280 + 64 * (j))
#define XB_XGEN(j)  (2304 + 64 * (j))
#define XB_TOP      3328
#define XB_TOPGEN   3392
#define XCD_BAR_WORDS 3456
#define XB_SPIN_CAP (1u << 22)
__device__ __forceinline__ unsigned xb_ld(unsigned* p)              { return __hip_atomic_load(p, __ATOMIC_RELAXED, __HIP_MEMORY_SCOPE_AGENT); }
__device__ __forceinline__ unsigned xb_add(unsigned* p, unsigned v) { return __hip_atomic_fetch_add(p, v, __ATOMIC_RELAXED, __HIP_MEMORY_SCOPE_AGENT); }
__device__ __forceinline__ unsigned xb_xcc_id() { return (unsigned)__builtin_amdgcn_s_getreg((3 << 11) | 20) & 0xFu; }
#define XB_SPIN(cond, bar) do { unsigned _sp = 0; while (cond) { __builtin_amdgcn_s_sleep(1); \
    if ((++_sp & 255u) == 0u) { if (xb_ld(&(bar)[XB_TMO])) break; if (_sp > XB_SPIN_CAP) { atomicAdd(&(bar)[XB_TMO], 1u); break; } } } } while (0)
struct XcdBarrier { unsigned* bar; unsigned x; volatile LAS unsigned* st; };
__device__ __forceinline__ XcdBarrier xcd_barrier_post(unsigned* bar, volatile LAS unsigned* st) {
    XcdBarrier b; b.bar = bar; b.x = xb_xcc_id(); b.st = st;
    if (threadIdx.x == 0) (void)xb_add(&bar[XB_XCNT(b.x)], 1u);
    return b;
}
__device__ __forceinline__ void xcd_barrier_complete(unsigned* bar, unsigned x, unsigned& nloc, unsigned& nx) {
    const unsigned G = gridDim.x * gridDim.y * gridDim.z;
    unsigned sum, cnt, mine, sp = 0u;
    for (;;) {
        sum = 0u; cnt = 0u; mine = 0u;
#pragma unroll
        for (unsigned j = 0; j < 16; ++j) { const unsigned c = xb_ld(&bar[XB_XCNT(j)]); sum += c; cnt += (c > 0u) ? 1u : 0u; }
        mine = xb_ld(&bar[XB_XCNT(x)]);
        if (sum == G) break;
        __builtin_amdgcn_s_sleep(1);
        if ((++sp & 255u) == 0u) { if (xb_ld(&bar[XB_TMO])) break; if (sp > XB_SPIN_CAP) { atomicAdd(&bar[XB_TMO], 1u); break; } }
    }
    nloc = mine > 0u ? mine : 1u; nx = cnt > 0u ? cnt : 1u;
}
__device__ __forceinline__ void xcd_barrier(const XcdBarrier& b, const int tid) {
    asm volatile("s_waitcnt vmcnt(0)" ::: "memory");
    __syncthreads();
    if (tid == 0) {
        unsigned* bar = b.bar;
        __builtin_amdgcn_s_waitcnt(0);
        unsigned nloc = b.st[0], nx = b.st[1];
        if (nloc == 0u) { xcd_barrier_complete(bar, b.x, nloc, nx); b.st[0] = nloc; b.st[1] = nx; }
        const unsigned old = xb_add(&bar[XB_XSUB(b.x)], 1u);
        const unsigned gen = old / nloc;
        if (old + 1u == (gen + 1u) * nloc) {
            __builtin_amdgcn_fence(__ATOMIC_RELEASE, "agent");
            asm volatile("s_waitcnt vmcnt(0)" ::: "memory");
            const unsigned og = xb_add(&bar[XB_TOP], 1u);
            const unsigned tg = og / nx;
            if (og + 1u == (tg + 1u) * nx) xb_add(&bar[XB_TOPGEN], 1u);
            else XB_SPIN(xb_ld(&bar[XB_TOPGEN]) == tg, bar);
            __builtin_amdgcn_fence(__ATOMIC_ACQUIRE, "agent");
            xb_add(&bar[XB_XGEN(b.x)], 1u);
            asm volatile("s_waitcnt vmcnt(0)" ::: "memory");
        } else {
            XB_SPIN(xb_ld(&bar[XB_XGEN(b.x)]) == gen, bar);
            __builtin_amdgcn_fence(__ATOMIC_ACQUIRE, "agent");
            asm volatile("s_waitcnt vmcnt(0)" ::: "memory");
        }
    }
    __syncthreads();
}

template <bool COOP>
__global__ void __launch_bounds__(512, 2) fwd_kernel(Args Aparam) {
    extern __shared__ __attribute__((aligned(16))) unsigned char lds_raw[];
    LAS unsigned char* lds = (LAS unsigned char*)lds_raw;
    const int G = gridDim.x;
    ArgP A = (ArgP)__builtin_amdgcn_kernarg_segment_ptr();
    const int ph_lo = A->ph_lo, ph_hi = A->ph_hi;
    XcdBarrier xbar; xbar.bar = nullptr; xbar.x = 0; xbar.st = (volatile LAS unsigned*)(lds + QSLOT_OFF + 16);
    if constexpr (COOP) {
        if (threadIdx.x < 2) xbar.st[threadIdx.x] = 0u;
        __syncthreads();
        xbar = xcd_barrier_post((unsigned*)(A->ws + WS_CTL) + 8192, xbar.st);
    }
    int tid0 = threadIdx.x;
    for (int ph = ph_lo; ph < ph_hi; ++ph) {
        asm volatile("" : "+s"(A));
        asm volatile("" : "+v"(tid0)); const int tid = tid0;
        unsigned* ctl = (unsigned*)(A->ws + WS_CTL);
        if (ph < PH_BASE) p0_prologue(A, lds, G, tid);
        else if (ph == NPHASE - 1) final_norm(A, G, tid);
        else if (ph == PH_BASE) norm_phase(A, 0, 0, false, (int)blockIdx.x * 8, RT, G * 8, tid);
        else {
            const int q = ph - PH_BASE - 1, kj = q % PH_PER, lc = q / PH_PER, l = lc >> 1, ch = lc & 1;
            const int PKJ = PROBE_K < 3 ? PROBE_K - 1 : PROBE_K - 2;
            const int kq = (PROBE_K >= 1 && PROBE_K <= 8 && kj > PKJ) ? kj - 1 : kj;
            const int k = kq < 2 ? kq + 1 : kq + 2;
            const int sub = (PROBE_K >= 1 && PROBE_K <= 8 && kj == PKJ + 1) ? PROBE_SUB : 7;
            if (k == 6) norm_phase(A, l, ch, true, (int)blockIdx.x * 8, RT, G * 8, tid);
            else {
                Sched S; S.kind = k; S.l = l; S.ch = ch; S.G = G; S.c = (int)blockIdx.x; S.ap = A;
                pg8::Gemm g; g.lda = (k == 2 || k == 8) ? 4096 : (k == 4 ? YN : DM); g.ldb = g.lda;
                if (k == 2 && !(sub & 1)) {} else if (k == 1 || k == 2 || k == 7) { pg8::EpiBf E; E.act = (k == 7) ? 1 : 0; pg8::gemm_phase<pg8::EpiBf, Sched>(lds, g, S, E, tid); }
                else if (k == 4) { pg8::EpiMerge E; pg8::gemm_phase<pg8::EpiMerge, Sched>(lds, g, S, E, tid); }
                else { pg8::EpiRes E; pg8::gemm_phase<pg8::EpiRes, Sched>(lds, g, S, E, tid); }
                if (k == 8 && lc + 1 < DEPTH * NCH) {
                    const int l2 = (lc + 1) >> 1, ch2 = (lc + 1) & 1;
                    for (;;) { const int it = fetch_item(ctl + 64 * ph, lds, tid); if (it >= RT / 64) break; norm_phase(A, l2, ch2, false, it * 64, it * 64 + 64, 8, tid); }
                }
                if (k == 2) {
                    if (sub & 2) for (int it = (int)blockIdx.x - (G >> 1); it >= 0 && it < NB * 8; it += G - (G >> 1)) lru_sweep(A, l, it, lds, tid);
                    const int nseg = (l == 0) ? 576 : 512, total = (sub & 4) ? 2 * nseg : 0;
                    for (;;) { const int it = fetch_item(ctl + 64 * ph, lds, tid); if (it >= total) break;
                        if (it < nseg) pool_item(A, it, lds, tid);
                        else sconv_item(A, l, it - nseg, tid); }
                }
            }
        }
        if (ph + 1 < ph_hi) { if constexpr (COOP) { if (ph == 0) cg::this_grid().sync(); else xcd_barrier(xbar, tid); } }
    }
}

extern "C" void kernel_launch(void* const* d_in, const int* in_sizes, int n_in, void* d_out, int out_size, void* d_ws, size_t ws_size, hipStream_t stream) {
    static int grid = 0;
    if (grid == 0) {
        if (n_in != 27 || out_size != NBATCH * SEQ * DM || ws_size < WS_END) { fprintf(stderr, "kernel_launch: unexpected shapes (n_in %d out %d ws %zu)\n", n_in, out_size, ws_size); grid = -1; return; }
        int dev = 0, cus = 0, per_cu = 0;
        hipGetDevice(&dev); hipDeviceGetAttribute(&cus, hipDeviceAttributeMultiprocessorCount, dev);
        hipFuncSetAttribute((const void*)fwd_kernel<true>, hipFuncAttributeMaxDynamicSharedMemorySize, LDS_BYTES);
        hipFuncSetAttribute((const void*)fwd_kernel<false>, hipFuncAttributeMaxDynamicSharedMemorySize, LDS_BYTES);
        hipOccupancyMaxActiveBlocksPerMultiprocessor(&per_cu, (const void*)fwd_kernel<true>, 512, LDS_BYTES);
        (void)hipGetLastError();
        if (per_cu < 1) per_cu = 1;
        grid = cus * 1;
        if (grid <= 0) grid = 256;
    }
    if (grid < 0) return;
    hipMemsetAsync((char*)d_ws + WS_CTL, 0, CTL_ZERO_BYTES, stream);
    Args a{};
    for (int i = 0; i < 27; ++i) a.in[i] = (const float*)d_in[i];
    a.out = (float*)d_out; a.ws = (unsigned char*)d_ws;
#if MK_COOP
    a.ph_lo = 0; a.ph_hi = NPHASE;
    void* args[] = {&a};
    hipError_t e = hipLaunchCooperativeKernel((const void*)fwd_kernel<true>, dim3(grid), dim3(512), args, LDS_BYTES, stream);
    if (e != hipSuccess) fprintf(stderr, "cooperative launch failed: %s (grid %d)\n", hipGetErrorString(e), grid);
#else
    for (int ph = 0; ph < NPHASE; ++ph) { a.ph_lo = ph; a.ph_hi = ph + 1; hipLaunchKernelGGL(fwd_kernel<false>, dim3(grid), dim3(512), LDS_BYTES, stream, a); }
#endif
}
```

```cpp
#include <hip/hip_runtime.h>
#include <hip/hip_cooperative_groups.h>
#include <cstdio>
#include <cstdint>
namespace cg = cooperative_groups;

#ifndef MK_COOP
#define MK_COOP 1
#endif
#define PROBE_SUB 7
#define PROBE_K -1

#define LAS __attribute__((address_space(3)))
typedef unsigned short bf16_t;
typedef short bf16x8 __attribute__((ext_vector_type(8)));
typedef float f32x4 __attribute__((ext_vector_type(4)));
typedef float f32x2 __attribute__((ext_vector_type(2)));
typedef unsigned u32x4 __attribute__((ext_vector_type(4)));
typedef unsigned u32x2 __attribute__((ext_vector_type(2)));

constexpr int NBATCH = 32, SEQ = 2048, CTXL = 256, DM = 1024, DEPTH = 2, DLRU = 512, NIN = 6400, DFF = 4096;
constexpr int NB = 16, NCH = 2;
constexpr int RL = NB * SEQ, RC = NB * CTXL, RT = RL + RC;
constexpr int ZN = 4096  , WN = 6144  , YN = 1280;
constexpr int Z_LG = 512, Z_POOL = 1024, Z_SC = 1280, Z_GATE = 2048;
constexpr int Y_F = 512, Y_POOL = 768, Y_SC = 1024;
constexpr int NSC = 36;
constexpr size_t MiB = 1u << 20;
constexpr size_t WS_CTL = 0, CTL_ZERO_BYTES = 65536;
constexpr size_t WS_MOD = 1 * MiB, WS_WG = 3 * MiB, WS_SUMA = 4 * MiB, WS_SUMH = 7 * MiB, WS_DFTC = 10 * MiB, WS_DFT = 12 * MiB;
constexpr size_t WS_WIN = 28 * MiB, WS_WF = 52 * MiB, WS_WBR = 54 * MiB, WS_WOUT = 60 * MiB, WS_W1 = 64 * MiB, WS_W2 = 80 * MiB;
constexpr size_t WS_CTXW = 96 * MiB, WS_U = 128 * MiB, WS_MRG = 200 * MiB, WS_PT = 272 * MiB, WS_PTC = 304 * MiB, WS_Y = 336 * MiB, WS_Z = 432 * MiB;
constexpr size_t WS_HF = WS_Z + (size_t)RT * ZN * 2, WS_HB = WS_HF + (size_t)RT * DLRU * 4;
constexpr size_t WS_END = WS_HB + (size_t)RT * DLRU * 4;
static_assert(WS_END <= 1024 * MiB, "workspace map");
static_assert(WS_Y + (size_t)RT * YN * 2 <= WS_Z && WS_PTC + (size_t)NB * 256 * 4096 * 2 <= WS_Y && WS_MRG + (size_t)RT * DM * 2 <= WS_PT, "workspace map 2");
constexpr int LDS_BYTES = 147456, RING_BYTES = 131072, QSLOT_OFF = LDS_BYTES - 64;
constexpr int PH_PER = 7 + ((PROBE_K >= 1 && PROBE_K <= 8) ? 1 : 0), PH_BASE = (PROBE_K == 9) ? 2 : 1;
constexpr int NPHASE = PH_BASE + 2 + DEPTH * NCH * PH_PER;

__device__ __forceinline__ float bf_lo(unsigned w) { return __uint_as_float(w << 16); }
__device__ __forceinline__ float bf_hi(unsigned w) { return __uint_as_float(w & 0xffff0000u); }
__device__ __forceinline__ unsigned cvt_pk_bf16(float lo, float hi) { unsigned r; asm volatile("v_cvt_pk_bf16_f32 %0, %1, %2" : "=v"(r) : "v"(lo), "v"(hi)); return r; }
__device__ __forceinline__ float sigm(float x) { return __builtin_amdgcn_rcpf(1.0f + __expf(-x)); }
__device__ __forceinline__ float wave_sum(float v) {
#pragma unroll
    for (int o = 1; o < 64; o <<= 1) v += __shfl_xor(v, o);
    return v;
}
#define LDS_WAIT() asm volatile("s_waitcnt lgkmcnt(0)" ::: "memory")
#define DPP_SHR(ident, v, N) __builtin_bit_cast(float, __builtin_amdgcn_update_dpp(__builtin_bit_cast(int, (float)(ident)), __builtin_bit_cast(int, (float)(v)), 0x110 + (N), 0xf, 0xf, false))
#define SCAN_STEP(N) do { const float Ap_ = DPP_SHR(1.0f, Av, N), Bp_ = DPP_SHR(0.0f, Bv, N); Bv = Av * Bp_ + Bv; Av = Av * Ap_; } while (0)

namespace pg8 {
constexpr int BM = 256, BK = 64, HALF = 128, HTB = HALF * BK * 2, STAGE_BYTES = 8 * HTB, NXCD = 8, WGM = 8;
__host__ __device__ __forceinline__ int lds_byte(int r, int c) { const int st = (r >> 4) * 2 + (c >> 5), rr = r & 15, cc = c & 31, ob = rr * 64 + cc * 2; return st * 1024 + (ob ^ (((ob >> 9) & 1) << 5)); }
__host__ __device__ __forceinline__ void stage_rc(int b, int& R, int& C) { const int st = b / 1024, sb = b % 1024, swz = sb ^ (((sb >> 9) & 1) << 5); R = (st >> 1) * 16 + swz / 64; C = (st & 1) * 32 + (swz % 64) / 2; }
__host__ __device__ __forceinline__ int perm32(int rho) { const int n = rho >> 4, i = rho & 15; return 8 * (i >> 2) + 4 * n + (i & 3); }

struct Unit { const char* a; const char* b; char* dst; const char* x0; const char* x1; int nt, seg; };
struct Gemm { int lda, ldb; };

__device__ __forceinline__ bool tile_of(long L, int nM, int nN, int& pm, int& pn) {
    const int nwg = nM * nN; if (L >= nwg) return false;
    int wgid = (int)L; { const int q = nwg / NXCD, r = nwg % NXCD, xcd = wgid % NXCD, off = wgid / NXCD; wgid = (xcd < r ? xcd * (q + 1) : r * (q + 1) + (xcd - r) * q) + off; }
    const int nig = WGM * nN, gid = wgid / nig, fm = gid * WGM, gsz = (nM - fm) < WGM ? (nM - fm) : WGM;
    pm = fm + ((wgid % nig) % gsz); pn = (wgid % nig) / gsz; return true;
}

struct EpiBf {
    static constexpr bool PERM = true;
    int act;
    __device__ __forceinline__ bool operator()(f32x4 (&acc)[2][2][4][2], const Unit& u, int wr, int wc, int fr, int fq) const {
        const int ldc = (u.seg & 12) ? YN : 4096;
        bf16_t* base = (bf16_t*)u.dst + (size_t)(wr * 64 + fr) * ldc + wc * 32 + 8 * fq;
        const float sc = (u.seg & 4) ? 0.001381067932004975f   : ((u.seg & 8) ? 1.f / 256.f : 1.f);
#pragma unroll
        for (int ai = 0; ai < 2; ++ai)
#pragma unroll
            for (int m = 0; m < 4; ++m) { bf16_t* rowp = base + (size_t)(ai * HALF + m * 16) * ldc;
#pragma unroll
                for (int bj = 0; bj < 2; ++bj) { f32x4 v0 = acc[ai][bj][m][0], v1 = acc[ai][bj][m][1];
                    if (u.seg == 2) {
                        unsigned p0 = 0u, p1 = 0u;
#pragma unroll
                        for (int e = 0; e < 4; ++e) {
                            const float s0 = fmaxf(__builtin_amdgcn_rcpf(__builtin_amdgcn_exp2f(v0[e] * -1.4426950408889634f) * (1.0f / 255.0f) + (1.0f / 255.0f)), 1.0f);
                            const float s1 = fmaxf(__builtin_amdgcn_rcpf(__builtin_amdgcn_exp2f(v1[e] * -1.4426950408889634f) * (1.0f / 255.0f) + (1.0f / 255.0f)), 1.0f);
                            p0 = __builtin_amdgcn_cvt_pk_u8_f32(s0, e, p0); p1 = __builtin_amdgcn_cvt_pk_u8_f32(s1, e, p1); }
                        u32x2 wg; wg.x = p0; wg.y = p1;
                        *(u32x2*)(u.dst + (size_t)(wr * 64 + fr + ai * HALF + m * 16) * (ZN * 2) + wc * 32 + 8 * fq + bj * HALF) = wg;
                        continue; }
                    if (act == 1) {
#pragma unroll
                        for (int e = 0; e < 4; ++e) { const float a = fmaxf(v0[e], 0.f), b = fmaxf(v1[e], 0.f); v0[e] = a * a; v1[e] = b * b; } }
                    v0 = v0 * sc; v1 = v1 * sc;
                    u32x4 w; w.x = cvt_pk_bf16(v0[0], v0[1]); w.y = cvt_pk_bf16(v0[2], v0[3]); w.z = cvt_pk_bf16(v1[0], v1[1]); w.w = cvt_pk_bf16(v1[2], v1[3]);
                    *(u32x4*)(rowp + bj * HALF) = w; } }
        return true;
    }
};
struct EpiRes {
    static constexpr bool PERM = false;
    __device__ __forceinline__ bool operator()(f32x4 (&acc)[2][2][4][2], const Unit& u, int wr, int wc, int fr, int fq) const {
        const float* gv = (const float*)u.x1 + wc * 32 + 4 * fq;
        f32x4 g[2][2];
#pragma unroll
        for (int bj = 0; bj < 2; ++bj)
#pragma unroll
            for (int n = 0; n < 2; ++n) g[bj][n] = *(const f32x4*)(gv + bj * HALF + n * 16);
        const size_t o0 = (size_t)(wr * 64 + fr) * DM + wc * 32 + 4 * fq;
        const float* bs = (const float*)u.x0 + o0; float* od = (float*)u.dst + o0;
        f32x4 bc[2][2];
#pragma unroll
        for (int bj = 0; bj < 2; ++bj)
#pragma unroll
            for (int n = 0; n < 2; ++n) bc[bj][n] = *(const f32x4*)(bs + bj * HALF + n * 16);
#pragma unroll
        for (int am = 0; am < 8; ++am) { const int ai = am >> 2, m = am & 3; const size_t off = (size_t)(ai * HALF + m * 16) * DM;
            f32x4 bn[2][2];
            if (am < 7) { const size_t offn = (size_t)(((am + 1) >> 2) * HALF + ((am + 1) & 3) * 16) * DM;
#pragma unroll
                for (int bj = 0; bj < 2; ++bj)
#pragma unroll
                    for (int n = 0; n < 2; ++n) bn[bj][n] = *(const f32x4*)(bs + offn + bj * HALF + n * 16); }
#pragma unroll
            for (int bj = 0; bj < 2; ++bj)
#pragma unroll
                for (int n = 0; n < 2; ++n) *(f32x4*)(od + off + bj * HALF + n * 16) = bc[bj][n] + g[bj][n] * acc[ai][bj][m][n];
            if (am < 7) {
#pragma unroll
                for (int bj = 0; bj < 2; ++bj)
#pragma unroll
                    for (int n = 0; n < 2; ++n) bc[bj][n] = bn[bj][n]; }
        }
        return true;
    }
};
struct EpiMerge {
    static constexpr bool PERM = true;
    __device__ __forceinline__ void apply(const bool LAST, f32x4 (&acc)[2][2][4][2], const Unit& u, int wr, int wc, int fr, int fq) const {
        const unsigned char* g0 = (const unsigned char*)u.x0 + (size_t)(wr * 64 + fr) * (ZN * 2) + wc * 32 + 8 * fq;
        bf16_t* base = (bf16_t*)u.dst + (size_t)(wr * 64 + fr) * DM + wc * 32 + 8 * fq;
        const int gboff = LAST ? 0 : DM; const unsigned lastmask = LAST ? 0xffffffffu : 0u;
        u32x2 ga[2][2][2], gb[2][2][2];
#pragma unroll
        for (int mm = 0; mm < 2; ++mm)
#pragma unroll
            for (int bj = 0; bj < 2; ++bj) { const unsigned char* rp = g0 + (size_t)(mm * 16) * (ZN * 2) + bj * HALF; ga[0][mm][bj] = *(const u32x2*)rp; gb[0][mm][bj] = *(const u32x2*)(rp + gboff); }
#pragma unroll
        for (int am = 0; am < 4; ++am) { const int ai = am >> 1, m0 = (am & 1) * 2, cb_ = am & 1, nb_ = cb_ ^ 1;
            if (am < 3) { const int ai2 = (am + 1) >> 1, m02 = ((am + 1) & 1) * 2;
#pragma unroll
                for (int mm = 0; mm < 2; ++mm)
#pragma unroll
                    for (int bj = 0; bj < 2; ++bj) { const unsigned char* rp = g0 + (size_t)(ai2 * HALF + (m02 + mm) * 16) * (ZN * 2) + bj * HALF; ga[nb_][mm][bj] = *(const u32x2*)rp; gb[nb_][mm][bj] = *(const u32x2*)(rp + gboff); } }
            asm volatile("" ::: "memory");
#pragma unroll
            for (int mm = 0; mm < 2; ++mm)
#pragma unroll
                for (int bj = 0; bj < 2; ++bj) { const int m = m0 + mm;
                    f32x4 v0 = acc[ai][bj][m][0], v1 = acc[ai][bj][m][1];
#pragma unroll
                    for (int h2 = 0; h2 < 2; ++h2) { const unsigned wa = ga[cb_][mm][bj][h2], wb = gb[cb_][mm][bj][h2] | lastmask;
#pragma unroll
                        for (int e = 0; e < 4; ++e) { const float sa = (float)((wa >> (8 * e)) & 0xffu), sb = (float)((wb >> (8 * e)) & 0xffu);
                            const float f = sa * __builtin_amdgcn_rcpf(sb);
                            if (h2 == 0) v0[e] *= f; else v1[e] *= f; } }
                    acc[ai][bj][m][0] = v0; acc[ai][bj][m][1] = v1;
                    if (LAST) { u32x4 w; w.x = cvt_pk_bf16(v0[0], v0[1]); w.y = cvt_pk_bf16(v0[2], v0[3]); w.z = cvt_pk_bf16(v1[0], v1[1]); w.w = cvt_pk_bf16(v1[2], v1[3]);
                        *(u32x4*)(base + (size_t)(ai * HALF + m * 16) * DM + bj * HALF) = w; }
                }
        }
    }
    __device__ __forceinline__ bool operator()(f32x4 (&acc)[2][2][4][2], const Unit& u, int wr, int wc, int fr, int fq) const {
        const bool last = (u.seg == 3); apply(last, acc, u, wr, wc, fr, fq); return last;
    }
};

template <class Epi, class Sched>
__device__ __forceinline__ void gemm_phase(LAS unsigned char* lds, const Gemm g, const Sched& S, const Epi& E, const int tid) {
    const int wid = __builtin_amdgcn_readfirstlane(tid >> 6), lane = tid & 63, wr = wid >> 2, wc = wid & 3, fr = lane & 15, fq = lane >> 4;
    unsigned voffA[2], voffB[2];
#pragma unroll
    for (int i = 0; i < 2; ++i) { int R, C; stage_rc(tid * 16 + i * 8192, R, C); const int Rb = Epi::PERM ? ((R & ~31) + perm32(R & 31)) : R;
        voffA[i] = (unsigned)(R * g.lda + C) * 2u; voffB[i] = (unsigned)(Rb * g.ldb + C) * 2u; }
    const size_t kstep = (size_t)(BK * 2);
    const size_t hstepA = (size_t)HALF * g.lda * 2, hstepB = (size_t)HALF * g.ldb * 2;
    const unsigned ldsw = (unsigned)wid * 1024u;
    const int aoff = lds_byte(wr * 64 + fr, fq * 8), boff = lds_byte(wc * 32 + fr, fq * 8);
#define PG8_SA(b, h) (((b) * 2 + (h)) * HTB)
#define PG8_SB(b, h) ((4 + (b) * 2 + (h)) * HTB)
#define PG8_STAGE(bufoff, gbase, voff) do { _Pragma("unroll") for (int _i = 0; _i < 2; ++_i) \
        __builtin_amdgcn_global_load_lds((const unsigned*)((const char*)(gbase) + (voff)[_i]), (LAS unsigned*)(lds + (bufoff) + ldsw + _i * 8192), 16, 0, 0); } while (0)
#define PG8_LDA(dst, b, h) do { _Pragma("unroll") for (int m = 0; m < 4; ++m) _Pragma("unroll") for (int k = 0; k < 2; ++k) dst[m][k] = *(const LAS bf16x8*)(lds + PG8_SA(b, h) + aoff + m * 2048 + k * 1024); } while (0)
#define PG8_LDB(dst, b, h) do { _Pragma("unroll") for (int n = 0; n < 2; ++n) _Pragma("unroll") for (int k = 0; k < 2; ++k) dst[n][k] = *(const LAS bf16x8*)(lds + PG8_SB(b, h) + boff + n * 2048 + k * 1024); } while (0)
#define PG8_MMA(ai, bj, At, Bt) do { __builtin_amdgcn_s_setprio(1); _Pragma("unroll") for (int m = 0; m < 4; ++m) _Pragma("unroll") for (int n = 0; n < 2; ++n) _Pragma("unroll") for (int k = 0; k < 2; ++k) \
        acc[ai][bj][m][n] = __builtin_amdgcn_mfma_f32_16x16x32_bf16(Bt[n][k], At[m][k], acc[ai][bj][m][n], 0, 0, 0); __builtin_amdgcn_s_setprio(0); } while (0)
#define PG8_WAIT_V(n) asm volatile("s_waitcnt vmcnt(" #n ")" ::: "memory")
#define PG8_WAIT_L(n) asm volatile("s_waitcnt lgkmcnt(" #n ")" ::: "memory")
#define PG8_BAR __builtin_amdgcn_s_barrier()
#define PG8_SCHED __builtin_amdgcn_sched_barrier(0)
    Unit cur, nxt; int ui = 0;
    if (!S.next(0, cur)) return;
    f32x4 acc[2][2][4][2];
#pragma unroll
    for (int a = 0; a < 2; ++a)
#pragma unroll
        for (int b = 0; b < 2; ++b)
#pragma unroll
            for (int m = 0; m < 4; ++m)
#pragma unroll
                for (int n = 0; n < 2; ++n) acc[a][b][m][n] = (f32x4){0.f, 0.f, 0.f, 0.f};
    bf16x8 At[4][2], B0[2][2], B1[2][2];
    const char* cA = cur.a; const char* cB = cur.b;
    PG8_STAGE(PG8_SB(0, 0), cB, voffB); PG8_STAGE(PG8_SB(0, 1), cB + hstepB, voffB); PG8_STAGE(PG8_SA(0, 0), cA, voffA); PG8_STAGE(PG8_SA(0, 1), cA + hstepA, voffA);
    if (wr == 1) PG8_BAR;
    PG8_WAIT_V(2); PG8_BAR;
    PG8_STAGE(PG8_SB(1, 0), cB + kstep, voffB); PG8_STAGE(PG8_SA(1, 0), cA + kstep, voffA); PG8_STAGE(PG8_SB(1, 1), cB + hstepB + kstep, voffB);
    PG8_WAIT_V(6); PG8_BAR;
    for (;;) {
        const bool has_next = S.next(ui + 1, nxt);
        const char* nA = has_next ? nxt.a : cA; const char* nB = has_next ? nxt.b : cB;
        const int nt = cur.nt;
        for (int t = 0; t < nt; t += 2) {
            const bool last = (t == nt - 2);
            const char* a1 = cA + (size_t)(t + 1) * kstep;
            const char* a2 = last ? nA : cA + (size_t)(t + 2) * kstep; const char* b2 = last ? nB : cB + (size_t)(t + 2) * kstep;
            const char* a3 = a2 + kstep; const char* b3 = b2 + kstep;
            PG8_LDB(B0, 0, 0); PG8_LDB(B1, 0, 1); PG8_SCHED; PG8_LDA(At, 0, 0); PG8_STAGE(PG8_SA(1, 1), a1 + hstepA, voffA);
            PG8_WAIT_V(8); PG8_WAIT_L(0); PG8_BAR; PG8_MMA(0, 0, At, B0); PG8_MMA(0, 1, At, B1); PG8_BAR; PG8_SCHED;
            PG8_LDA(At, 0, 1); PG8_STAGE(PG8_SB(0, 0), b2, voffB); PG8_STAGE(PG8_SB(0, 1), b2 + hstepB, voffB); PG8_STAGE(PG8_SA(0, 0), a2, voffA);
            PG8_WAIT_V(8); PG8_WAIT_L(0); PG8_BAR; PG8_MMA(1, 0, At, B0); PG8_MMA(1, 1, At, B1); PG8_BAR; PG8_SCHED;
            PG8_LDB(B0, 1, 0); PG8_LDB(B1, 1, 1); PG8_SCHED; PG8_LDA(At, 1, 0); PG8_STAGE(PG8_SA(0, 1), a2 + hstepA, voffA);
            PG8_WAIT_V(8); PG8_WAIT_L(0); PG8_BAR; PG8_MMA(0, 0, At, B0); PG8_MMA(0, 1, At, B1); PG8_BAR; PG8_SCHED;
            PG8_LDA(At, 1, 1); PG8_STAGE(PG8_SB(1, 0), b3, voffB); PG8_STAGE(PG8_SB(1, 1), b3 + hstepB, voffB); PG8_STAGE(PG8_SA(1, 0), a3, voffA);
            PG8_WAIT_V(8); PG8_WAIT_L(0); PG8_BAR; PG8_MMA(1, 0, At, B0); PG8_MMA(1, 1, At, B1); PG8_BAR; PG8_SCHED;
        }
        if (wr == 0) PG8_BAR;
        const bool zero = E(acc, cur, wr, wc, fr, fq);
        if (!has_next) break;
        if (zero) {
#pragma unroll
            for (int a = 0; a < 2; ++a)
#pragma unroll
                for (int b = 0; b < 2; ++b)
#pragma unroll
                    for (int m = 0; m < 4; ++m)
#pragma unroll
                        for (int n = 0; n < 2; ++n) acc[a][b][m][n] = (f32x4){0.f, 0.f, 0.f, 0.f};
        }
        cur = nxt; cA = nA; cB = nB; ++ui;
        if (wr == 1) PG8_BAR;
    }
    PG8_WAIT_V(0);
    PG8_BAR;
#undef PG8_SA
#undef PG8_SB
#undef PG8_STAGE
#undef PG8_LDA
#undef PG8_LDB
#undef PG8_MMA
#undef PG8_WAIT_V
#undef PG8_WAIT_L
#undef PG8_BAR
#undef PG8_SCHED
}
}

struct Args { const float* in[27]; float* out; unsigned char* ws; int ph_lo, ph_hi; };
typedef const __attribute__((address_space(4))) Args* ArgP;
enum { I_X = 0, I_C, I_CTX, I_CCTX, I_WMOD, I_BMOD, I_G1, I_G2, I_WIN, I_CONVW, I_CONVB, I_WA, I_BA, I_WX, I_BX, I_LAM, I_POOLW, I_POOLS, I_SCW,
       I_BRL, I_BRF, I_BRP, I_BRS, I_WOUT, I_FF1, I_FF2, I_GF };

struct Sched {
    int kind, l, ch, G, c;
    ArgP ap;
    __device__ __forceinline__ bool next(int i, pg8::Unit& u) const {
        unsigned char* ws = ap->ws;
        const long L = (long)i * G + c;
        const int nM = (l == 0) ? RT / 256 : RL / 256;
        u.x0 = nullptr; u.x1 = nullptr; u.seg = 0;
        int pm, pn;
        if (kind == 1) {
            const char* U = (const char*)(ws + WS_U);
            const int nZ = nM * 24;
            long L2 = L - nZ; bool isz = false;
            if (L < nZ) { pg8::tile_of(L, nM, 24, pm, pn); isz = true; }
            else if (l == 1) { if (L2 < 32) { pm = 128 + (int)(L2 >> 1); pn = (int)(L2 & 1); isz = true; } else L2 -= 32; }
            if (isz) {
                u.a = U + (size_t)pm * 256 * DM * 2; u.b = (const char*)(ws + WS_WIN) + ((size_t)l * WN + (size_t)pn * 256) * DM * 2; u.nt = 16;
                u.dst = (char*)(ws + WS_Z) + (size_t)pm * 256 * ZN * 2 + (pn < 8 ? (size_t)pn * 512 : (size_t)4096 + (size_t)(pn - 8) * 256); u.seg = (pn >= 8) ? 2 : 0; return true;
            }
            if (L2 >= 2 * nM) return false;
            const int seg = (int)(L2 & 1), tt = (int)(L2 >> 1);
            u.a = (const char*)(ws + WS_WF) + ((size_t)l * 512 + (size_t)seg * 256) * DM * 2; u.b = U + (size_t)tt * 256 * DM * 2; u.nt = 16;
            if (tt < 128) u.dst = (char*)(ws + WS_PT) + ((size_t)(tt >> 3) * 256 * 4096 + (size_t)seg * 2048 + (size_t)(tt & 7) * 256) * 2;
            else u.dst = (char*)(ws + WS_PTC) + ((size_t)(tt - 128) * 256 * 4096 + (size_t)seg * 256) * 2;
            return true;
        }
        if (kind == 7) {
            if (!pg8::tile_of(L, nM, 16, pm, pn)) return false;
            u.a = (const char*)(ws + WS_U) + (size_t)pm * 256 * DM * 2; u.b = (const char*)(ws + WS_W1) + ((size_t)l * DFF + (size_t)pn * 256) * DM * 2; u.nt = 16;
            u.dst = (char*)(ws + WS_Z) + ((size_t)pm * 256 * DFF + (size_t)pn * 256) * 2; return true;
        }
        if (kind == 2) {
            if (L < 128) { const int b_ = (int)(L >> 3), kt = (int)(L & 7);
                u.a = (const char*)(ws + WS_DFT) + (size_t)kt * 256 * 4096 * 2; u.b = (const char*)(ws + WS_PT) + (size_t)b_ * 256 * 4096 * 2; u.nt = 64;
                u.dst = (char*)(ws + WS_Y) + ((size_t)(b_ * SEQ + kt * 256) * YN + Y_F) * 2; u.seg = 4; return true; }
            if (l == 0 && L < 144) { const int j = (int)L - 128;
                u.a = (const char*)(ws + WS_DFTC); u.b = (const char*)(ws + WS_PTC) + (size_t)j * 256 * 4096 * 2; u.nt = 8;
                u.dst = (char*)(ws + WS_Y) + ((size_t)(RL + j * 256) * YN + Y_F) * 2; u.seg = 8; return true; }
            return false;
        }
        if (kind == 4) {
            const int seg = i & 3; const long T = (long)(i >> 2) * G + c;
            if (!pg8::tile_of(T, nM, 4, pm, pn)) return false;
            const int coff = seg == 0 ? 0 : (256 + 256 * seg);
            u.a = (const char*)(ws + WS_Y) + ((size_t)pm * 256 * YN + coff) * 2; u.b = (const char*)(ws + WS_WBR) + (((size_t)l * DM + (size_t)pn * 256) * YN + coff) * 2;
            u.nt = seg == 0 ? 8 : 4; u.seg = seg;
            u.dst = (char*)(ws + WS_MRG) + ((size_t)pm * 256 * DM + (size_t)pn * 256) * 2;
            u.x0 = (const char*)(ws + WS_Z) + (size_t)pm * 256 * ZN * 2 + 4096 + seg * DM + pn * 256;
            return true;
        }
        if (!pg8::tile_of(L, nM, 4, pm, pn)) return false;
        if (kind == 5) { u.a = (const char*)(ws + WS_MRG) + (size_t)pm * 256 * DM * 2; u.b = (const char*)(ws + WS_WOUT) + ((size_t)l * DM + (size_t)pn * 256) * DM * 2; u.nt = 16; }
        else { u.a = (const char*)(ws + WS_Z) + (size_t)pm * 256 * DFF * 2; u.b = (const char*)(ws + WS_W2) + ((size_t)l * DM + (size_t)pn * 256) * DFF * 2; u.nt = 64; }
        int bidx; size_t eoff;
        if (pm < 128) { eoff = ((size_t)(ch * RL + pm * 256) * DM + pn * 256) * 4; bidx = ch * NB + (pm >> 3);
            char* out = (char*)ap->out; u.dst = out + eoff; u.x0 = (kind == 5 && l == 0) ? (const char*)ap->in[I_X] + eoff : (const char*)out + eoff; }
        else { eoff = ((size_t)(ch * RC + (pm - 128) * 256) * DM + pn * 256) * 4; bidx = 32;
            u.dst = (char*)(ws + WS_CTXW) + eoff; u.x0 = (kind == 5) ? (const char*)ap->in[I_CTX] + eoff : (const char*)(ws + WS_CTXW) + eoff; }
        u.x1 = (const char*)(ws + WS_MOD) + ((size_t)((l * 33 + bidx) * 6 + (kind == 5 ? 2 : 5)) * DM + pn * 256) * 4;
        return true;
    }
};

__device__ __forceinline__ void tr_item(const float* W, int ldw, int col0, int ncols, bf16_t* WT, int ldt, int koff, LAS float* scr, int item, int lane) {
    const int nblk = ncols / 32, kb = item / nblk, nb = item % nblk, k0 = 64 * kb, n0 = 32 * nb;
#pragma unroll 8
    for (int i = 0; i < 32; ++i) { const int kk = 2 * i + (lane >> 5); scr[kk * 33 + (lane & 31)] = W[(size_t)(k0 + kk) * ldw + col0 + n0 + (lane & 31)]; }
    LDS_WAIT(); asm volatile("" ::: "memory");
    const int c = lane & 7;
#pragma unroll
    for (int j = 0; j < 4; ++j) { const int n = (lane >> 3) + 8 * j; const LAS float* s = scr + (8 * c) * 33 + n;
        u32x4 o; o.x = cvt_pk_bf16(s[0 * 33], s[1 * 33]); o.y = cvt_pk_bf16(s[2 * 33], s[3 * 33]); o.z = cvt_pk_bf16(s[4 * 33], s[5 * 33]); o.w = cvt_pk_bf16(s[6 * 33], s[7 * 33]);
        *(u32x4*)(WT + (size_t)(n0 + n) * ldt + koff + k0 + 8 * c) = o; }
    LDS_WAIT(); asm volatile("" ::: "memory");
}

__device__ __forceinline__ void p0_prologue(ArgP A, LAS unsigned char* lds, int G, const int tid) {
    const int lane = tid & 63, wave = tid >> 6, bx = blockIdx.x;
    unsigned char* ws = A->ws;
    if (bx < 192) {
        const int l = bx / 96, cb = bx % 96, n = cb * 64 + lane;
        LAS float* sl = (LAS float*)lds;
        for (int idx = tid; idx < 33 * 1024; idx += 512) { const int bb = idx >> 10, k = idx & 1023; const float v = bb < 32 ? A->in[I_C][bb * 1024 + k] : A->in[I_CCTX][k]; sl[idx] = v * sigm(v); }
        __syncthreads();
        float acc[33];
#pragma unroll
        for (int bb = 0; bb < 33; ++bb) acc[bb] = 0.f;
        const float* wp = A->in[I_WMOD] + ((size_t)l * 1024 + wave * 128) * 6144 + n;
        for (int k4 = 0; k4 < 32; ++k4) {
            const float w0 = wp[(size_t)(4 * k4 + 0) * 6144], w1 = wp[(size_t)(4 * k4 + 1) * 6144], w2 = wp[(size_t)(4 * k4 + 2) * 6144], w3 = wp[(size_t)(4 * k4 + 3) * 6144];
#pragma unroll
            for (int bb = 0; bb < 33; ++bb) { const f32x4 s = *(const LAS f32x4*)(sl + bb * 1024 + wave * 128 + 4 * k4); acc[bb] += s[0] * w0 + s[1] * w1 + s[2] * w2 + s[3] * w3; }
        }
        __syncthreads();
        LAS float* red = (LAS float*)lds;
#pragma unroll
        for (int bb = 0; bb < 33; ++bb) red[(wave * 33 + bb) * 64 + lane] = acc[bb];
        __syncthreads();
        float* MOD = (float*)(ws + WS_MOD);
        for (int idx = tid; idx < 33 * 64; idx += 512) { const int bb = idx >> 6, ln = idx & 63; float s = A->in[I_BMOD][l * 6144 + cb * 64 + ln];
#pragma unroll
            for (int w = 0; w < 8; ++w) s += red[(w * 33 + bb) * 64 + ln];
            MOD[(size_t)(l * 33 + bb) * 6144 + cb * 64 + ln] = s; }
        __syncthreads();
    } else if (bx < 224) {
        const int it = bx - 192, l = it >> 4, k0 = (it & 15) * 64;
        LAS float* wt = (LAS float*)lds;
        LAS float* tab = (LAS float*)(lds + 65536);
        for (int idx = tid; idx < 64 * 256; idx += 512) { const int kk = idx >> 8, c = idx & 255; wt[idx] = A->in[I_WIN][((size_t)l * 1024 + k0 + kk) * NIN + 1024 + c]; }
        { const int i = tid & 255; tab[tid] = (tid < 256) ? cospif((float)i / 128.f) : sinpif((float)i / 128.f); }
        __syncthreads();
        const int m = tid & 255; const LAS float* tb = tab + (tid >> 8) * 256;
        bf16_t* WF = (bf16_t*)(ws + WS_WF) + ((size_t)l * 512 + tid) * DM + k0;
        for (int kg = 0; kg < 8; ++kg) {
            float a[8];
#pragma unroll
            for (int q = 0; q < 8; ++q) a[q] = 0.f;
            for (int c = 0; c < 256; ++c) { const float tv = tb[(m * c) & 255];
#pragma unroll
                for (int q = 0; q < 8; ++q) a[q] += wt[(kg * 8 + q) * 256 + c] * tv; }
            u32x4 o; o.x = cvt_pk_bf16(a[0], a[1]); o.y = cvt_pk_bf16(a[2], a[3]); o.z = cvt_pk_bf16(a[4], a[5]); o.w = cvt_pk_bf16(a[6], a[7]);
            *(u32x4*)(WF + kg * 8) = o;
        }
        __syncthreads();
    }
    {
        LAS float* scr = (LAS float*)(lds + wave * 16384);
        const int gw = wave * G + bx, NGW = G * 8;
        for (int it = gw; it < 16384; it += NGW) {
            const int l = it >> 13; int r = it & 8191;
            const float* win = A->in[I_WIN] + (size_t)l * 1024 * NIN;
            bf16_t* WIN = (bf16_t*)(ws + WS_WIN) + (size_t)l * WN * DM;
            bf16_t* WBR = (bf16_t*)(ws + WS_WBR) + (size_t)l * DM * YN;
            if (r < 512) { tr_item(win, NIN, 0, 1024, WIN, DM, 0, scr, r, lane); continue; } r -= 512;
            if (r < 2560) { tr_item(win, NIN, 1280, 5120, WIN + (size_t)1024 * DM, DM, 0, scr, r, lane); continue; } r -= 2560;
            if (r < 256) { tr_item(A->in[I_BRL] + (size_t)l * 512 * DM, DM, 0, DM, WBR, YN, 0, scr, r, lane); continue; } r -= 256;
            if (r < 128) { tr_item(A->in[I_BRF] + (size_t)l * 256 * DM, DM, 0, DM, WBR, YN, Y_F, scr, r, lane); continue; } r -= 128;
            if (r < 128) { tr_item(A->in[I_BRS] + (size_t)l * 256 * DM, DM, 0, DM, WBR, YN, Y_SC, scr, r, lane); continue; } r -= 128;
            if (r < 512) { tr_item(A->in[I_WOUT] + (size_t)l * DM * DM, DM, 0, DM, (bf16_t*)(ws + WS_WOUT) + (size_t)l * DM * DM, DM, 0, scr, r, lane); continue; } r -= 512;
            if (r < 2048) { tr_item(A->in[I_FF1] + (size_t)l * DM * DFF, DFF, 0, DFF, (bf16_t*)(ws + WS_W1) + (size_t)l * DFF * DM, DM, 0, scr, r, lane); continue; } r -= 2048;
            tr_item(A->in[I_FF2] + (size_t)l * DFF * DM, DM, 0, DM, (bf16_t*)(ws + WS_W2) + (size_t)l * DM * DFF, DFF, 0, scr, r, lane);
        }
    }
    const int gt = bx * 512 + tid, NGT = G * 512;
    {
        bf16_t* WG = (bf16_t*)(ws + WS_WG);
        for (int idx = gt; idx < 2 * 8 * 256 * 64; idx += NGT) { const int i = idx & 63, n = (idx >> 6) & 255, h = (idx >> 14) & 7, l = idx >> 17, d = n >> 7, gate = (n >> 6) & 1, j = n & 63;
            const float v = (gate ? A->in[I_WX] : A->in[I_WA])[((size_t)((l * 2 + d) * 8 + h) * 64 + i) * 64 + j];
            WG[idx] = (bf16_t)(cvt_pk_bf16(v, 0.f) & 0xffffu); }
    }
    {
        for (int idx = gt; idx < 2 * 256 * 1024; idx += NGT) { const int n = idx & 1023, i = (idx >> 10) & 255, l = idx >> 18, g = i >> 6, il = i & 63;
            const float* pw = A->in[I_POOLW] + ((size_t)(l * 4 + g) * 64 + il) * 64; const float* ps = A->in[I_POOLS] + l * 256 + g * 64; const float* wb = A->in[I_BRP] + ((size_t)l * 256 + g * 64) * DM + n;
            float s = 0.f;
            for (int j = 0; j < 64; ++j) s += pw[j] * ps[j] * wb[(size_t)j * DM];
            ((bf16_t*)(ws + WS_WBR))[((size_t)l * DM + n) * YN + Y_POOL + i] = (bf16_t)(cvt_pk_bf16(s, 0.f) & 0xffffu); }
    }
    {
        bf16_t* DF = (bf16_t*)(ws + WS_DFT);
        for (int idx = gt; idx < 2048 * 512; idx += NGT) { const int k = idx >> 9, n8 = (idx & 511) * 8; float v[8];
#pragma unroll
            for (int e = 0; e < 8; ++e) { const int np = n8 + e; if (np < 2048) v[e] = cospif((float)((k * np) & 2047) * (1.f / 1024.f)); else v[e] = -sinpif((float)((k * (np - 2048)) & 2047) * (1.f / 1024.f)); }
            u32x4 o; o.x = cvt_pk_bf16(v[0], v[1]); o.y = cvt_pk_bf16(v[2], v[3]); o.z = cvt_pk_bf16(v[4], v[5]); o.w = cvt_pk_bf16(v[6], v[7]);
            *(u32x4*)(DF + (size_t)k * 4096 + n8) = o; }
        bf16_t* DC = (bf16_t*)(ws + WS_DFTC);
        for (int idx = gt; idx < 256 * 64; idx += NGT) { const int k = idx >> 6, n8 = (idx & 63) * 8; float v[8];
#pragma unroll
            for (int e = 0; e < 8; ++e) { const int np = n8 + e; if (np < 256) v[e] = cospif((float)((k * np) & 255) * (1.f / 128.f)); else v[e] = -sinpif((float)((k * (np - 256)) & 255) * (1.f / 128.f)); }
            u32x4 o; o.x = cvt_pk_bf16(v[0], v[1]); o.y = cvt_pk_bf16(v[2], v[3]); o.z = cvt_pk_bf16(v[4], v[5]); o.w = cvt_pk_bf16(v[6], v[7]);
            *(u32x4*)(DC + (size_t)k * 4096 + n8) = o; }
    }
}

__device__ __forceinline__ void norm_phase(ArgP A, int l, int ch, bool second, int r_begin, int r_end, int r_step, const int tid) {
    const int lane = tid & 63, wave = tid >> 6;
    unsigned char* ws = A->ws;
    const int nrows = (second && l == 1) ? RL : RT, rend = r_end < nrows ? r_end : nrows;
    const float* gn = (second ? A->in[I_G2] : A->in[I_G1]) + l * DM;
    const float* MOD = (const float*)(ws + WS_MOD);
    bf16_t* U = (bf16_t*)(ws + WS_U);
    for (int r0 = r_begin + wave; r0 < rend; r0 += 2 * r_step) {
        const float* src[2]; const float* sh[2]; int rr[2]; bool ok[2];
#pragma unroll
        for (int q = 0; q < 2; ++q) { const int rq = r0 + q * r_step; ok[q] = rq < rend; const int r = ok[q] ? rq : r0; rr[q] = r; int bidx;
            if (r < RL) { const size_t grow = (size_t)ch * RL + r; src[q] = ((!second && l == 0) ? A->in[I_X] : (const float*)A->out) + grow * DM; bidx = ch * NB + (r >> 11); }
            else { const size_t grow = (size_t)ch * RC + (r - RL); src[q] = ((!second && l == 0) ? A->in[I_CTX] : (const float*)(ws + WS_CTXW)) + grow * DM; bidx = 32; }
            sh[q] = MOD + (size_t)((l * 33 + bidx) * 6 + (second ? 3 : 0)) * DM; }
        f32x4 v[2][4]; float s[2] = {0.f, 0.f};
#pragma unroll
        for (int q = 0; q < 2; ++q)
#pragma unroll
            for (int j = 0; j < 4; ++j) v[q][j] = *(const f32x4*)(src[q] + 4 * (lane + 64 * j));
#pragma unroll
        for (int q = 0; q < 2; ++q) {
#pragma unroll
            for (int j = 0; j < 4; ++j) s[q] += (v[q][j][0] * v[q][j][0] + v[q][j][1] * v[q][j][1]) + (v[q][j][2] * v[q][j][2] + v[q][j][3] * v[q][j][3]);
            s[q] = 1.0f / sqrtf(wave_sum(s[q]) * (1.f / DM) + 1e-6f); }
#pragma unroll
        for (int q = 0; q < 2; ++q) { if (!ok[q]) continue;
#pragma unroll
            for (int j = 0; j < 4; ++j) { const int col = 4 * (lane + 64 * j);
                const f32x4 gg = *(const f32x4*)(gn + col), s1 = *(const f32x4*)(sh[q] + DM + col), s0 = *(const f32x4*)(sh[q] + col);
                const f32x4 o = (v[q][j] * s[q]) * gg * (s1 + 1.0f) + s0;
                u32x2 w; w.x = cvt_pk_bf16(o[0], o[1]); w.y = cvt_pk_bf16(o[2], o[3]);
                *(u32x2*)(U + (size_t)rr[q] * DM + col) = w; } }
    }
}
__device__ __forceinline__ void final_norm(ArgP A, int G, const int tid) {
    const int lane = tid & 63, wave = tid >> 6;
    const float* gn = A->in[I_GF];
    for (int r0 = blockIdx.x * 8 + wave; r0 < NBATCH * SEQ; r0 += 2 * G * 8) {
        float* p[2]; f32x4 v[2][4]; float s[2] = {0.f, 0.f};
#pragma unroll
        for (int q = 0; q < 2; ++q) { int r = r0 + q * G * 8; if (r >= NBATCH * SEQ) r = r0; p[q] = A->out + (size_t)r * DM;
#pragma unroll
            for (int j = 0; j < 4; ++j) v[q][j] = *(const f32x4*)(p[q] + 4 * (lane + 64 * j)); }
#pragma unroll
        for (int q = 0; q < 2; ++q) {
#pragma unroll
            for (int j = 0; j < 4; ++j) s[q] += (v[q][j][0] * v[q][j][0] + v[q][j][1] * v[q][j][1]) + (v[q][j][2] * v[q][j][2] + v[q][j][3] * v[q][j][3]);
            s[q] = 1.0f / sqrtf(wave_sum(s[q]) * (1.f / DM) + 1e-6f); }
#pragma unroll
        for (int q = 0; q < 2; ++q)
#pragma unroll
            for (int j = 0; j < 4; ++j) { const int col = 4 * (lane + 64 * j); const f32x4 gg = *(const f32x4*)(gn + col); *(f32x4*)(p[q] + col) = (v[q][j] * s[q]) * gg; }
    }
}

__device__ __forceinline__ void unpack8(const u32x4 w, float (&f)[8]) {
#pragma unroll
    for (int e = 0; e < 4; ++e) { f[2 * e] = bf_lo(w[e]); f[2 * e + 1] = bf_hi(w[e]); }
}
__device__ __forceinline__ u32x4 pack8(const float (&f)[8]) { u32x4 o; o.x = cvt_pk_bf16(f[0], f[1]); o.y = cvt_pk_bf16(f[2], f[3]); o.z = cvt_pk_bf16(f[4], f[5]); o.w = cvt_pk_bf16(f[6], f[7]); return o; }

__device__ __forceinline__ void lru_item(ArgP A, int l, int it, bool pass2, LAS unsigned char* lds, const int tid) {
    const int lane = tid & 63, wid = tid >> 6;
    unsigned char* ws = A->ws;
    const int head = it & 7, rest = it >> 3;
    int sc, bl;
    if (!pass2 || l == 0) { sc = rest % NSC; bl = rest / NSC; } else { sc = 4 + (rest & 31); bl = rest >> 5; }
    const bool isctx = sc < 4; const int c = isctx ? sc : sc - 4, Lseq = isctx ? CTXL : SEQ, rowbase = isctx ? RL + bl * CTXL : bl * SEQ, t0 = c * 64;
    const bf16_t* Z = (const bf16_t*)(ws + WS_Z);
    LAS float* xaf = (LAS float*)lds;
    LAS bf16_t* xab = (LAS bf16_t*)(lds + 17408);
    LAS float* hbuf = (LAS float*)(lds + 32768);
    {
        const int t = tid >> 3, i8 = (tid & 7) * 8, tok = t0 + t, Cc = head * 64 + i8;
        float acc[8];
        { const f32x4 b0 = *(const f32x4*)(A->in[I_CONVB] + l * DLRU + Cc), b1 = *(const f32x4*)(A->in[I_CONVB] + l * DLRU + Cc + 4);
#pragma unroll
          for (int e = 0; e < 4; ++e) { acc[e] = b0[e]; acc[4 + e] = b1[e]; } }
#pragma unroll
        for (int k = 0; k < 4; ++k) { const int tt = tok + k - 2;
            if (tt >= 0 && tt < Lseq) { float z[8]; unpack8(*(const u32x4*)(Z + (size_t)(rowbase + tt) * ZN + Cc), z);
                const float* cw = A->in[I_CONVW] + (size_t)(l * 4 + k) * DLRU + Cc; const f32x4 c0 = *(const f32x4*)cw, c1 = *(const f32x4*)(cw + 4);
#pragma unroll
                for (int e = 0; e < 4; ++e) { acc[e] += z[e] * c0[e]; acc[4 + e] += z[4 + e] * c1[e]; } } }
        *(LAS f32x4*)(xaf + t * 68 + i8) = (f32x4){acc[0], acc[1], acc[2], acc[3]}; *(LAS f32x4*)(xaf + t * 68 + i8 + 4) = (f32x4){acc[4], acc[5], acc[6], acc[7]};
        *(LAS u32x4*)(xab + t * 72 + i8) = pack8(acc);
    }
    __syncthreads();
    {
        const int d = wid >> 2, g = wid & 3, fr = lane & 15, fq = lane >> 4;
        const bf16_t* wb = (const bf16_t*)(ws + WS_WG) + ((size_t)((l * 8 + head) * 256 + d * 128 + 16 * g + fr)) * 64 + 8 * fq;
        bf16x8 wR[2], wG[2];
#pragma unroll
        for (int ks = 0; ks < 2; ++ks) { wR[ks] = *(const bf16x8*)(wb + 32 * ks); wG[ks] = *(const bf16x8*)(wb + 64 * 64 + 32 * ks); }
        const int cb = head * 64 + 16 * g + 4 * fq;
        const f32x4 ba = *(const f32x4*)(A->in[I_BA] + (l * 2 + d) * DLRU + cb), bxv = *(const f32x4*)(A->in[I_BX] + (l * 2 + d) * DLRU + cb), lam = *(const f32x4*)(A->in[I_LAM] + (l * 2 + d) * DLRU + cb);
        f32x4 sp8;
#pragma unroll
        for (int e = 0; e < 4; ++e) sp8[e] = 8.0f * log1pf(__expf(-lam[e]));
        const int p = (d == 0) ? sc : (isctx ? 3 - c : 4 + 31 - c);
        float* SA = (float*)(ws + WS_SUMA) + ((size_t)(bl * 2 + d) * NSC) * DLRU + cb; float* SH = (float*)(ws + WS_SUMH) + ((size_t)(bl * 2 + d) * NSC) * DLRU + cb;
        f32x4 hin = (f32x4){0.f, 0.f, 0.f, 0.f}, Atot = (f32x4){1.f, 1.f, 1.f, 1.f}, Htot = (f32x4){0.f, 0.f, 0.f, 0.f};
        if (pass2) for (int pp = 0; pp < p; ++pp) { const f32x4 a4 = *(const f32x4*)(SA + (size_t)pp * DLRU), h4 = *(const f32x4*)(SH + (size_t)pp * DLRU); hin = a4 * hin + h4; }
        const int lastl = (lane & 48) | (d ? 0 : 15);
#pragma unroll
        for (int q = 0; q < 4; ++q) { const int tt = d ? 3 - q : q;
            f32x4 aR = (f32x4){0.f, 0.f, 0.f, 0.f}, aG = (f32x4){0.f, 0.f, 0.f, 0.f};
#pragma unroll
            for (int ks = 0; ks < 2; ++ks) { const bf16x8 bfrag = *(const LAS bf16x8*)(xab + (16 * tt + fr) * 72 + 8 * fq + 32 * ks);
                aR = __builtin_amdgcn_mfma_f32_16x16x32_bf16(wR[ks], bfrag, aR, 0, 0, 0); aG = __builtin_amdgcn_mfma_f32_16x16x32_bf16(wG[ks], bfrag, aG, 0, 0, 0); }
            const f32x4 xv = *(const LAS f32x4*)(xaf + (16 * tt + fr) * 68 + 16 * g + 4 * fq);
            f32x4 hv;
#pragma unroll
            for (int e = 0; e < 4; ++e) {
                const float r = sigm(aR[e] + ba[e]), gi = sigm(aG[e] + bxv[e]);
                const float la = -r * sp8[e], a = __expf(la), x2 = -2.0f * la;
                const float om = x2 < 0.1f ? x2 * (1.0f - x2 * (0.5f - x2 * (0.16666667f - x2 * 0.041666668f))) : 1.0f - a * a;
                float Av = a, Bv = sqrtf(om) * gi * xv[e];
#pragma unroll
                for (int off = 1; off < 16; off <<= 1) { const int src = d ? lane + off : lane - off; const float Ap = __shfl(Av, src), Bp = __shfl(Bv, src);
                    const bool valid = d ? (fr + off < 16) : (fr >= off); if (valid) { Bv = Av * Bp + Bv; Av = Av * Ap; } }
                if (pass2) { const float h = Av * hin[e] + Bv; hv[e] = h; hin[e] = __shfl(h, lastl); }
                else { const float AT = __shfl(Av, lastl), BT = __shfl(Bv, lastl); Htot[e] = AT * Htot[e] + BT; Atot[e] = Atot[e] * AT; }
            }
            if (pass2) *(LAS f32x4*)(hbuf + ((d * 64 + 16 * tt + fr) * 68 + 16 * g + 4 * fq)) = hv;
        }
        if (!pass2 && fr == 0) { *(f32x4*)(SA + (size_t)p * DLRU) = Atot; *(f32x4*)(SH + (size_t)p * DLRU) = Htot; }
    }
    if (pass2) {
        __syncthreads();
        const int t = tid >> 3, i8 = (tid & 7) * 8, tok = t0 + t, Cc = head * 64 + i8;
        float zg[8]; unpack8(*(const u32x4*)(Z + (size_t)(rowbase + tok) * ZN + Z_LG + Cc), zg);
        const f32x4 h00 = *(const LAS f32x4*)(hbuf + t * 68 + i8), h01 = *(const LAS f32x4*)(hbuf + t * 68 + i8 + 4), h10 = *(const LAS f32x4*)(hbuf + (64 + t) * 68 + i8), h11 = *(const LAS f32x4*)(hbuf + (64 + t) * 68 + i8 + 4);
        float y[8];
#pragma unroll
        for (int e = 0; e < 8; ++e) { const float hs = e < 4 ? h00[e & 3] + h10[e & 3] : h01[e & 3] + h11[e & 3]; const float x = zg[e];
            const float u2 = 1.5957691216057308f * (x + 0.044715f * x * x * x);
            y[e] = hs * x * sigm(u2); }
        *(u32x4*)((bf16_t*)(ws + WS_Y) + (size_t)(rowbase + tok) * YN + Cc) = pack8(y);
    }
}

__device__ __forceinline__ void sweep_chunk(int d, int j, int bl, int& rowbase, int& t0, int& Lseq, bool& isctx) {
    isctx = j < 4; const int c = isctx ? (d ? 3 - j : j) : (d ? 35 - j : j - 4);
    Lseq = isctx ? CTXL : SEQ; rowbase = isctx ? RL + bl * CTXL : bl * SEQ; t0 = c * 64;
}
__device__ __forceinline__ void lru_sweep(ArgP A, int l, int item, LAS unsigned char* lds, const int tid) {
    unsigned char* ws = A->ws;
    const int lane = tid & 63, wid = tid >> 6, d = wid >> 2, g = wid & 3, fr = lane & 15, fq = lane >> 4, hl = tid & 255;
    const int head = item & 7, bl = item >> 3;
    const bf16_t* Z = (const bf16_t*)(ws + WS_Z);
    LAS float* cwl = (LAS float*)(lds + 106496);
    __syncthreads();
    if (tid < 256) cwl[tid] = A->in[I_CONVW][(size_t)(l * 4 + (tid >> 6)) * DLRU + head * 64 + (tid & 63)];
    else if (tid < 320) cwl[tid] = A->in[I_CONVB][l * DLRU + head * 64 + (tid - 256)];
    const bf16_t* wb = (const bf16_t*)(ws + WS_WG) + ((size_t)((l * 8 + head) * 256 + d * 128 + 16 * g + fr)) * 64 + 8 * fq;
    bf16x8 wR[2], wG[2];
#pragma unroll
    for (int ks = 0; ks < 2; ++ks) { wR[ks] = *(const bf16x8*)(wb + 32 * ks); wG[ks] = *(const bf16x8*)(wb + 64 * 64 + 32 * ks); }
    const int cb = head * 64 + 16 * g + 4 * fq;
    const f32x4 ba = *(const f32x4*)(A->in[I_BA] + (l * 2 + d) * DLRU + cb), bxv = *(const f32x4*)(A->in[I_BX] + (l * 2 + d) * DLRU + cb), lam = *(const f32x4*)(A->in[I_LAM] + (l * 2 + d) * DLRU + cb);
    const float LOG2E = 1.4426950408889634f;
    f32x4 spl2; const f32x4 nba = ba * (-LOG2E), nbx = bxv * (-LOG2E);
#pragma unroll
    for (int e = 0; e < 4; ++e) { const float sp8 = 8.0f * log1pf(__expf(-lam[e])); spl2[e] = sp8 * LOG2E; }
    float* HX = (float*)(ws + (d ? WS_HB : WS_HF));
    const int lastl = lane | 15;
    const int ct = hl >> 2, ci = (hl & 3) * 16;
    f32x4 hin = (f32x4){0.f, 0.f, 0.f, 0.f};
#define SWEEP_LOAD(zr, jj) do { int rb_, t0_, Ls_; bool ic_; sweep_chunk(d, (jj) < NSC ? (jj) : NSC - 1, bl, rb_, t0_, Ls_, ic_); \
        _Pragma("unroll") for (int k = 0; k < 4; ++k) { const int tt_ = t0_ + ct + k - 2; const bool ok_ = (tt_ >= 0 && tt_ < Ls_); const int tc_ = ok_ ? tt_ : t0_ + ct; \
            const bf16_t* zp_ = Z + (size_t)(rb_ + tc_) * ZN + head * 64 + ci; const u32x4 l0_ = *(const u32x4*)zp_, l1_ = *(const u32x4*)(zp_ + 8); const unsigned mk_ = ok_ ? 0xffffffffu : 0u; \
            zr[k][0] = l0_ & mk_; zr[k][1] = l1_ & mk_; } } while (0)
#define SWEEP_CONV(zr, bufi) do { LAS float* xaf_ = (LAS float*)(lds + d * 53248 + (bufi) * 26624); LAS bf16_t* xab_ = (LAS bf16_t*)(lds + d * 53248 + (bufi) * 26624 + 17408); \
        _Pragma("unroll") for (int hf_ = 0; hf_ < 2; ++hf_) { float acc[8]; \
            { const f32x4 b0_ = *(const LAS f32x4*)(cwl + 256 + ci + 8 * hf_), b1_ = *(const LAS f32x4*)(cwl + 256 + ci + 8 * hf_ + 4); _Pragma("unroll") for (int e = 0; e < 4; ++e) { acc[e] = b0_[e]; acc[4 + e] = b1_[e]; } } \
            _Pragma("unroll") for (int k = 0; k < 4; ++k) { float z[8]; unpack8(zr[k][hf_], z); \
                const f32x4 w0_ = *(const LAS f32x4*)(cwl + k * 64 + ci + 8 * hf_), w1_ = *(const LAS f32x4*)(cwl + k * 64 + ci + 8 * hf_ + 4); \
                _Pragma("unroll") for (int e = 0; e < 4; ++e) { acc[e] += z[e] * w0_[e]; acc[4 + e] += z[4 + e] * w1_[e]; } } \
            *(LAS f32x4*)(xaf_ + ct * 68 + ci + 8 * hf_) = (f32x4){acc[0], acc[1], acc[2], acc[3]}; *(LAS f32x4*)(xaf_ + ct * 68 + ci + 8 * hf_ + 4) = (f32x4){acc[4], acc[5], acc[6], acc[7]}; \
            *(LAS u32x4*)(xab_ + ct * 72 + ci + 8 * hf_) = pack8(acc); } } while (0)
#define SCAN_LVL(N) "v_fmac_f32_dpp %0, %0, %4 row_shr:" #N " row_mask:0xf bank_mask:0xf\n\tv_fmac_f32_dpp %1, %1, %5 row_shr:" #N " row_mask:0xf bank_mask:0xf\n\t" \
                    "v_fmac_f32_dpp %2, %2, %6 row_shr:" #N " row_mask:0xf bank_mask:0xf\n\tv_fmac_f32_dpp %3, %3, %7 row_shr:" #N " row_mask:0xf bank_mask:0xf\n\t" \
                    "v_mul_f32_dpp %4, %4, %4 row_shr:" #N " row_mask:0xf bank_mask:0xf\n\tv_mul_f32_dpp %5, %5, %5 row_shr:" #N " row_mask:0xf bank_mask:0xf\n\t" \
                    "v_mul_f32_dpp %6, %6, %6 row_shr:" #N " row_mask:0xf bank_mask:0xf\n\tv_mul_f32_dpp %7, %7, %7 row_shr:" #N " row_mask:0xf bank_mask:0xf\n\t"
#define SWEEP_SCAN \
        _Pragma("unroll") \
        for (int q = 0; q < 4; ++q) { const int tt = d ? 3 - q : q, trow = 16 * tt + (d ? 15 - fr : fr); \
            f32x4 aR = (f32x4){0.f, 0.f, 0.f, 0.f}, aG = (f32x4){0.f, 0.f, 0.f, 0.f}; \
        _Pragma("unroll") \
            for (int ks = 0; ks < 2; ++ks) { const bf16x8 bfrag = *(const LAS bf16x8*)(xab + trow * 72 + 8 * fq + 32 * ks); \
                aR = __builtin_amdgcn_mfma_f32_16x16x32_bf16(wR[ks], bfrag, aR, 0, 0, 0); aG = __builtin_amdgcn_mfma_f32_16x16x32_bf16(wG[ks], bfrag, aG, 0, 0, 0); } \
            const f32x4 xv = *(const LAS f32x4*)(xaf + trow * 68 + 16 * g + 4 * fq); \
            f32x4 Av, Bv; \
            { \
                const f32x4 tR = aR * (-LOG2E) + nba, tG = aG * (-LOG2E) + nbx; \
                f32x4 eR, eG; \
        _Pragma("unroll") \
                for (int e = 0; e < 4; ++e) { eR[e] = __builtin_amdgcn_exp2f(tR[e]); eG[e] = __builtin_amdgcn_exp2f(tG[e]); } \
                eR = eR + 1.0f; eG = eG + 1.0f; \
                f32x4 r, gi; \
        _Pragma("unroll") \
                for (int e = 0; e < 4; ++e) { r[e] = __builtin_amdgcn_rcpf(eR[e]); gi[e] = __builtin_amdgcn_rcpf(eG[e]); } \
                const f32x4 ta = r * spl2, x2 = ta * 1.3862943611198906f; \
        _Pragma("unroll") \
                for (int e = 0; e < 4; ++e) Av[e] = __builtin_amdgcn_exp2f(-ta[e]); \
                const f32x4 pser = x2 * (x2 * (x2 * 0.16666667f - 0.5f) + 1.0f), om1 = 1.0f - Av * Av; \
                f32x4 sq; \
        _Pragma("unroll") \
                for (int e = 0; e < 4; ++e) sq[e] = __builtin_amdgcn_sqrtf(x2[e] < 0.02f ? pser[e] : om1[e]); \
                Bv = sq * gi * xv; \
            } \
            { \
                float B0 = Bv[0], B1 = Bv[1], B2 = Bv[2], B3 = Bv[3], A0 = Av[0], A1 = Av[1], A2 = Av[2], A3 = Av[3]; \
                asm volatile("s_nop 1\n\t" SCAN_LVL(1) SCAN_LVL(2) SCAN_LVL(4) SCAN_LVL(8) "s_nop 1" \
                    : "+v"(B0), "+v"(B1), "+v"(B2), "+v"(B3), "+v"(A0), "+v"(A1), "+v"(A2), "+v"(A3)); \
                Av = (f32x4){A0, A1, A2, A3}; Bv = (f32x4){B0, B1, B2, B3}; \
            } \
            const f32x4 hq = Av * hin + Bv; *(f32x4*)(HX + (size_t)(rowbase + t0 + trow) * DLRU + cb) = hq; \
        _Pragma("unroll") \
            for (int e = 0; e < 4; ++e) hin[e] = __shfl(hq[e], lastl); \
        }
    __syncthreads();
    u32x4 za[4][2], zb[4][2];
    { SWEEP_LOAD(zb, 0); SWEEP_LOAD(za, 1); SWEEP_CONV(zb, 0); }
    __syncthreads();
#define SWEEP_STEP(jj, ZL, ZC) do { const int j = (jj); \
        int rowbase, t0, Lseq; bool isctx; sweep_chunk(d, j, bl, rowbase, t0, Lseq, isctx); \
        SWEEP_LOAD(ZL, j + 2); \
        const LAS float* xaf = (const LAS float*)(lds + d * 53248 + (j & 1) * 26624); \
        const LAS bf16_t* xab = (const LAS bf16_t*)(lds + d * 53248 + (j & 1) * 26624 + 17408); \
        SWEEP_SCAN \
        if (j + 1 < NSC) SWEEP_CONV(ZC, (j + 1) & 1); \
        __syncthreads(); } while (0)
    for (int j2 = 0; j2 < NSC; j2 += 2) { SWEEP_STEP(j2, zb, za); SWEEP_STEP(j2 + 1, za, zb); }
#undef SWEEP_STEP
#undef SWEEP_SCAN
#undef SCAN_LVL
#undef SWEEP_LOAD
#undef SWEEP_CONV
    asm volatile("s_waitcnt vmcnt(0)" ::: "memory");
    __syncthreads();
    {
        const float* HF = (const float*)(ws + WS_HF); const float* HB = (const float*)(ws + WS_HB);
        const int t = tid >> 3, i8 = (tid & 7) * 8, Cc = head * 64 + i8;
        for (int sc0 = (l == 0 ? 0 : 4); sc0 < NSC; sc0 += 4) {
            u32x4 zgw[4]; f32x4 f0[4], f1[4], b0[4], b1[4]; int rows[4];
#pragma unroll
            for (int u = 0; u < 4; ++u) { const int sc = sc0 + u; const int row = (sc < 4 ? RL + bl * CTXL + sc * 64 : bl * SEQ + (sc - 4) * 64) + t; rows[u] = row;
                zgw[u] = *(const u32x4*)(Z + (size_t)row * ZN + Z_LG + Cc);
                f0[u] = *(const f32x4*)(HF + (size_t)row * DLRU + Cc); f1[u] = *(const f32x4*)(HF + (size_t)row * DLRU + Cc + 4);
                b0[u] = *(const f32x4*)(HB + (size_t)row * DLRU + Cc); b1[u] = *(const f32x4*)(HB + (size_t)row * DLRU + Cc + 4); }
#pragma unroll
            for (int u = 0; u < 4; ++u) { float zg[8]; unpack8(zgw[u], zg); float y[8];
#pragma unroll
                for (int e = 0; e < 8; ++e) { const float hs = e < 4 ? f0[u][e & 3] + b0[u][e & 3] : f1[u][e & 3] + b1[u][e & 3]; const float x = zg[e];
                    const float u2 = 1.5957691216057308f * (x + 0.044715f * x * x * x);
                    y[e] = hs * x * sigm(u2); }
                *(u32x4*)((bf16_t*)(ws + WS_Y) + (size_t)rows[u] * YN + Cc) = pack8(y); }
        }
    }
}

__device__ __forceinline__ void seg_decode(int it, int& rowbase, int& s0, int& lob, int& hib, int& Lseq) {
    if (it < 512) { const int bl = it >> 5, sg = it & 31; rowbase = bl * SEQ; s0 = sg * 64; lob = s0; hib = s0 + 64; Lseq = SEQ; }
    else { const int j = it - 512, bl = j >> 2, q = j & 3; rowbase = RL + bl * CTXL; s0 = q * 64; lob = 0; hib = CTXL; Lseq = CTXL; }
}
__device__ __forceinline__ void pool_item(ArgP A, int it, LAS unsigned char* lds, const int tid) {
    unsigned char* ws = A->ws;
    int rowbase, s0, lob, hib, Lseq; seg_decode(it, rowbase, s0, lob, hib, Lseq);
    const bf16_t* Z = (const bf16_t*)(ws + WS_Z) + Z_POOL;
    const int c8 = (tid & 31) * 8, tq = tid >> 5, w2 = 1 << (c8 >> 6);
    bf16_t* Y = (bf16_t*)(ws + WS_Y) + Y_POOL + c8;
#pragma unroll
    for (int u = 0; u < 4; ++u) { const int tok = s0 + tq * 4 + u; const int lo = max(tok - w2, lob), hi = min(tok + w2, hib);
        float sum[8];
#pragma unroll
        for (int e = 0; e < 8; ++e) sum[e] = 0.f;
        for (int j = lo; j < hi; ++j) { float z[8]; unpack8(*(const u32x4*)(Z + (size_t)(rowbase + j) * ZN + c8), z);
#pragma unroll
            for (int e = 0; e < 8; ++e) sum[e] += z[e]; }
        float zc[8]; unpack8(*(const u32x4*)(Z + (size_t)(rowbase + tok) * ZN + c8), zc);
        const float inv = 1.0f / (float)(hi - lo);
#pragma unroll
        for (int e = 0; e < 8; ++e) sum[e] = sum[e] * inv - zc[e];
        *(u32x4*)(Y + (size_t)(rowbase + tok) * YN) = pack8(sum); }
}
__device__ __forceinline__ void sconv_item(ArgP A, int l, int it, const int tid) {
    unsigned char* ws = A->ws;
    int rowbase, s0, lob, hib, Lseq; seg_decode(it, rowbase, s0, lob, hib, Lseq);
    const bf16_t* Z = (const bf16_t*)(ws + WS_Z);
    const int c8 = (tid & 31) * 8, tr = tid >> 5;
    const float* sw = A->in[I_SCW] + (size_t)l * 3 * 256 + c8;
    f32x4 w0[3], w1[3];
#pragma unroll
    for (int k = 0; k < 3; ++k) { w0[k] = *(const f32x4*)(sw + k * 256); w1[k] = *(const f32x4*)(sw + k * 256 + 4); }
#pragma unroll
    for (int pp = 0; pp < 2; ++pp) {
        u32x4 gcw[2][3], hsw[2][3], gbw[2];
#pragma unroll
        for (int q = 0; q < 2; ++q) { const int tok = s0 + (pp * 2 + q) * 16 + tr;
            gbw[q] = *(const u32x4*)(Z + (size_t)(rowbase + tok) * ZN + Z_SC + c8);
#pragma unroll
            for (int k = 0; k < 3; ++k) { const int tt = tok + k - 1; const bool ok = (tt >= 0 && tt < Lseq); const bf16_t* zr = Z + (size_t)(rowbase + (ok ? tt : tok)) * ZN + Z_SC + c8;
                const u32x4 a = *(const u32x4*)(zr + 256), b = *(const u32x4*)(zr + 512); const unsigned mk = ok ? 0xffffffffu : 0u; gcw[q][k] = a & mk; hsw[q][k] = b; } }
#pragma unroll
        for (int q = 0; q < 2; ++q) { const int tok = s0 + (pp * 2 + q) * 16 + tr; float acc[8];
#pragma unroll
            for (int e = 0; e < 8; ++e) acc[e] = 0.f;
#pragma unroll
            for (int k = 0; k < 3; ++k) { float gc[8], hs[8]; unpack8(gcw[q][k], gc); unpack8(hsw[q][k], hs);
#pragma unroll
                for (int e = 0; e < 4; ++e) { acc[e] += gc[e] * hs[e] * w0[k][e]; acc[4 + e] += gc[4 + e] * hs[4 + e] * w1[k][e]; } }
            float gb[8]; unpack8(gbw[q], gb);
#pragma unroll
            for (int e = 0; e < 8; ++e) acc[e] *= gb[e];
            *(u32x4*)((bf16_t*)(ws + WS_Y) + (size_t)(rowbase + tok) * YN + Y_SC + c8) = pack8(acc); }
    }
}

__device__ __forceinline__ int fetch_item(unsigned* ctr, LAS unsigned char* lds, const int tid) {
    LAS unsigned* slot = (LAS unsigned*)(lds + QSLOT_OFF);
    __syncthreads();
    if (tid == 0) *slot = atomicAdd(ctr, 1u);
    __syncthreads();
    return (int)*slot;
}


#define XB_TMO      128
#define XB_XCNT(j)  (256  + 64 * (j))
#define XB_XSUB(j)  (1280 + 64 * (j))
#define XB_XGEN(j)  (2304 + 64 * (j))
#define XB_TOP      3328
#define XB_TOPGEN   3392
#define XCD_BAR_WORDS 3456
#define XB_SPIN_CAP (1u << 22)
__device__ __forceinline__ unsigned xb_ld(unsigned* p)              { return __hip_atomic_load(p, __ATOMIC_RELAXED, __HIP_MEMORY_SCOPE_AGENT); }
__device__ __forceinline__ unsigned xb_add(unsigned* p, unsigned v) { return __hip_atomic_fetch_add(p, v, __ATOMIC_RELAXED, __HIP_MEMORY_SCOPE_AGENT); }
__device__ __forceinline__ unsigned xb_xcc_id() { return (unsigned)__builtin_amdgcn_s_getreg((3 << 11) | 20) & 0xFu; }
#define XB_SPIN(cond, bar) do { unsigned _sp = 0; while (cond) { __builtin_amdgcn_s_sleep(1); \
    if ((++_sp & 255u) == 0u) { if (xb_ld(&(bar)[XB_TMO])) break; if (_sp > XB_SPIN_CAP) { atomicAdd(&(bar)[XB_TMO], 1u); break; } } } } while (0)
struct XcdBarrier { unsigned* bar; unsigned x; volatile LAS unsigned* st; };
__device__ __forceinline__ XcdBarrier xcd_barrier_post(unsigned* bar, volatile LAS unsigned* st) {
    XcdBarrier b; b.bar = bar; b.x = xb_xcc_id(); b.st = st;
    if (threadIdx.x == 0) (void)xb_add(&bar[XB_XCNT(b.x)], 1u);
    return b;
}
__device__ __forceinline__ void xcd_barrier_complete(unsigned* bar, unsigned x, unsigned& nloc, unsigned& nx) {
    const unsigned G = gridDim.x * gridDim.y * gridDim.z;
    unsigned sum, cnt, mine, sp = 0u;
    for (;;) {
        sum = 0u; cnt = 0u; mine = 0u;
#pragma unroll
        for (unsigned j = 0; j < 16; ++j) { const unsigned c = xb_ld(&bar[XB_XCNT(j)]); sum += c; cnt += (c > 0u) ? 1u : 0u; }
        mine = xb_ld(&bar[XB_XCNT(x)]);
        if (sum == G) break;
        __builtin_amdgcn_s_sleep(1);
        if ((++sp & 255u) == 0u) { if (xb_ld(&bar[XB_TMO])) break; if (sp > XB_SPIN_CAP) { atomicAdd(&bar[XB_TMO], 1u); break; } }
    }
    nloc = mine > 0u ? mine : 1u; nx = cnt > 0u ? cnt : 1u;
}
__device__ __forceinline__ void xcd_barrier(const XcdBarrier& b, const int tid) {
    asm volatile("s_waitcnt vmcnt(0)" ::: "memory");
    __syncthreads();
    if (tid == 0) {
        unsigned* bar = b.bar;
        __builtin_amdgcn_s_waitcnt(0);
        unsigned nloc = b.st[0], nx = b.st[1];
        if (nloc == 0u) { xcd_barrier_complete(bar, b.x, nloc, nx); b.st[0] = nloc; b.st[1] = nx; }
        const unsigned old = xb_add(&bar[XB_XSUB(b.x)], 1u);
        const unsigned gen = old / nloc;
        if (old + 1u == (gen + 1u) * nloc) {
            __builtin_amdgcn_fence(__ATOMIC_RELEASE, "agent");
            asm volatile("s_waitcnt vmcnt(0)" ::: "memory");
            const unsigned og = xb_add(&bar[XB_TOP], 1u);
            const unsigned tg = og / nx;
            if (og + 1u == (tg + 1u) * nx) xb_add(&bar[XB_TOPGEN], 1u);
            else XB_SPIN(xb_ld(&bar[XB_TOPGEN]) == tg, bar);
            __builtin_amdgcn_fence(__ATOMIC_ACQUIRE, "agent");
            xb_add(&bar[XB_XGEN(b.x)], 1u);
            asm volatile("s_waitcnt vmcnt(0)" ::: "memory");
        } else {
            XB_SPIN(xb_ld(&bar[XB_XGEN(b.x)]) == gen, bar);
            __builtin_amdgcn_fence(__ATOMIC_ACQUIRE, "agent");
            asm volatile("s_waitcnt vmcnt(0)" ::: "memory");
        }
    }
    __syncthreads();
}

template <bool COOP>
__global__ void __launch_bounds__(512, 2) fwd_kernel(Args Aparam) {
    extern __shared__ __attribute__((aligned(16))) unsigned char lds_raw[];
    LAS unsigned char* lds = (LAS unsigned char*)lds_raw;
    const int G = gridDim.x;
    ArgP A = (ArgP)__builtin_amdgcn_kernarg_segment_ptr();
    const int ph_lo = A->ph_lo, ph_hi = A->ph_hi;
    XcdBarrier xbar; xbar.bar = nullptr; xbar.x = 0; xbar.st = (volatile LAS unsigned*)(lds + QSLOT_OFF + 16);
    if constexpr (COOP) {
        if (threadIdx.x < 2) xbar.st[threadIdx.x] = 0u;
        __syncthreads();
        xbar = xcd_barrier_post((unsigned*)(A->ws + WS_CTL) + 8192, xbar.st);
    }
    int tid0 = threadIdx.x;
    for (int ph = ph_lo; ph < ph_hi; ++ph) {
        asm volatile("" : "+s"(A));
        asm volatile("" : "+v"(tid0)); const int tid = tid0;
        unsigned* ctl = (unsigned*)(A->ws + WS_CTL);
        if (ph < PH_BASE) p0_prologue(A, lds, G, tid);
        else if (ph == NPHASE - 1) final_norm(A, G, tid);
        else if (ph == PH_BASE) norm_phase(A, 0, 0, false, (int)blockIdx.x * 8, RT, G * 8, tid);
        else {
            const int q = ph - PH_BASE - 1, kj = q % PH_PER, lc = q / PH_PER, l = lc >> 1, ch = lc & 1;
            const int PKJ = PROBE_K < 3 ? PROBE_K - 1 : PROBE_K - 2;
            const int kq = (PROBE_K >= 1 && PROBE_K <= 8 && kj > PKJ) ? kj - 1 : kj;
            const int k = kq < 2 ? kq + 1 : kq + 2;
            const int sub = (PROBE_K >= 1 && PROBE_K <= 8 && kj == PKJ + 1) ? PROBE_SUB : 7;
            if (k == 6) norm_phase(A, l, ch, true, (int)blockIdx.x * 8, RT, G * 8, tid);
            else {
                Sched S; S.kind = k; S.l = l; S.ch = ch; S.G = G; S.c = (int)blockIdx.x; S.ap = A;
                pg8::Gemm g; g.lda = (k == 2 || k == 8) ? 4096 : (k == 4 ? YN : DM); g.ldb = g.lda;
                if (k == 2 && !(sub & 1)) {} else if (k == 1 || k == 2 || k == 7) { pg8::EpiBf E; E.act = (k == 7) ? 1 : 0; pg8::gemm_phase<pg8::EpiBf, Sched>(lds, g, S, E, tid); }
                else if (k == 4) { pg8::EpiMerge E; pg8::gemm_phase<pg8::EpiMerge, Sched>(lds, g, S, E, tid); }
                else { pg8::EpiRes E; pg8::gemm_phase<pg8::EpiRes, Sched>(lds, g, S, E, tid); }
                if (k == 8 && lc + 1 < DEPTH * NCH) {
                    const int l2 = (lc + 1) >> 1, ch2 = (lc + 1) & 1;
                    for (;;) { const int it = fetch_item(ctl + 64 * ph, lds, tid); if (it >= RT / 64) break; norm_phase(A, l2, ch2, false, it * 64, it * 64 + 64, 8, tid); }
                }
                if (k == 2) {
                    if (sub & 2) for (int it = (int)blockIdx.x - (G >> 1); it >= 0 && it < NB * 8; it += G - (G >> 1)) lru_sweep(A, l, it, lds, tid);
                    const int nseg = (l == 0) ? 576 : 512, total = (sub & 4) ? 2 * nseg : 0;
                    for (;;) { const int it = fetch_item(ctl + 64 * ph, lds, tid); if (it >= total) break;
                        if (it < nseg) pool_item(A, it, lds, tid);
                        else sconv_item(A, l, it - nseg, tid); }
                }
            }
        }
        if (ph + 1 < ph_hi) { if constexpr (COOP) { if (ph == 0) cg::this_grid().sync(); else xcd_barrier(xbar, tid); } }
    }
}

extern "C" void kernel_launch(void* const* d_in, const int* in_sizes, int n_in, void* d_out, int out_size, void* d_ws, size_t ws_size, hipStream_t stream) {
    static int grid = 0;
    if (grid == 0) {
        if (n_in != 27 || out_size != NBATCH * SEQ * DM || ws_size < WS_END) { fprintf(stderr, "kernel_launch: unexpected shapes (n_in %d out %d ws %zu)\n", n_in, out_size, ws_size); grid = -1; return; }
        int dev = 0, cus = 0, per_cu = 0;
        hipGetDevice(&dev); hipDeviceGetAttribute(&cus, hipDeviceAttributeMultiprocessorCount, dev);
        hipFuncSetAttribute((const void*)fwd_kernel<true>, hipFuncAttributeMaxDynamicSharedMemorySize, LDS_BYTES);
        hipFuncSetAttribute((const void*)fwd_kernel<false>, hipFuncAttributeMaxDynamicSharedMemorySize, LDS_BYTES);
        hipOccupancyMaxActiveBlocksPerMultiprocessor(&per_cu, (const void*)fwd_kernel<true>, 512, LDS_BYTES);
        (void)hipGetLastError();
        if (per_cu < 1) per_cu = 1;
        grid = cus * 1;
        if (grid <= 0) grid = 256;
    }
    if (grid < 0) return;
    hipMemsetAsync((char*)d_ws + WS_CTL, 0, CTL_ZERO_BYTES, stream);
    Args a{};
    for (int i = 0; i < 27; ++i) a.in[i] = (const float*)d_in[i];
    a.out = (float*)d_out; a.ws = (unsigned char*)d_ws;
#if MK_COOP
    a.ph_lo = 0; a.ph_hi = NPHASE;
    void* args[] = {&a};
    hipError_t e = hipLaunchCooperativeKernel((const void*)fwd_kernel<true>, dim3(grid), dim3(512), args, LDS_BYTES, stream);
    if (e != hipSuccess) fprintf(stderr, "cooperative launch failed: %s (grid %d)\n", hipGetErrorString(e), grid);
#else
    for (int ph = 0; ph < NPHASE; ++ph) { a.ph_lo = ph; a.ph_hi = ph + 1; hipLaunchKernelGGL(fwd_kernel<false>, dim3(grid), dim3(512), LDS_BYTES, stream, a); }
#endif
}
```

```cpp
#include <hip/hip_runtime.h>
#include <hip/hip_cooperative_groups.h>
#include <cstdio>
#include <cstdint>
namespace cg = cooperative_groups;

#ifndef MK_COOP
#define MK_COOP 1
#endif
#define PROBE_SUB 7
#define PROBE_K -1

#define LAS __attribute__((address_space(3)))
typedef unsigned short bf16_t;
typedef short bf16x8 __attribute__((ext_vector_type(8)));
typedef float f32x4 __attribute__((ext_vector_type(4)));
typedef float f32x2 __attribute__((ext_vector_type(2)));
typedef unsigned u32x4 __attribute__((ext_vector_type(4)));
typedef unsigned u32x2 __attribute__((ext_vector_type(2)));

constexpr int NBATCH = 32, SEQ = 2048, CTXL = 256, DM = 1024, DEPTH = 2, DLRU = 512, NIN = 6400, DFF = 4096;
constexpr int NB = 16, NCH = 2;
constexpr int RL = NB * SEQ, RC = NB * CTXL, RT = RL + RC;
constexpr int ZN = 4096  , WN = 6144  , YN = 1280;
constexpr int Z_LG = 512, Z_POOL = 1024, Z_SC = 1280, Z_GATE = 2048;
constexpr int Y_F = 512, Y_POOL = 768, Y_SC = 1024;
constexpr int NSC = 36;
constexpr size_t MiB = 1u << 20;
constexpr size_t WS_CTL = 0, CTL_ZERO_BYTES = 65536;
constexpr size_t WS_MOD = 1 * MiB, WS_WG = 3 * MiB, WS_SUMA = 4 * MiB, WS_SUMH = 7 * MiB, WS_DFTC = 10 * MiB, WS_DFT = 12 * MiB;
constexpr size_t WS_WIN = 28 * MiB, WS_WF = 52 * MiB, WS_WBR = 54 * MiB, WS_WOUT = 60 * MiB, WS_W1 = 64 * MiB, WS_W2 = 80 * MiB;
constexpr size_t WS_CTXW = 96 * MiB, WS_U = 128 * MiB, WS_MRG = 200 * MiB, WS_PT = 272 * MiB, WS_PTC = 304 * MiB, WS_Y = 336 * MiB, WS_Z = 432 * MiB;
constexpr size_t WS_HF = WS_Z + (size_t)RT * ZN * 2, WS_HB = WS_HF + (size_t)RT * DLRU * 4;
constexpr size_t WS_END = WS_HB + (size_t)RT * DLRU * 4;
static_assert(WS_END <= 1024 * MiB, "workspace map");
static_assert(WS_Y + (size_t)RT * YN * 2 <= WS_Z && WS_PTC + (size_t)NB * 256 * 4096 * 2 <= WS_Y && WS_MRG + (size_t)RT * DM * 2 <= WS_PT, "workspace map 2");
constexpr int LDS_BYTES = 147456, RING_BYTES = 131072, QSLOT_OFF = LDS_BYTES - 64;
constexpr int PH_PER = 7 + ((PROBE_K >= 1 && PROBE_K <= 8) ? 1 : 0), PH_BASE = (PROBE_K == 9) ? 2 : 1;
constexpr int NPHASE = PH_BASE + 2 + DEPTH * NCH * PH_PER;

__device__ __forceinline__ float bf_lo(unsigned w) { return __uint_as_float(w << 16); }
__device__ __forceinline__ float bf_hi(unsigned w) { return __uint_as_float(w & 0xffff0000u); }
__device__ __forceinline__ unsigned cvt_pk_bf16(float lo, float hi) { unsigned r; asm volatile("v_cvt_pk_bf16_f32 %0, %1, %2" : "=v"(r) : "v"(lo), "v"(hi)); return r; }
__device__ __forceinline__ float sigm(float x) { return __builtin_amdgcn_rcpf(1.0f + __expf(-x)); }
__device__ __forceinline__ float wave_sum(float v) {
#pragma unroll
    for (int o = 1; o < 64; o <<= 1) v += __shfl_xor(v, o);
    return v;
}
#define LDS_WAIT() asm volatile("s_waitcnt lgkmcnt(0)" ::: "memory")
#define DPP_SHR(ident, v, N) __builtin_bit_cast(float, __builtin_amdgcn_update_dpp(__builtin_bit_cast(int, (float)(ident)), __builtin_bit_cast(int, (float)(v)), 0x110 + (N), 0xf, 0xf, false))
#define SCAN_STEP(N) do { const float Ap_ = DPP_SHR(1.0f, Av, N), Bp_ = DPP_SHR(0.0f, Bv, N); Bv = Av * Bp_ + Bv; Av = Av * Ap_; } while (0)

namespace pg8 {
constexpr int BM = 256, BK = 64, HALF = 128, HTB = HALF * BK * 2, STAGE_BYTES = 8 * HTB, NXCD = 8, WGM = 8;
__host__ __device__ __forceinline__ int lds_byte(int r, int c) { const int st = (r >> 4) * 2 + (c >> 5), rr = r & 15, cc = c & 31, ob = rr * 64 + cc * 2; return st * 1024 + (ob ^ (((ob >> 9) & 1) << 5)); }
__host__ __device__ __forceinline__ void stage_rc(int b, int& R, int& C) { const int st = b / 1024, sb = b % 1024, swz = sb ^ (((sb >> 9) & 1) << 5); R = (st >> 1) * 16 + swz / 64; C = (st & 1) * 32 + (swz % 64) / 2; }
__host__ __device__ __forceinline__ int perm32(int rho) { const int n = rho >> 4, i = rho & 15; return 8 * (i >> 2) + 4 * n + (i & 3); }

struct Unit { const char* a; const char* b; char* dst; const char* x0; const char* x1; int nt, seg; };
struct Gemm { int lda, ldb; };

__device__ __forceinline__ bool tile_of(long L, int nM, int nN, int& pm, int& pn) {
    const int nwg = nM * nN; if (L >= nwg) return false;
    int wgid = (int)L; { const int q = nwg / NXCD, r = nwg % NXCD, xcd = wgid % NXCD, off = wgid / NXCD; wgid = (xcd < r ? xcd * (q + 1) : r * (q + 1) + (xcd - r) * q) + off; }
    const int nig = WGM * nN, gid = wgid / nig, fm = gid * WGM, gsz = (nM - fm) < WGM ? (nM - fm) : WGM;
    pm = fm + ((wgid % nig) % gsz); pn = (wgid % nig) / gsz; return true;
}

struct EpiBf {
    static constexpr bool PERM = true;
    int act;
    __device__ __forceinline__ bool operator()(f32x4 (&acc)[2][2][4][2], const Unit& u, int wr, int wc, int fr, int fq) const {
        const int ldc = (u.seg & 12) ? YN : 4096;
        bf16_t* base = (bf16_t*)u.dst + (size_t)(wr * 64 + fr) * ldc + wc * 32 + 8 * fq;
        const float sc = (u.seg & 4) ? 0.001381067932004975f   : ((u.seg & 8) ? 1.f / 256.f : 1.f);
#pragma unroll
        for (int ai = 0; ai < 2; ++ai)
#pragma unroll
            for (int m = 0; m < 4; ++m) { bf16_t* rowp = base + (size_t)(ai * HALF + m * 16) * ldc;
#pragma unroll
                for (int bj = 0; bj < 2; ++bj) { f32x4 v0 = acc[ai][bj][m][0], v1 = acc[ai][bj][m][1];
                    if (u.seg == 2) {
                        unsigned p0 = 0u, p1 = 0u;
#pragma unroll
                        for (int e = 0; e < 4; ++e) {
                            const float s0 = fmaxf(__builtin_amdgcn_rcpf(__builtin_amdgcn_exp2f(v0[e] * -1.4426950408889634f) * (1.0f / 255.0f) + (1.0f / 255.0f)), 1.0f);
                            const float s1 = fmaxf(__builtin_amdgcn_rcpf(__builtin_amdgcn_exp2f(v1[e] * -1.4426950408889634f) * (1.0f / 255.0f) + (1.0f / 255.0f)), 1.0f);
                            p0 = __builtin_amdgcn_cvt_pk_u8_f32(s0, e, p0); p1 = __builtin_amdgcn_cvt_pk_u8_f32(s1, e, p1); }
                        u32x2 wg; wg.x = p0; wg.y = p1;
                        *(u32x2*)(u.dst + (size_t)(wr * 64 + fr + ai * HALF + m * 16) * (ZN * 2) + wc * 32 + 8 * fq + bj * HALF) = wg;
                        continue; }
                    if (act == 1) {
#pragma unroll
                        for (int e = 0; e < 4; ++e) { const float a = fmaxf(v0[e], 0.f), b = fmaxf(v1[e], 0.f); v0[e] = a * a; v1[e] = b * b; } }
                    v0 = v0 * sc; v1 = v1 * sc;
                    u32x4 w; w.x = cvt_pk_bf16(v0[0], v0[1]); w.y = cvt_pk_bf16(v0[2], v0[3]); w.z = cvt_pk_bf16(v1[0], v1[1]); w.w = cvt_pk_bf16(v1[2], v1[3]);
                    *(u32x4*)(rowp + bj * HALF) = w; } }
        return true;
    }
};
struct EpiRes {
    static constexpr bool PERM = false;
    __device__ __forceinline__ bool operator()(f32x4 (&acc)[2][2][4][2], const Unit& u, int wr, int wc, int fr, int fq) const {
        const float* gv = (const float*)u.x1 + wc * 32 + 4 * fq;
        f32x4 g[2][2];
#pragma unroll
        for (int bj = 0; bj < 2; ++bj)
#pragma unroll
            for (int n = 0; n < 2; ++n) g[bj][n] = *(const f32x4*)(gv + bj * HALF + n * 16);
        const size_t o0 = (size_t)(wr * 64 + fr) * DM + wc * 32 + 4 * fq;
        const float* bs = (const float*)u.x0 + o0; float* od = (float*)u.dst + o0;
        f32x4 bc[2][2];
#pragma unroll
        for (int bj = 0; bj < 2; ++bj)
#pragma unroll
            for (int n = 0; n < 2; ++n) bc[bj][n] = *(const f32x4*)(bs + bj * HALF + n * 16);
#pragma unroll
        for (int am = 0; am < 8; ++am) { const int ai = am >> 2, m = am & 3; const size_t off = (size_t)(ai * HALF + m * 16) * DM;
            f32x4 bn[2][2];
            if (am < 7) { const size_t offn = (size_t)(((am + 1) >> 2) * HALF + ((am + 1) & 3) * 16) * DM;
#pragma unroll
                for (int bj = 0; bj < 2; ++bj)
#pragma unroll
                    for (int n = 0; n < 2; ++n) bn[bj][n] = *(const f32x4*)(bs + offn + bj * HALF + n * 16); }
#pragma unroll
            for (int bj = 0; bj < 2; ++bj)
#pragma unroll
                for (int n = 0; n < 2; ++n) *(f32x4*)(od + off + bj * HALF + n * 16) = bc[bj][n] + g[bj][n] * acc[ai][bj][m][n];
            if (am < 7) {
#pragma unroll
                for (int bj = 0; bj < 2; ++bj)
#pragma unroll
                    for (int n = 0; n < 2; ++n) bc[bj][n] = bn[bj][n]; }
        }
        return true;
    }
};
struct EpiMerge {
    static constexpr bool PERM = true;
    __device__ __forceinline__ void apply(const bool LAST, f32x4 (&acc)[2][2][4][2], const Unit& u, int wr, int wc, int fr, int fq) const {
        const unsigned char* g0 = (const unsigned char*)u.x0 + (size_t)(wr * 64 + fr) * (ZN * 2) + wc * 32 + 8 * fq;
        bf16_t* base = (bf16_t*)u.dst + (size_t)(wr * 64 + fr) * DM + wc * 32 + 8 * fq;
        const int gboff = LAST ? 0 : DM; const unsigned lastmask = LAST ? 0xffffffffu : 0u;
        u32x2 ga[2][2][2], gb[2][2][2];
#pragma unroll
        for (int mm = 0; mm < 2; ++mm)
#pragma unroll
            for (int bj = 0; bj < 2; ++bj) { const unsigned char* rp = g0 + (size_t)(mm * 16) * (ZN * 2) + bj * HALF; ga[0][mm][bj] = *(const u32x2*)rp; gb[0][mm][bj] = *(const u32x2*)(rp + gboff); }
#pragma unroll
        for (int am = 0; am < 4; ++am) { const int ai = am >> 1, m0 = (am & 1) * 2, cb_ = am & 1, nb_ = cb_ ^ 1;
            if (am < 3) { const int ai2 = (am + 1) >> 1, m02 = ((am + 1) & 1) * 2;
#pragma unroll
                for (int mm = 0; mm < 2; ++mm)
#pragma unroll
                    for (int bj = 0; bj < 2; ++bj) { const unsigned char* rp = g0 + (size_t)(ai2 * HALF + (m02 + mm) * 16) * (ZN * 2) + bj * HALF; ga[nb_][mm][bj] = *(const u32x2*)rp; gb[nb_][mm][bj] = *(const u32x2*)(rp + gboff); } }
            asm volatile("" ::: "memory");
#pragma unroll
            for (int mm = 0; mm < 2; ++mm)
#pragma unroll
                for (int bj = 0; bj < 2; ++bj) { const int m = m0 + mm;
                    f32x4 v0 = acc[ai][bj][m][0], v1 = acc[ai][bj][m][1];
#pragma unroll
                    for (int h2 = 0; h2 < 2; ++h2) { const unsigned wa = ga[cb_][mm][bj][h2], wb = gb[cb_][mm][bj][h2] | lastmask;
#pragma unroll
                        for (int e = 0; e < 4; ++e) { const float sa = (float)((wa >> (8 * e)) & 0xffu), sb = (float)((wb >> (8 * e)) & 0xffu);
                            const float f = sa * __builtin_amdgcn_rcpf(sb);
                            if (h2 == 0) v0[e] *= f; else v1[e] *= f; } }
                    acc[ai][bj][m][0] = v0; acc[ai][bj][m][1] = v1;
                    if (LAST) { u32x4 w; w.x = cvt_pk_bf16(v0[0], v0[1]); w.y = cvt_pk_bf16(v0[2], v0[3]); w.z = cvt_pk_bf16(v1[0], v1[1]); w.w = cvt_pk_bf16(v1[2], v1[3]);
                        *(u32x4*)(base + (size_t)(ai * HALF + m * 16) * DM + bj * HALF) = w; }
                }
        }
    }
    __device__ __forceinline__ bool operator()(f32x4 (&acc)[2][2][4][2], const Unit& u, int wr, int wc, int fr, int fq) const {
        const bool last = (u.seg == 3); apply(last, acc, u, wr, wc, fr, fq); return last;
    }
};

template <class Epi, class Sched>
__device__ __forceinline__ void gemm_phase(LAS unsigned char* lds, const Gemm g, const Sched& S, const Epi& E, const int tid) {
    const int wid = __builtin_amdgcn_readfirstlane(tid >> 6), lane = tid & 63, wr = wid >> 2, wc = wid & 3, fr = lane & 15, fq = lane >> 4;
    unsigned voffA[2], voffB[2];
#pragma unroll
    for (int i = 0; i < 2; ++i) { int R, C; stage_rc(tid * 16 + i * 8192, R, C); const int Rb = Epi::PERM ? ((R & ~31) + perm32(R & 31)) : R;
        voffA[i] = (unsigned)(R * g.lda + C) * 2u; voffB[i] = (unsigned)(Rb * g.ldb + C) * 2u; }
    const size_t kstep = (size_t)(BK * 2);
    const size_t hstepA = (size_t)HALF * g.lda * 2, hstepB = (size_t)HALF * g.ldb * 2;
    const unsigned ldsw = (unsigned)wid * 1024u;
    const int aoff = lds_byte(wr * 64 + fr, fq * 8), boff = lds_byte(wc * 32 + fr, fq * 8);
#define PG8_SA(b, h) (((b) * 2 + (h)) * HTB)
#define PG8_SB(b, h) ((4 + (b) * 2 + (h)) * HTB)
#define PG8_STAGE(bufoff, gbase, voff) do { _Pragma("unroll") for (int _i = 0; _i < 2; ++_i) \
        __builtin_amdgcn_global_load_lds((const unsigned*)((const char*)(gbase) + (voff)[_i]), (LAS unsigned*)(lds + (bufoff) + ldsw + _i * 8192), 16, 0, 0); } while (0)
#define PG8_LDA(dst, b, h) do { _Pragma("unroll") for (int m = 0; m < 4; ++m) _Pragma("unroll") for (int k = 0; k < 2; ++k) dst[m][k] = *(const LAS bf16x8*)(lds + PG8_SA(b, h) + aoff + m * 2048 + k * 1024); } while (0)
#define PG8_LDB(dst, b, h) do { _Pragma("unroll") for (int n = 0; n < 2; ++n) _Pragma("unroll") for (int k = 0; k < 2; ++k) dst[n][k] = *(const LAS bf16x8*)(lds + PG8_SB(b, h) + boff + n * 2048 + k * 1024); } while (0)
#define PG8_MMA(ai, bj, At, Bt) do { __builtin_amdgcn_s_setprio(1); _Pragma("unroll") for (int m = 0; m < 4; ++m) _Pragma("unroll") for (int n = 0; n < 2; ++n) _Pragma("unroll") for (int k = 0; k < 2; ++k) \
        acc[ai][bj][m][n] = __builtin_amdgcn_mfma_f32_16x16x32_bf16(Bt[n][k], At[m][k], acc[ai][bj][m][n], 0, 0, 0); __builtin_amdgcn_s_setprio(0); } while (0)
#define PG8_WAIT_V(n) asm volatile("s_waitcnt vmcnt(" #n ")" ::: "memory")
#define PG8_WAIT_L(n) asm volatile("s_waitcnt lgkmcnt(" #n ")" ::: "memory")
#define PG8_BAR __builtin_amdgcn_s_barrier()
#define PG8_SCHED __builtin_amdgcn_sched_barrier(0)
    Unit cur, nxt; int ui = 0;
    if (!S.next(0, cur)) return;
    f32x4 acc[2][2][4][2];
#pragma unroll
    for (int a = 0; a < 2; ++a)
#pragma unroll
        for (int b = 0; b < 2; ++b)
#pragma unroll
            for (int m = 0; m < 4; ++m)
#pragma unroll
                for (int n = 0; n < 2; ++n) acc[a][b][m][n] = (f32x4){0.f, 0.f, 0.f, 0.f};
    bf16x8 At[4][2], B0[2][2], B1[2][2];
    const char* cA = cur.a; const char* cB = cur.b;
    PG8_STAGE(PG8_SB(0, 0), cB, voffB); PG8_STAGE(PG8_SB(0, 1), cB + hstepB, voffB); PG8_STAGE(PG8_SA(0, 0), cA, voffA); PG8_STAGE(PG8_SA(0, 1), cA + hstepA, voffA);
    if (wr == 1) PG8_BAR;
    PG8_WAIT_V(2); PG8_BAR;
    PG8_STAGE(PG8_SB(1, 0), cB + kstep, voffB); PG8_STAGE(PG8_SA(1, 0), cA + kstep, voffA); PG8_STAGE(PG8_SB(1, 1), cB + hstepB + kstep, voffB);
    PG8_WAIT_V(6); PG8_BAR;
    for (;;) {
        const bool has_next = S.next(ui + 1, nxt);
        const char* nA = has_next ? nxt.a : cA; const char* nB = has_next ? nxt.b : cB;
        const int nt = cur.nt;
        for (int t = 0; t < nt; t += 2) {
            const bool last = (t == nt - 2);
            const char* a1 = cA + (size_t)(t + 1) * kstep;
            const char* a2 = last ? nA : cA + (size_t)(t + 2) * kstep; const char* b2 = last ? nB : cB + (size_t)(t + 2) * kstep;
            const char* a3 = a2 + kstep; const char* b3 = b2 + kstep;
            PG8_LDB(B0, 0, 0); PG8_LDB(B1, 0, 1); PG8_SCHED; PG8_LDA(At, 0, 0); PG8_STAGE(PG8_SA(1, 1), a1 + hstepA, voffA);
            PG8_WAIT_V(8); PG8_WAIT_L(0); PG8_BAR; PG8_MMA(0, 0, At, B0); PG8_MMA(0, 1, At, B1); PG8_BAR; PG8_SCHED;
            PG8_LDA(At, 0, 1); PG8_STAGE(PG8_SB(0, 0), b2, voffB); PG8_STAGE(PG8_SB(0, 1), b2 + hstepB, voffB); PG8_STAGE(PG8_SA(0, 0), a2, voffA);
            PG8_WAIT_V(8); PG8_WAIT_L(0); PG8_BAR; PG8_MMA(1, 0, At, B0); PG8_MMA(1, 1, At, B1); PG8_BAR; PG8_SCHED;
            PG8_LDB(B0, 1, 0); PG8_LDB(B1, 1, 1); PG8_SCHED; PG8_LDA(At, 1, 0); PG8_STAGE(PG8_SA(0, 1), a2 + hstepA, voffA);
            PG8_WAIT_V(8); PG8_WAIT_L(0); PG8_BAR; PG8_MMA(0, 0, At, B0); PG8_MMA(0, 1, At, B1); PG8_BAR; PG8_SCHED;
            PG8_LDA(At, 1, 1); PG8_STAGE(PG8_SB(1, 0), b3, voffB); PG8_STAGE(PG8_SB(1, 1), b3 + hstepB, voffB); PG8_STAGE(PG8_SA(1, 0), a3, voffA);
            PG8_WAIT_V(8); PG8_WAIT_L(0); PG8_BAR; PG8_MMA(1, 0, At, B0); PG8_MMA(1, 1, At, B1); PG8_BAR; PG8_SCHED;
        }
        if (wr == 0) PG8_BAR;
        const bool zero = E(acc, cur, wr, wc, fr, fq);
        if (!has_next) break;
        if (zero) {
#pragma unroll
            for (int a = 0; a < 2; ++a)
#pragma unroll
                for (int b = 0; b < 2; ++b)
#pragma unroll
                    for (int m = 0; m < 4; ++m)
#pragma unroll
                        for (int n = 0; n < 2; ++n) acc[a][b][m][n] = (f32x4){0.f, 0.f, 0.f, 0.f};
        }
        cur = nxt; cA = nA; cB = nB; ++ui;
        if (wr == 1) PG8_BAR;
    }
    PG8_WAIT_V(0);
    PG8_BAR;
#undef PG8_SA
#undef PG8_SB
#undef PG8_STAGE
#undef PG8_LDA
#undef PG8_LDB
#undef PG8_MMA
#undef PG8_WAIT_V
#undef PG8_WAIT_L
#undef PG8_BAR
#undef PG8_SCHED
}
}

struct Args { const float* in[27]; float* out; unsigned char* ws; int ph_lo, ph_hi; };
typedef const __attribute__((address_space(4))) Args* ArgP;
enum { I_X = 0, I_C, I_CTX, I_CCTX, I_WMOD, I_BMOD, I_G1, I_G2, I_WIN, I_CONVW, I_CONVB, I_WA, I_BA, I_WX, I_BX, I_LAM, I_POOLW, I_POOLS, I_SCW,
       I_BRL, I_BRF, I_BRP, I_BRS, I_WOUT, I_FF1, I_FF2, I_GF };

struct Sched {
    int kind, l, ch, G, c;
    ArgP ap;
    __device__ __forceinline__ bool next(int i, pg8::Unit& u) const {
        unsigned char* ws = ap->ws;
        const long L = (long)i * G + c;
        const int nM = (l == 0) ? RT / 256 : RL / 256;
        u.x0 = nullptr; u.x1 = nullptr; u.seg = 0;
        int pm, pn;
        if (kind == 1) {
            const char* U = (const char*)(ws + WS_U);
            const int nZ = nM * 24;
            long L2 = L - nZ; bool isz = false;
            if (L < nZ) { pg8::tile_of(L, nM, 24, pm, pn); isz = true; }
            else if (l == 1) { if (L2 < 32) { pm = 128 + (int)(L2 >> 1); pn = (int)(L2 & 1); isz = true; } else L2 -= 32; }
            if (isz) {
                u.a = U + (size_t)pm * 256 * DM * 2; u.b = (const char*)(ws + WS_WIN) + ((size_t)l * WN + (size_t)pn * 256) * DM * 2; u.nt = 16;
                u.dst = (char*)(ws + WS_Z) + (size_t)pm * 256 * ZN * 2 + (pn < 8 ? (size_t)pn * 512 : (size_t)4096 + (size_t)(pn - 8) * 256); u.seg = (pn >= 8) ? 2 : 0; return true;
            }
            if (L2 >= 2 * nM) return false;
            const int seg = (int)(L2 & 1), tt = (int)(L2 >> 1);
            u.a = (const char*)(ws + WS_WF) + ((size_t)l * 512 + (size_t)seg * 256) * DM * 2; u.b = U + (size_t)tt * 256 * DM * 2; u.nt = 16;
            if (tt < 128) u.dst = (char*)(ws + WS_PT) + ((size_t)(tt >> 3) * 256 * 4096 + (size_t)seg * 2048 + (size_t)(tt & 7) * 256) * 2;
            else u.dst = (char*)(ws + WS_PTC) + ((size_t)(tt - 128) * 256 * 4096 + (size_t)seg * 256) * 2;
            return true;
        }
        if (kind == 7) {
            if (!pg8::tile_of(L, nM, 16, pm, pn)) return false;
            u.a = (const char*)(ws + WS_U) + (size_t)pm * 256 * DM * 2; u.b = (const char*)(ws + WS_W1) + ((size_t)l * DFF + (size_t)pn * 256) * DM * 2; u.nt = 16;
            u.dst = (char*)(ws + WS_Z) + ((size_t)pm * 256 * DFF + (size_t)pn * 256) * 2; return true;
        }
        if (kind == 2) {
            if (L < 128) { const int b_ = (int)(L >> 3), kt = (int)(L & 7);
                u.a = (const char*)(ws + WS_DFT) + (size_t)kt * 256 * 4096 * 2; u.b = (const char*)(ws + WS_PT) + (size_t)b_ * 256 * 4096 * 2; u.nt = 64;
                u.dst = (char*)(ws + WS_Y) + ((size_t)(b_ * SEQ + kt * 256) * YN + Y_F) * 2; u.seg = 4; return true; }
            if (l == 0 && L < 144) { const int j = (int)L - 128;
                u.a = (const char*)(ws + WS_DFTC); u.b = (const char*)(ws + WS_PTC) + (size_t)j * 256 * 4096 * 2; u.nt = 8;
                u.dst = (char*)(ws + WS_Y) + ((size_t)(RL + j * 256) * YN + Y_F) * 2; u.seg = 8; return true; }
            return false;
        }
        if (kind == 4) {
            const int seg = i & 3; const long T = (long)(i >> 2) * G + c;
            if (!pg8::tile_of(T, nM, 4, pm, pn)) return false;
            const int coff = seg == 0 ? 0 : (256 + 256 * seg);
            u.a = (const char*)(ws + WS_Y) + ((size_t)pm * 256 * YN + coff) * 2; u.b = (const char*)(ws + WS_WBR) + (((size_t)l * DM + (size_t)pn * 256) * YN + coff) * 2;
            u.nt = seg == 0 ? 8 : 4; u.seg = seg;
            u.dst = (char*)(ws + WS_MRG) + ((size_t)pm * 256 * DM + (size_t)pn * 256) * 2;
            u.x0 = (const char*)(ws + WS_Z) + (size_t)pm * 256 * ZN * 2 + 4096 + seg * DM + pn * 256;
            return true;
        }
        if (!pg8::tile_of(L, nM, 4, pm, pn)) return false;
        if (kind == 5) { u.a = (const char*)(ws + WS_MRG) + (size_t)pm * 256 * DM * 2; u.b = (const char*)(ws + WS_WOUT) + ((size_t)l * DM + (size_t)pn * 256) * DM * 2; u.nt = 16; }
        else { u.a = (const char*)(ws + WS_Z) + (size_t)pm * 256 * DFF * 2; u.b = (const char*)(ws + WS_W2) + ((size_t)l * DM + (size_t)pn * 256) * DFF * 2; u.nt = 64; }
        int bidx; size_t eoff;
        if (pm < 128) { eoff = ((size_t)(ch * RL + pm * 256) * DM + pn * 256) * 4; bidx = ch * NB + (pm >> 3);
            char* out = (char*)ap->out; u.dst = out + eoff; u.x0 = (kind == 5 && l == 0) ? (const char*)ap->in[I_X] + eoff : (const char*)out + eoff; }
        else { eoff = ((size_t)(ch * RC + (pm - 128) * 256) * DM + pn * 256) * 4; bidx = 32;
            u.dst = (char*)(ws + WS_CTXW) + eoff; u.x0 = (kind == 5) ? (const char*)ap->in[I_CTX] + eoff : (const char*)(ws + WS_CTXW) + eoff; }
        u.x1 = (const char*)(ws + WS_MOD) + ((size_t)((l * 33 + bidx) * 6 + (kind == 5 ? 2 : 5)) * DM + pn * 256) * 4;
        return true;
    }
};

__device__ __forceinline__ void tr_item(const float* W, int ldw, int col0, int ncols, bf16_t* WT, int ldt, int koff, LAS float* scr, int item, int lane) {
    const int nblk = ncols / 32, kb = item / nblk, nb = item % nblk, k0 = 64 * kb, n0 = 32 * nb;
#pragma unroll 8
    for (int i = 0; i < 32; ++i) { const int kk = 2 * i + (lane >> 5); scr[kk * 33 + (lane & 31)] = W[(size_t)(k0 + kk) * ldw + col0 + n0 + (lane & 31)]; }
    LDS_WAIT(); asm volatile("" ::: "memory");
    const int c = lane & 7;
#pragma unroll
    for (int j = 0; j < 4; ++j) { const int n = (lane >> 3) + 8 * j; const LAS float* s = scr + (8 * c) * 33 + n;
        u32x4 o; o.x = cvt_pk_bf16(s[0 * 33], s[1 * 33]); o.y = cvt_pk_bf16(s[2 * 33], s[3 * 33]); o.z = cvt_pk_bf16(s[4 * 33], s[5 * 33]); o.w = cvt_pk_bf16(s[6 * 33], s[7 * 33]);
        *(u32x4*)(WT + (size_t)(n0 + n) * ldt + koff + k0 + 8 * c) = o; }
    LDS_WAIT(); asm volatile("" ::: "memory");
}

__device__ __forceinline__ void p0_prologue(ArgP A, LAS unsigned char* lds, int G, const int tid) {
    const int lane = tid & 63, wave = tid >> 6, bx = blockIdx.x;
    unsigned char* ws = A->ws;
    if (bx < 192) {
        const int l = bx / 96, cb = bx % 96, n = cb * 64 + lane;
        LAS float* sl = (LAS float*)lds;
        for (int idx = tid; idx < 33 * 1024; idx += 512) { const int bb = idx >> 10, k = idx & 1023; const float v = bb < 32 ? A->in[I_C][bb * 1024 + k] : A->in[I_CCTX][k]; sl[idx] = v * sigm(v); }
        __syncthreads();
        float acc[33];
#pragma unroll
        for (int bb = 0; bb < 33; ++bb) acc[bb] = 0.f;
        const float* wp = A->in[I_WMOD] + ((size_t)l * 1024 + wave * 128) * 6144 + n;
        for (int k4 = 0; k4 < 32; ++k4) {
            const float w0 = wp[(size_t)(4 * k4 + 0) * 6144], w1 = wp[(size_t)(4 * k4 + 1) * 6144], w2 = wp[(size_t)(4 * k4 + 2) * 6144], w3 = wp[(size_t)(4 * k4 + 3) * 6144];
#pragma unroll
            for (int bb = 0; bb < 33; ++bb) { const f32x4 s = *(const LAS f32x4*)(sl + bb * 1024 + wave * 128 + 4 * k4); acc[bb] += s[0] * w0 + s[1] * w1 + s[2] * w2 + s[3] * w3; }
        }
        __syncthreads();
        LAS float* red = (LAS float*)lds;
#pragma unroll
        for (int bb = 0; bb < 33; ++bb) red[(wave * 33 + bb) * 64 + lane] = acc[bb];
        __syncthreads();
        float* MOD = (float*)(ws + WS_MOD);
        for (int idx = tid; idx < 33 * 64; idx += 512) { const int bb = idx >> 6, ln = idx & 63; float s = A->in[I_BMOD][l * 6144 + cb * 64 + ln];
#pragma unroll
            for (int w = 0; w < 8; ++w) s += red[(w * 33 + bb) * 64 + ln];
            MOD[(size_t)(l * 33 + bb) * 6144 + cb * 64 + ln] = s; }
        __syncthreads();
    } else if (bx < 224) {
        const int it = bx - 192, l = it >> 4, k0 = (it & 15) * 64;
        LAS float* wt = (LAS float*)lds;
        LAS float* tab = (LAS float*)(lds + 65536);
        for (int idx = tid; idx < 64 * 256; idx += 512) { const int kk = idx >> 8, c = idx & 255; wt[idx] = A->in[I_WIN][((size_t)l * 1024 + k0 + kk) * NIN + 1024 + c]; }
        { const int i = tid & 255; tab[tid] = (tid < 256) ? cospif((float)i / 128.f) : sinpif((float)i / 128.f); }
        __syncthreads();
        const int m = tid & 255; const LAS float* tb = tab + (tid >> 8) * 256;
        bf16_t* WF = (bf16_t*)(ws + WS_WF) + ((size_t)l * 512 + tid) * DM + k0;
        for (int kg = 0; kg < 8; ++kg) {
            float a[8];
#pragma unroll
            for (int q = 0; q < 8; ++q) a[q] = 0.f;
            for (int c = 0; c < 256; ++c) { const float tv = tb[(m * c) & 255];
#pragma unroll
                for (int q = 0; q < 8; ++q) a[q] += wt[(kg * 8 + q) * 256 + c] * tv; }
            u32x4 o; o.x = cvt_pk_bf16(a[0], a[1]); o.y = cvt_pk_bf16(a[2], a[3]); o.z = cvt_pk_bf16(a[4], a[5]); o.w = cvt_pk_bf16(a[6], a[7]);
            *(u32x4*)(WF + kg * 8) = o;
        }
        __syncthreads();
    }
    {
        LAS float* scr = (LAS float*)(lds + wave * 16384);
        const int gw = wave * G + bx, NGW = G * 8;
        for (int it = gw; it < 16384; it += NGW) {
            const int l = it >> 13; int r = it & 8191;
            const float* win = A->in[I_WIN] + (size_t)l * 1024 * NIN;
            bf16_t* WIN = (bf16_t*)(ws + WS_WIN) + (size_t)l * WN * DM;
            bf16_t* WBR = (bf16_t*)(ws + WS_WBR) + (size_t)l * DM * YN;
            if (r < 512) { tr_item(win, NIN, 0, 1024, WIN, DM, 0, scr, r, lane); continue; } r -= 512;
            if (r < 2560) { tr_item(win, NIN, 1280, 5120, WIN + (size_t)1024 * DM, DM, 0, scr, r, lane); continue; } r -= 2560;
            if (r < 256) { tr_item(A->in[I_BRL] + (size_t)l * 512 * DM, DM, 0, DM, WBR, YN, 0, scr, r, lane); continue; } r -= 256;
            if (r < 128) { tr_item(A->in[I_BRF] + (size_t)l * 256 * DM, DM, 0, DM, WBR, YN, Y_F, scr, r, lane); continue; } r -= 128;
            if (r < 128) { tr_item(A->in[I_BRS] + (size_t)l * 256 * DM, DM, 0, DM, WBR, YN, Y_SC, scr, r, lane); continue; } r -= 128;
            if (r < 512) { tr_item(A->in[I_WOUT] + (size_t)l * DM * DM, DM, 0, DM, (bf16_t*)(ws + WS_WOUT) + (size_t)l * DM * DM, DM, 0, scr, r, lane); continue; } r -= 512;
            if (r < 2048) { tr_item(A->in[I_FF1] + (size_t)l * DM * DFF, DFF, 0, DFF, (bf16_t*)(ws + WS_W1) + (size_t)l * DFF * DM, DM, 0, scr, r, lane); continue; } r -= 2048;
            tr_item(A->in[I_FF2] + (size_t)l * DFF * DM, DM, 0, DM, (bf16_t*)(ws + WS_W2) + (size_t)l * DM * DFF, DFF, 0, scr, r, lane);
        }
    }
    const int gt = bx * 512 + tid, NGT = G * 512;
    {
        bf16_t* WG = (bf16_t*)(ws + WS_WG);
        for (int idx = gt; idx < 2 * 8 * 256 * 64; idx += NGT) { const int i = idx & 63, n = (idx >> 6) & 255, h = (idx >> 14) & 7, l = idx >> 17, d = n >> 7, gate = (n >> 6) & 1, j = n & 63;
            const float v = (gate ? A->in[I_WX] : A->in[I_WA])[((size_t)((l * 2 + d) * 8 + h) * 64 + i) * 64 + j];
            WG[idx] = (bf16_t)(cvt_pk_bf16(v, 0.f) & 0xffffu); }
    }
    {
        for (int idx = gt; idx < 2 * 256 * 1024; idx += NGT) { const int n = idx & 1023, i = (idx >> 10) & 255, l = idx >> 18, g = i >> 6, il = i & 63;
            const float* pw = A->in[I_POOLW] + ((size_t)(l * 4 + g) * 64 + il) * 64; const float* ps = A->in[I_POOLS] + l * 256 + g * 64; const float* wb = A->in[I_BRP] + ((size_t)l * 256 + g * 64) * DM + n;
            float s = 0.f;
            for (int j = 0; j < 64; ++j) s += pw[j] * ps[j] * wb[(size_t)j * DM];
            ((bf16_t*)(ws + WS_WBR))[((size_t)l * DM + n) * YN + Y_POOL + i] = (bf16_t)(cvt_pk_bf16(s, 0.f) & 0xffffu); }
    }
    {
        bf16_t* DF = (bf16_t*)(ws + WS_DFT);
        for (int idx = gt; idx < 2048 * 512; idx += NGT) { const int k = idx >> 9, n8 = (idx & 511) * 8; float v[8];
#pragma unroll
            for (int e = 0; e < 8; ++e) { const int np = n8 + e; if (np < 2048) v[e] = cospif((float)((k * np) & 2047) * (1.f / 1024.f)); else v[e] = -sinpif((float)((k * (np - 2048)) & 2047) * (1.f / 1024.f)); }
            u32x4 o; o.x = cvt_pk_bf16(v[0], v[1]); o.y = cvt_pk_bf16(v[2], v[3]); o.z = cvt_pk_bf16(v[4], v[5]); o.w = cvt_pk_bf16(v[6], v[7]);
            *(u32x4*)(DF + (size_t)k * 4096 + n8) = o; }
        bf16_t* DC = (bf16_t*)(ws + WS_DFTC);
        for (int idx = gt; idx < 256 * 64; idx += NGT) { const int k = idx >> 6, n8 = (idx & 63) * 8; float v[8];
#pragma unroll
            for (int e = 0; e < 8; ++e) { const int np = n8 + e; if (np < 256) v[e] = cospif((float)((k * np) & 255) * (1.f / 128.f)); else v[e] = -sinpif((float)((k * (np - 256)) & 255) * (1.f / 128.f)); }
            u32x4 o; o.x = cvt_pk_bf16(v[0], v[1]); o.y = cvt_pk_bf16(v[2], v[3]); o.z = cvt_pk_bf16(v[4], v[5]); o.w = cvt_pk_bf16(v[6], v[7]);
            *(u32x4*)(DC + (size_t)k * 4096 + n8) = o; }
    }
}

__device__ __forceinline__ void norm_phase(ArgP A, int l, int ch, bool second, int r_begin, int r_end, int r_step, const int tid) {
    const int lane = tid & 63, wave = tid >> 6;
    unsigned char* ws = A->ws;
    const int nrows = (second && l == 1) ? RL : RT, rend = r_end < nrows ? r_end : nrows;
    const float* gn = (second ? A->in[I_G2] : A->in[I_G1]) + l * DM;
    const float* MOD = (const float*)(ws + WS_MOD);
    bf16_t* U = (bf16_t*)(ws + WS_U);
    for (int r0 = r_begin + wave; r0 < rend; r0 += 2 * r_step) {
        const float* src[2]; const float* sh[2]; int rr[2]; bool ok[2];
#pragma unroll
        for (int q = 0; q < 2; ++q) { const int rq = r0 + q * r_step; ok[q] = rq < rend; const int r = ok[q] ? rq : r0; rr[q] = r; int bidx;
            if (r < RL) { const size_t grow = (size_t)ch * RL + r; src[q] = ((!second && l == 0) ? A->in[I_X] : (const float*)A->out) + grow * DM; bidx = ch * NB + (r >> 11); }
            else { const size_t grow = (size_t)ch * RC + (r - RL); src[q] = ((!second && l == 0) ? A->in[I_CTX] : (const float*)(ws + WS_CTXW)) + grow * DM; bidx = 32; }
            sh[q] = MOD + (size_t)((l * 33 + bidx) * 6 + (second ? 3 : 0)) * DM; }
        f32x4 v[2][4]; float s[2] = {0.f, 0.f};
#pragma unroll
        for (int q = 0; q < 2; ++q)
#pragma unroll
            for (int j = 0; j < 4; ++j) v[q][j] = *(const f32x4*)(src[q] + 4 * (lane + 64 * j));
#pragma unroll
        for (int q = 0; q < 2; ++q) {
#pragma unroll
            for (int j = 0; j < 4; ++j) s[q] += (v[q][j][0] * v[q][j][0] + v[q][j][1] * v[q][j][1]) + (v[q][j][2] * v[q][j][2] + v[q][j][3] * v[q][j][3]);
            s[q] = 1.0f / sqrtf(wave_sum(s[q]) * (1.f / DM) + 1e-6f); }
#pragma unroll
        for (int q = 0; q < 2; ++q) { if (!ok[q]) continue;
#pragma unroll
            for (int j = 0; j < 4; ++j) { const int col = 4 * (lane + 64 * j);
                const f32x4 gg = *(const f32x4*)(gn + col), s1 = *(const f32x4*)(sh[q] + DM + col), s0 = *(const f32x4*)(sh[q] + col);
                const f32x4 o = (v[q][j] * s[q]) * gg * (s1 + 1.0f) + s0;
                u32x2 w; w.x = cvt_pk_bf16(o[0], o[1]); w.y = cvt_pk_bf16(o[2], o[3]);
                *(u32x2*)(U + (size_t)rr[q] * DM + col) = w; } }
    }
}
__device__ __forceinline__ void final_norm(ArgP A, int G, const int tid) {
    const int lane = tid & 63, wave = tid >> 6;
    const float* gn = A->in[I_GF];
    for (int r0 = blockIdx.x * 8 + wave; r0 < NBATCH * SEQ; r0 += 2 * G * 8) {
        float* p[2]; f32x4 v[2][4]; float s[2] = {0.f, 0.f};
#pragma unroll
        for (int q = 0; q < 2; ++q) { int r = r0 + q * G * 8; if (r >= NBATCH * SEQ) r = r0; p[q] = A->out + (size_t)r * DM;
#pragma unroll
            for (int j = 0; j < 4; ++j) v[q][j] = *(const f32x4*)(p[q] + 4 * (lane + 64 * j)); }
#pragma unroll
        for (int q = 0; q < 2; ++q) {
#pragma unroll
            for (int j = 0; j < 4; ++j) s[q] += (v[q][j][0] * v[q][j][0] + v[q][j][1] * v[q][j][1]) + (v[q][j][2] * v[q][j][2] + v[q][j][3] * v[q][j][3]);
            s[q] = 1.0f / sqrtf(wave_sum(s[q]) * (1.f / DM) + 1e-6f); }
#pragma unroll
        for (int q = 0; q < 2; ++q)
#pragma unroll
            for (int j = 0; j < 4; ++j) { const int col = 4 * (lane + 64 * j); const f32x4 gg = *(const f32x4*)(gn + col); *(f32x4*)(p[q] + col) = (v[q][j] * s[q]) * gg; }
    }
}

__device__ __forceinline__ void unpack8(const u32x4 w, float (&f)[8]) {
#pragma unroll
    for (int e = 0; e < 4; ++e) { f[2 * e] = bf_lo(w[e]); f[2 * e + 1] = bf_hi(w[e]); }
}
__device__ __forceinline__ u32x4 pack8(const float (&f)[8]) { u32x4 o; o.x = cvt_pk_bf16(f[0], f[1]); o.y = cvt_pk_bf16(f[2], f[3]); o.z = cvt_pk_bf16(f[4], f[5]); o.w = cvt_pk_bf16(f[6], f[7]); return o; }

__device__ __forceinline__ void lru_item(ArgP A, int l, int it, bool pass2, LAS unsigned char* lds, const int tid) {
    const int lane = tid & 63, wid = tid >> 6;
    unsigned char* ws = A->ws;
    const int head = it & 7, rest = it >> 3;
    int sc, bl;
    if (!pass2 || l == 0) { sc = rest % NSC; bl = rest / NSC; } else { sc = 4 + (rest & 31); bl = rest >> 5; }
    const bool isctx = sc < 4; const int c = isctx ? sc : sc - 4, Lseq = isctx ? CTXL : SEQ, rowbase = isctx ? RL + bl * CTXL : bl * SEQ, t0 = c * 64;
    const bf16_t* Z = (const bf16_t*)(ws + WS_Z);
    LAS float* xaf = (LAS float*)lds;
    LAS bf16_t* xab = (LAS bf16_t*)(lds + 17408);
    LAS float* hbuf = (LAS float*)(lds + 32768);
    {
        const int t = tid >> 3, i8 = (tid & 7) * 8, tok = t0 + t, Cc = head * 64 + i8;
        float acc[8];
        { const f32x4 b0 = *(const f32x4*)(A->in[I_CONVB] + l * DLRU + Cc), b1 = *(const f32x4*)(A->in[I_CONVB] + l * DLRU + Cc + 4);
#pragma unroll
          for (int e = 0; e < 4; ++e) { acc[e] = b0[e]; acc[4 + e] = b1[e]; } }
#pragma unroll
        for (int k = 0; k < 4; ++k) { const int tt = tok + k - 2;
            if (tt >= 0 && tt < Lseq) { float z[8]; unpack8(*(const u32x4*)(Z + (size_t)(rowbase + tt) * ZN + Cc), z);
                const float* cw = A->in[I_CONVW] + (size_t)(l * 4 + k) * DLRU + Cc; const f32x4 c0 = *(const f32x4*)cw, c1 = *(const f32x4*)(cw + 4);
#pragma unroll
                for (int e = 0; e < 4; ++e) { acc[e] += z[e] * c0[e]; acc[4 + e] += z[4 + e] * c1[e]; } } }
        *(LAS f32x4*)(xaf + t * 68 + i8) = (f32x4){acc[0], acc[1], acc[2], acc[3]}; *(LAS f32x4*)(xaf + t * 68 + i8 + 4) = (f32x4){acc[4], acc[5], acc[6], acc[7]};
        *(LAS u32x4*)(xab + t * 72 + i8) = pack8(acc);
    }
    __syncthreads();
    {
        const int d = wid >> 2, g = wid & 3, fr = lane & 15, fq = lane >> 4;
        const bf16_t* wb = (const bf16_t*)(ws + WS_WG) + ((size_t)((l * 8 + head) * 256 + d * 128 + 16 * g + fr)) * 64 + 8 * fq;
        bf16x8 wR[2], wG[2];
#pragma unroll
        for (int ks = 0; ks < 2; ++ks) { wR[ks] = *(const bf16x8*)(wb + 32 * ks); wG[ks] = *(const bf16x8*)(wb + 64 * 64 + 32 * ks); }
        const int cb = head * 64 + 16 * g + 4 * fq;
        const f32x4 ba = *(const f32x4*)(A->in[I_BA] + (l * 2 + d) * DLRU + cb), bxv = *(const f32x4*)(A->in[I_BX] + (l * 2 + d) * DLRU + cb), lam = *(const f32x4*)(A->in[I_LAM] + (l * 2 + d) * DLRU + cb);
        f32x4 sp8;
#pragma unroll
        for (int e = 0; e < 4; ++e) sp8[e] = 8.0f * log1pf(__expf(-lam[e]));
        const int p = (d == 0) ? sc : (isctx ? 3 - c : 4 + 31 - c);
        float* SA = (float*)(ws + WS_SUMA) + ((size_t)(bl * 2 + d) * NSC) * DLRU + cb; float* SH = (float*)(ws + WS_SUMH) + ((size_t)(bl * 2 + d) * NSC) * DLRU + cb;
        f32x4 hin = (f32x4){0.f, 0.f, 0.f, 0.f}, Atot = (f32x4){1.f, 1.f, 1.f, 1.f}, Htot = (f32x4){0.f, 0.f, 0.f, 0.f};
        if (pass2) for (int pp = 0; pp < p; ++pp) { const f32x4 a4 = *(const f32x4*)(SA + (size_t)pp * DLRU), h4 = *(const f32x4*)(SH + (size_t)pp * DLRU); hin = a4 * hin + h4; }
        const int lastl = (lane & 48) | (d ? 0 : 15);
#pragma unroll
        for (int q = 0; q < 4; ++q) { const int tt = d ? 3 - q : q;
            f32x4 aR = (f32x4){0.f, 0.f, 0.f, 0.f}, aG = (f32x4){0.f, 0.f, 0.f, 0.f};
#pragma unroll
            for (int ks = 0; ks < 2; ++ks) { const bf16x8 bfrag = *(const LAS bf16x8*)(xab + (16 * tt + fr) * 72 + 8 * fq + 32 * ks);
                aR = __builtin_amdgcn_mfma_f32_16x16x32_bf16(wR[ks], bfrag, aR, 0, 0, 0); aG = __builtin_amdgcn_mfma_f32_16x16x32_bf16(wG[ks], bfrag, aG, 0, 0, 0); }
            const f32x4 xv = *(const LAS f32x4*)(xaf + (16 * tt + fr) * 68 + 16 * g + 4 * fq);
            f32x4 hv;
#pragma unroll
            for (int e = 0; e < 4; ++e) {
                const float r = sigm(aR[e] + ba[e]), gi = sigm(aG[e] + bxv[e]);
                const float la = -r * sp8[e], a = __expf(la), x2 = -2.0f * la;
                const float om = x2 < 0.1f ? x2 * (1.0f - x2 * (0.5f - x2 * (0.16666667f - x2 * 0.041666668f))) : 1.0f - a * a;
                float Av = a, Bv = sqrtf(om) * gi * xv[e];
#pragma unroll
                for (int off = 1; off < 16; off <<= 1) { const int src = d ? lane + off : lane - off; const float Ap = __shfl(Av, src), Bp = __shfl(Bv, src);
                    const bool valid = d ? (fr + off < 16) : (fr >= off); if (valid) { Bv = Av * Bp + Bv; Av = Av * Ap; } }
                if (pass2) { const float h = Av * hin[e] + Bv; hv[e] = h; hin[e] = __shfl(h, lastl); }
                else { const float AT = __shfl(Av, lastl), BT = __shfl(Bv, lastl); Htot[e] = AT * Htot[e] + BT; Atot[e] = Atot[e] * AT; }
            }
            if (pass2) *(LAS f32x4*)(hbuf + ((d * 64 + 16 * tt + fr) * 68 + 16 * g + 4 * fq)) = hv;
        }
        if (!pass2 && fr == 0) { *(f32x4*)(SA + (size_t)p * DLRU) = Atot; *(f32x4*)(SH + (size_t)p * DLRU) = Htot; }
    }
    if (pass2) {
        __syncthreads();
        const int t = tid >> 3, i8 = (tid & 7) * 8, tok = t0 + t, Cc = head * 64 + i8;
        float zg[8]; unpack8(*(const u32x4*)(Z + (size_t)(rowbase + tok) * ZN + Z_LG + Cc), zg);
        const f32x4 h00 = *(const LAS f32x4*)(hbuf + t * 68 + i8), h01 = *(const LAS f32x4*)(hbuf + t * 68 + i8 + 4), h10 = *(const LAS f32x4*)(hbuf + (64 + t) * 68 + i8), h11 = *(const LAS f32x4*)(hbuf + (64 + t) * 68 + i8 + 4);
        float y[8];
#pragma unroll
        for (int e = 0; e < 8; ++e) { const float hs = e < 4 ? h00[e & 3] + h10[e & 3] : h01[e & 3] + h11[e & 3]; const float x = zg[e];
            const float u2 = 1.5957691216057308f * (x + 0.044715f * x * x * x);
            y[e] = hs * x * sigm(u2); }
        *(u32x4*)((bf16_t*)(ws + WS_Y) + (size_t)(rowbase + tok) * YN + Cc) = pack8(y);
    }
}

__device__ __forceinline__ void sweep_chunk(int d, int j, int bl, int& rowbase, int& t0, int& Lseq, bool& isctx) {
    isctx = j < 4; const int c = isctx ? (d ? 3 - j : j) : (d ? 35 - j : j - 4);
    Lseq = isctx ? CTXL : SEQ; rowbase = isctx ? RL + bl * CTXL : bl * SEQ; t0 = c * 64;
}
__device__ __forceinline__ void lru_sweep(ArgP A, int l, int item, LAS unsigned char* lds, const int tid) {
    unsigned char* ws = A->ws;
    const int lane = tid & 63, wid = tid >> 6, d = wid >> 2, g = wid & 3, fr = lane & 15, fq = lane >> 4, hl = tid & 255;
    const int head = item & 7, bl = item >> 3;
    const bf16_t* Z = (const bf16_t*)(ws + WS_Z);
    LAS float* cwl = (LAS float*)(lds + 106496);
    __syncthreads();
    if (tid < 256) cwl[tid] = A->in[I_CONVW][(size_t)(l * 4 + (tid >> 6)) * DLRU + head * 64 + (tid & 63)];
    else if (tid < 320) cwl[tid] = A->in[I_CONVB][l * DLRU + head * 64 + (tid - 256)];
    const bf16_t* wb = (const bf16_t*)(ws + WS_WG) + ((size_t)((l * 8 + head) * 256 + d * 128 + 16 * g + fr)) * 64 + 8 * fq;
    bf16x8 wR[2], wG[2];
#pragma unroll
    for (int ks = 0; ks < 2; ++ks) { wR[ks] = *(const bf16x8*)(wb + 32 * ks); wG[ks] = *(const bf16x8*)(wb + 64 * 64 + 32 * ks); }
    const int cb = head * 64 + 16 * g + 4 * fq;
    const f32x4 ba = *(const f32x4*)(A->in[I_BA] + (l * 2 + d) * DLRU + cb), bxv = *(const f32x4*)(A->in[I_BX] + (l * 2 + d) * DLRU + cb), lam = *(const f32x4*)(A->in[I_LAM] + (l * 2 + d) * DLRU + cb);
    const float LOG2E = 1.4426950408889634f;
    f32x4 spl2; const f32x4 nba = ba * (-LOG2E), nbx = bxv * (-LOG2E);
#pragma unroll
    for (int e = 0; e < 4; ++e) { const float sp8 = 8.0f * log1pf(__expf(-lam[e])); spl2[e] = sp8 * LOG2E; }
    float* HX = (float*)(ws + (d ? WS_HB : WS_HF));
    const int lastl = lane | 15;
    const int ct = hl >> 2, ci = (hl & 3) * 16;
    f32x4 hin = (f32x4){0.f, 0.f, 0.f, 0.f};
#define SWEEP_LOAD(zr, jj) do { int rb_, t0_, Ls_; bool ic_; sweep_chunk(d, (jj) < NSC ? (jj) : NSC - 1, bl, rb_, t0_, Ls_, ic_); \
        _Pragma("unroll") for (int k = 0; k < 4; ++k) { const int tt_ = t0_ + ct + k - 2; const bool ok_ = (tt_ >= 0 && tt_ < Ls_); const int tc_ = ok_ ? tt_ : t0_ + ct; \
            const bf16_t* zp_ = Z + (size_t)(rb_ + tc_) * ZN + head * 64 + ci; const u32x4 l0_ = *(const u32x4*)zp_, l1_ = *(const u32x4*)(zp_ + 8); const unsigned mk_ = ok_ ? 0xffffffffu : 0u; \
            zr[k][0] = l0_ & mk_; zr[k][1] = l1_ & mk_; } } while (0)
#define SWEEP_CONV(zr, bufi) do { LAS float* xaf_ = (LAS float*)(lds + d * 53248 + (bufi) * 26624); LAS bf16_t* xab_ = (LAS bf16_t*)(lds + d * 53248 + (bufi) * 26624 + 17408); \
        _Pragma("unroll") for (int hf_ = 0; hf_ < 2; ++hf_) { float acc[8]; \
            { const f32x4 b0_ = *(const LAS f32x4*)(cwl + 256 + ci + 8 * hf_), b1_ = *(const LAS f32x4*)(cwl + 256 + ci + 8 * hf_ + 4); _Pragma("unroll") for (int e = 0; e < 4; ++e) { acc[e] = b0_[e]; acc[4 + e] = b1_[e]; } } \
            _Pragma("unroll") for (int k = 0; k < 4; ++k) { float z[8]; unpack8(zr[k][hf_], z); \
                const f32x4 w0_ = *(const LAS f32x4*)(cwl + k * 64 + ci + 8 * hf_), w1_ = *(const LAS f32x4*)(cwl + k * 64 + ci + 8 * hf_ + 4); \
                _Pragma("unroll") for (int e = 0; e < 4; ++e) { acc[e] += z[e] * w0_[e]; acc[4 + e] += z[4 + e] * w1_[e]; } } \
            *(LAS f32x4*)(xaf_ + ct * 68 + ci + 8 * hf_) = (f32x4){acc[0], acc[1], acc[2], acc[3]}; *(LAS f32x4*)(xaf_ + ct * 68 + ci + 8 * hf_ + 4) = (f32x4){acc[4], acc[5], acc[6], acc[7]}; \
            *(LAS u32x4*)(xab_ + ct * 72 + ci + 8 * hf_) = pack8(acc); } } while (0)
#define SCAN_LVL(N) "v_fmac_f32_dpp %0, %0, %4 row_shr:" #N " row_mask:0xf bank_mask:0xf\n\tv_fmac_f32_dpp %1, %1, %5 row_shr:" #N " row_mask:0xf bank_mask:0xf\n\t" \
                    "v_fmac_f32_dpp %2, %2, %6 row_shr:" #N " row_mask:0xf bank_mask:0xf\n\tv_fmac_f32_dpp %3, %3, %7 row_shr:" #N " row_mask:0xf bank_mask:0xf\n\t" \
                    "v_mul_f32_dpp %4, %4, %4 row_shr:" #N " row_mask:0xf bank_mask:0xf\n\tv_mul_f32_dpp %5, %5, %5 row_shr:" #N " row_mask:0xf bank_mask:0xf\n\t" \
                    "v_mul_f32_dpp %6, %6, %6 row_shr:" #N " row_mask:0xf bank_mask:0xf\n\tv_mul_f32_dpp %7, %7, %7 row_shr:" #N " row_mask:0xf bank_mask:0xf\n\t"
#define SWEEP_SCAN \
        f32x4 AvQ[4], BvQ[4]; \
        _Pragma("unroll") \
        for (int q = 0; q < 4; ++q) { const int tt = d ? 3 - q : q, trow = 16 * tt + (d ? 15 - fr : fr); \
            f32x4 aR = (f32x4){0.f, 0.f, 0.f, 0.f}, aG = (f32x4){0.f, 0.f, 0.f, 0.f}; \
        _Pragma("unroll") \
            for (int ks = 0; ks < 2; ++ks) { const bf16x8 bfrag = *(const LAS bf16x8*)(xab + trow * 72 + 8 * fq + 32 * ks); \
                aR = __builtin_amdgcn_mfma_f32_16x16x32_bf16(wR[ks], bfrag, aR, 0, 0, 0); aG = __builtin_amdgcn_mfma_f32_16x16x32_bf16(wG[ks], bfrag, aG, 0, 0, 0); } \
            const f32x4 xv = *(const LAS f32x4*)(xaf + trow * 68 + 16 * g + 4 * fq); \
            f32x4 Av, Bv; \
            { \
                const f32x4 tR = aR * (-LOG2E) + nba, tG = aG * (-LOG2E) + nbx; \
                f32x4 eR, eG; \
        _Pragma("unroll") \
                for (int e = 0; e < 4; ++e) { eR[e] = __builtin_amdgcn_exp2f(tR[e]); eG[e] = __builtin_amdgcn_exp2f(tG[e]); } \
                eR = eR + 1.0f; eG = eG + 1.0f; \
                f32x4 r, gi; \
        _Pragma("unroll") \
                for (int e = 0; e < 4; ++e) { r[e] = __builtin_amdgcn_rcpf(eR[e]); gi[e] = __builtin_amdgcn_rcpf(eG[e]); } \
                const f32x4 ta = r * spl2, x2 = ta * 1.3862943611198906f; \
        _Pragma("unroll") \
                for (int e = 0; e < 4; ++e) Av[e] = __builtin_amdgcn_exp2f(-ta[e]); \
                const f32x4 pser = x2 * (x2 * (x2 * 0.16666667f - 0.5f) + 1.0f), om1 = 1.0f - Av * Av; \
                f32x4 sq; \
        _Pragma("unroll") \
                for (int e = 0; e < 4; ++e) sq[e] = __builtin_amdgcn_sqrtf(x2[e] < 0.02f ? pser[e] : om1[e]); \
                Bv = sq * gi * xv; \
            } \
            { \
                float B0 = Bv[0], B1 = Bv[1], B2 = Bv[2], B3 = Bv[3], A0 = Av[0], A1 = Av[1], A2 = Av[2], A3 = Av[3]; \
                asm("s_nop 1\n\t" SCAN_LVL(1) SCAN_LVL(2) SCAN_LVL(4) SCAN_LVL(8) "s_nop 1" \
                    : "+v"(B0), "+v"(B1), "+v"(B2), "+v"(B3), "+v"(A0), "+v"(A1), "+v"(A2), "+v"(A3)); \
                AvQ[q] = (f32x4){A0, A1, A2, A3}; BvQ[q] = (f32x4){B0, B1, B2, B3}; \
            } \
        } \
        _Pragma("unroll") \
        for (int q = 0; q < 4; ++q) { const int tt = d ? 3 - q : q, trow = 16 * tt + (d ? 15 - fr : fr); \
            const f32x4 hq = AvQ[q] * hin + BvQ[q]; *(f32x4*)(HX + (size_t)(rowbase + t0 + trow) * DLRU + cb) = hq; \
        _Pragma("unroll") \
            for (int e = 0; e < 4; ++e) hin[e] = __shfl(hq[e], lastl); \
        }
    __syncthreads();
    u32x4 za[4][2], zb[4][2];
    { SWEEP_LOAD(zb, 0); SWEEP_LOAD(za, 1); SWEEP_CONV(zb, 0); }
    __syncthreads();
#define SWEEP_STEP(jj, ZL, ZC) do { const int j = (jj); \
        int rowbase, t0, Lseq; bool isctx; sweep_chunk(d, j, bl, rowbase, t0, Lseq, isctx); \
        SWEEP_LOAD(ZL, j + 2); \
        const LAS float* xaf = (const LAS float*)(lds + d * 53248 + (j & 1) * 26624); \
        const LAS bf16_t* xab = (const LAS bf16_t*)(lds + d * 53248 + (j & 1) * 26624 + 17408); \
        SWEEP_SCAN \
        if (j + 1 < NSC) SWEEP_CONV(ZC, (j + 1) & 1); \
        __syncthreads(); } while (0)
    for (int j2 = 0; j2 < NSC; j2 += 2) { SWEEP_STEP(j2, zb, za); SWEEP_STEP(j2 + 1, za, zb); }
#undef SWEEP_STEP
#undef SWEEP_SCAN
#undef SCAN_LVL
#undef SWEEP_LOAD
#undef SWEEP_CONV
    asm volatile("s_waitcnt vmcnt(0)" ::: "memory");
    __syncthreads();
    {
        const float* HF = (const float*)(ws + WS_HF); const float* HB = (const float*)(ws + WS_HB);
        const int t = tid >> 3, i8 = (tid & 7) * 8, Cc = head * 64 + i8;
        for (int sc0 = (l == 0 ? 0 : 4); sc0 < NSC; sc0 += 4) {
            u32x4 zgw[4]; f32x4 f0[4], f1[4], b0[4], b1[4]; int rows[4];
#pragma unroll
            for (int u = 0; u < 4; ++u) { const int sc = sc0 + u; const int row = (sc < 4 ? RL + bl * CTXL + sc * 64 : bl * SEQ + (sc - 4) * 64) + t; rows[u] = row;
                zgw[u] = *(const u32x4*)(Z + (size_t)row * ZN + Z_LG + Cc);
                f0[u] = *(const f32x4*)(HF + (size_t)row * DLRU + Cc); f1[u] = *(const f32x4*)(HF + (size_t)row * DLRU + Cc + 4);
                b0[u] = *(const f32x4*)(HB + (size_t)row * DLRU + Cc); b1[u] = *(const f32x4*)(HB + (size_t)row * DLRU + Cc + 4); }
#pragma unroll
            for (int u = 0; u < 4; ++u) { float zg[8]; unpack8(zgw[u], zg); float y[8];
#pragma unroll
                for (int e = 0; e < 8; ++e) { const float hs = e < 4 ? f0[u][e & 3] + b0[u][e & 3] : f1[u][e & 3] + b1[u][e & 3]; const float x = zg[e];
                    const float u2 = 1.5957691216057308f * (x + 0.044715f * x * x * x);
                    y[e] = hs * x * sigm(u2); }
                *(u32x4*)((bf16_t*)(ws + WS_Y) + (size_t)rows[u] * YN + Cc) = pack8(y); }
        }
    }
}

__device__ __forceinline__ void seg_decode(int it, int& rowbase, int& s0, int& lob, int& hib, int& Lseq) {
    if (it < 512) { const int bl = it >> 5, sg = it & 31; rowbase = bl * SEQ; s0 = sg * 64; lob = s0; hib = s0 + 64; Lseq = SEQ; }
    else { const int j = it - 512, bl = j >> 2, q = j & 3; rowbase = RL + bl * CTXL; s0 = q * 64; lob = 0; hib = CTXL; Lseq = CTXL; }
}
__device__ __forceinline__ void pool_item(ArgP A, int it, LAS unsigned char* lds, const int tid) {
    unsigned char* ws = A->ws;
    int rowbase, s0, lob, hib, Lseq; seg_decode(it, rowbase, s0, lob, hib, Lseq);
    const bf16_t* Z = (const bf16_t*)(ws + WS_Z) + Z_POOL;
    const int c8 = (tid & 31) * 8, tq = tid >> 5, w2 = 1 << (c8 >> 6);
    bf16_t* Y = (bf16_t*)(ws + WS_Y) + Y_POOL + c8;
#pragma unroll
    for (int u = 0; u < 4; ++u) { const int tok = s0 + tq * 4 + u; const int lo = max(tok - w2, lob), hi = min(tok + w2, hib);
        float sum[8];
#pragma unroll
        for (int e = 0; e < 8; ++e) sum[e] = 0.f;
        for (int j = lo; j < hi; ++j) { float z[8]; unpack8(*(const u32x4*)(Z + (size_t)(rowbase + j) * ZN + c8), z);
#pragma unroll
            for (int e = 0; e < 8; ++e) sum[e] += z[e]; }
        float zc[8]; unpack8(*(const u32x4*)(Z + (size_t)(rowbase + tok) * ZN + c8), zc);
        const float inv = 1.0f / (float)(hi - lo);
#pragma unroll
        for (int e = 0; e < 8; ++e) sum[e] = sum[e] * inv - zc[e];
        *(u32x4*)(Y + (size_t)(rowbase + tok) * YN) = pack8(sum); }
}
__device__ __forceinline__ void sconv_item(ArgP A, int l, int it, const int tid) {
    unsigned char* ws = A->ws;
    int rowbase, s0, lob, hib, Lseq; seg_decode(it, rowbase, s0, lob, hib, Lseq);
    const bf16_t* Z = (const bf16_t*)(ws + WS_Z);
    const int c8 = (tid & 31) * 8, tr = tid >> 5;
    const float* sw = A->in[I_SCW] + (size_t)l * 3 * 256 + c8;
    f32x4 w0[3], w1[3];
#pragma unroll
    for (int k = 0; k < 3; ++k) { w0[k] = *(const f32x4*)(sw + k * 256); w1[k] = *(const f32x4*)(sw + k * 256 + 4); }
#pragma unroll
    for (int pp = 0; pp < 2; ++pp) {
        u32x4 gcw[2][3], hsw[2][3], gbw[2];
#pragma unroll
        for (int q = 0; q < 2; ++q) { const int tok = s0 + (pp * 2 + q) * 16 + tr;
            gbw[q] = *(const u32x4*)(Z + (size_t)(rowbase + tok) * ZN + Z_SC + c8);
#pragma unroll
            for (int k = 0; k < 3; ++k) { const int tt = tok + k - 1; const bool ok = (tt >= 0 && tt < Lseq); const bf16_t* zr = Z + (size_t)(rowbase + (ok ? tt : tok)) * ZN + Z_SC + c8;
                const u32x4 a = *(const u32x4*)(zr + 256), b = *(const u32x4*)(zr + 512); const unsigned mk = ok ? 0xffffffffu : 0u; gcw[q][k] = a & mk; hsw[q][k] = b; } }
#pragma unroll
        for (int q = 0; q < 2; ++q) { const int tok = s0 + (pp * 2 + q) * 16 + tr; float acc[8];
#pragma unroll
            for (int e = 0; e < 8; ++e) acc[e] = 0.f;
#pragma unroll
            for (int k = 0; k < 3; ++k) { float gc[8], hs[8]; unpack8(gcw[q][k], gc); unpack8(hsw[q][k], hs);
#pragma unroll
                for (int e = 0; e < 4; ++e) { acc[e] += gc[e] * hs[e] * w0[k][e]; acc[4 + e] += gc[4 + e] * hs[4 + e] * w1[k][e]; } }
            float gb[8]; unpack8(gbw[q], gb);
#pragma unroll
            for (int e = 0; e < 8; ++e) acc[e] *= gb[e];
            *(u32x4*)((bf16_t*)(ws + WS_Y) + (size_t)(rowbase + tok) * YN + Y_SC + c8) = pack8(acc); }
    }
}

__device__ __forceinline__ int fetch_item(unsigned* ctr, LAS unsigned char* lds, const int tid) {
    LAS unsigned* slot = (LAS unsigned*)(lds + QSLOT_OFF);
    __syncthreads();
    if (tid == 0) *slot = atomicAdd(ctr, 1u);
    __syncthreads();
    return (int)*slot;
}


#define XB_TMO      128
#define XB_XCNT(j)  (256  + 64 * (j))
#define XB_XSUB(j)  (1280 + 64 * (j))
#define XB_XGEN(j)  (2304 + 64 * (j))
#define XB_TOP      3328
#define XB_TOPGEN   3392
#define XCD_BAR_WORDS 3456
#define XB_SPIN_CAP (1u << 22)
__device__ __forceinline__ unsigned xb_ld(unsigned* p)              { return __hip_atomic_load(p, __ATOMIC_RELAXED, __HIP_MEMORY_SCOPE_AGENT); }
__device__ __forceinline__ unsigned xb_add(unsigned* p, unsigned v) { return __hip_atomic_fetch_add(p, v, __ATOMIC_RELAXED, __HIP_MEMORY_SCOPE_AGENT); }
__device__ __forceinline__ unsigned xb_xcc_id() { return (unsigned)__builtin_amdgcn_s_getreg((3 << 11) | 20) & 0xFu; }
#define XB_SPIN(cond, bar) do { unsigned _sp = 0; while (cond) { __builtin_amdgcn_s_sleep(1); \
    if ((++_sp & 255u) == 0u) { if (xb_ld(&(bar)[XB_TMO])) break; if (_sp > XB_SPIN_CAP) { atomicAdd(&(bar)[XB_TMO], 1u); break; } } } } while (0)
struct XcdBarrier { unsigned* bar; unsigned x; volatile LAS unsigned* st; };
__device__ __forceinline__ XcdBarrier xcd_barrier_post(unsigned* bar, volatile LAS unsigned* st) {
    XcdBarrier b; b.bar = bar; b.x = xb_xcc_id(); b.st = st;
    if (threadIdx.x == 0) (void)xb_add(&bar[XB_XCNT(b.x)], 1u);
    return b;
}
__device__ __forceinline__ void xcd_barrier_complete(unsigned* bar, unsigned x, unsigned& nloc, unsigned& nx) {
    const unsigned G = gridDim.x * gridDim.y * gridDim.z;
    unsigned sum, cnt, mine, sp = 0u;
    for (;;) {
        sum = 0u; cnt = 0u; mine = 0u;
#pragma unroll
        for (unsigned j = 0; j < 16; ++j) { const unsigned c = xb_ld(&bar[XB_XCNT(j)]); sum += c; cnt += (c > 0u) ? 1u : 0u; }
        mine = xb_ld(&bar[XB_XCNT(x)]);
        if (sum == G) break;
        __builtin_amdgcn_s_sleep(1);
        if ((++sp & 255u) == 0u) { if (xb_ld(&bar[XB_TMO])) break; if (sp > XB_SPIN_CAP) { atomicAdd(&bar[XB_TMO], 1u); break; } }
    }
    nloc = mine > 0u ? mine : 1u; nx = cnt > 0u ? cnt : 1u;
}
__device__ __forceinline__ void xcd_barrier(const XcdBarrier& b, const int tid) {
    asm volatile("s_waitcnt vmcnt(0)" ::: "memory");
    __syncthreads();
    if (tid == 0) {
        unsigned* bar = b.bar;
        __builtin_amdgcn_s_waitcnt(0);
        unsigned nloc = b.st[0], nx = b.st[1];
        if (nloc == 0u) { xcd_barrier_complete(bar, b.x, nloc, nx); b.st[0] = nloc; b.st[1] = nx; }
        const unsigned old = xb_add(&bar[XB_XSUB(b.x)], 1u);
        const unsigned gen = old / nloc;
        if (old + 1u == (gen + 1u) * nloc) {
            __builtin_amdgcn_fence(__ATOMIC_RELEASE, "agent");
            asm volatile("s_waitcnt vmcnt(0)" ::: "memory");
            const unsigned og = xb_add(&bar[XB_TOP], 1u);
            const unsigned tg = og / nx;
            if (og + 1u == (tg + 1u) * nx) xb_add(&bar[XB_TOPGEN], 1u);
            else XB_SPIN(xb_ld(&bar[XB_TOPGEN]) == tg, bar);
            __builtin_amdgcn_fence(__ATOMIC_ACQUIRE, "agent");
            xb_add(&bar[XB_XGEN(b.x)], 1u);
            asm volatile("s_waitcnt vmcnt(0)" ::: "memory");
        } else {
            XB_SPIN(xb_ld(&bar[XB_XGEN(b.x)]) == gen, bar);
            __builtin_amdgcn_fence(__ATOMIC_ACQUIRE, "agent");
            asm volatile("s_waitcnt vmcnt(0)" ::: "memory");
        }
    }
    __syncthreads();
}

template <bool COOP>
__global__ void __launch_bounds__(512, 2) fwd_kernel(Args Aparam) {
    extern __shared__ __attribute__((aligned(16))) unsigned char lds_raw[];
    LAS unsigned char* lds = (LAS unsigned char*)lds_raw;
    const int G = gridDim.x;
    ArgP A = (ArgP)__builtin_amdgcn_kernarg_segment_ptr();
    const int ph_lo = A->ph_lo, ph_hi = A->ph_hi;
    XcdBarrier xbar; xbar.bar = nullptr; xbar.x = 0; xbar.st = (volatile LAS unsigned*)(lds + QSLOT_OFF + 16);
    if constexpr (COOP) {
        if (threadIdx.x < 2) xbar.st[threadIdx.x] = 0u;
        __syncthreads();
        xbar = xcd_barrier_post((unsigned*)(A->ws + WS_CTL) + 8192, xbar.st);
    }
    int tid0 = threadIdx.x;
    for (int ph = ph_lo; ph < ph_hi; ++ph) {
        asm volatile("" : "+s"(A));
        asm volatile("" : "+v"(tid0)); const int tid = tid0;
        unsigned* ctl = (unsigned*)(A->ws + WS_CTL);
        if (ph < PH_BASE) p0_prologue(A, lds, G, tid);
        else if (ph == NPHASE - 1) final_norm(A, G, tid);
        else if (ph == PH_BASE) norm_phase(A, 0, 0, false, (int)blockIdx.x * 8, RT, G * 8, tid);
        else {
            const int q = ph - PH_BASE - 1, kj = q % PH_PER, lc = q / PH_PER, l = lc >> 1, ch = lc & 1;
            const int PKJ = PROBE_K < 3 ? PROBE_K - 1 : PROBE_K - 2;
            const int kq = (PROBE_K >= 1 && PROBE_K <= 8 && kj > PKJ) ? kj - 1 : kj;
            const int k = kq < 2 ? kq + 1 : kq + 2;
            const int sub = (PROBE_K >= 1 && PROBE_K <= 8 && kj == PKJ + 1) ? PROBE_SUB : 7;
            if (k == 6) norm_phase(A, l, ch, true, (int)blockIdx.x * 8, RT, G * 8, tid);
            else {
                Sched S; S.kind = k; S.l = l; S.ch = ch; S.G = G; S.c = (int)blockIdx.x; S.ap = A;
                pg8::Gemm g; g.lda = (k == 2 || k == 8) ? 4096 : (k == 4 ? YN : DM); g.ldb = g.lda;
                if (k == 2 && !(sub & 1)) {} else if (k == 1 || k == 2 || k == 7) { pg8::EpiBf E; E.act = (k == 7) ? 1 : 0; pg8::gemm_phase<pg8::EpiBf, Sched>(lds, g, S, E, tid); }
                else if (k == 4) { pg8::EpiMerge E; pg8::gemm_phase<pg8::EpiMerge, Sched>(lds, g, S, E, tid); }
                else { pg8::EpiRes E; pg8::gemm_phase<pg8::EpiRes, Sched>(lds, g, S, E, tid); }
                if (k == 8 && lc + 1 < DEPTH * NCH) {
                    const int l2 = (lc + 1) >> 1, ch2 = (lc + 1) & 1;
                    for (;;) { const int it = fetch_item(ctl + 64 * ph, lds, tid); if (it >= RT / 64) break; norm_phase(A, l2, ch2, false, it * 64, it * 64 + 64, 8, tid); }
                }
                if (k == 2) {
                    if (sub & 2) for (int it = (int)blockIdx.x - (G >> 1); it >= 0 && it < NB * 8; it += G - (G >> 1)) lru_sweep(A, l, it, lds, tid);
                    const int nseg = (l == 0) ? 576 : 512, total = (sub & 4) ? 2 * nseg : 0;
                    for (;;) { const int it = fetch_item(ctl + 64 * ph, lds, tid); if (it >= total) break;
                        if (it < nseg) pool_item(A, it, lds, tid);
                        else sconv_item(A, l, it - nseg, tid); }
                }
            }
        }
        if (ph + 1 < ph_hi) { if constexpr (COOP) { if (ph == 0) cg::this_grid().sync(); else xcd_barrier(xbar, tid); } }
    }
}

extern "C" void kernel_launch(void* const* d_in, const int* in_sizes, int n_in, void* d_out, int out_size, void* d_ws, size_t ws_size, hipStream_t stream) {
    static int grid = 0;
    if (grid == 0) {
        if (n_in != 27 || out_size != NBATCH * SEQ * DM || ws_size < WS_END) { fprintf(stderr, "kernel_launch: unexpected shapes (n_in %d out %d ws %zu)\n", n_in, out_size, ws_size); grid = -1; return; }
        int dev = 0, cus = 0, per_cu = 0;
        hipGetDevice(&dev); hipDeviceGetAttribute(&cus, hipDeviceAttributeMultiprocessorCount, dev);
        hipFuncSetAttribute((const void*)fwd_kernel<true>, hipFuncAttributeMaxDynamicSharedMemorySize, LDS_BYTES);
        hipFuncSetAttribute((const void*)fwd_kernel<false>, hipFuncAttributeMaxDynamicSharedMemorySize, LDS_BYTES);
        hipOccupancyMaxActiveBlocksPerMultiprocessor(&per_cu, (const void*)fwd_kernel<true>, 512, LDS_BYTES);
        (void)hipGetLastError();
        if (per_cu < 1) per_cu = 1;
        grid = cus * 1;
        if (grid <= 0) grid = 256;
    }
    if (grid < 0) return;
    hipMemsetAsync((char*)d_ws + WS_CTL, 0, CTL_ZERO_BYTES, stream);
    Args a{};
    for (int i = 0; i < 27; ++i) a.in[i] = (const float*)d_in[i];
    a.out = (float*)d_out; a.ws = (unsigned char*)d_ws;
#if MK_COOP
    a.ph_lo = 0; a.ph_hi = NPHASE;
    void* args[] = {&a};
    hipError_t e = hipLaunchCooperativeKernel((const void*)fwd_kernel<true>, dim3(grid), dim3(512), args, LDS_BYTES, stream);
    if (e != hipSuccess) fprintf(stderr, "cooperative launch failed: %s (grid %d)\n", hipGetErrorString(e), grid);
#else
    for (int ph = 0; ph < NPHASE; ++ph) { a.ph_lo = ph; a.ph_hi = ph + 1; hipLaunchKernelGGL(fwd_kernel<false>, dim3(grid), dim3(512), LDS_BYTES, stream, a); }
#endif
}
```
